# Optimizing an MI355X kernel written in HIP

```python
import jax
import jax.numpy as jnp
from jax import lax
import numpy as np

D_MODEL = 1024
BATCH = 16
SEQ = 2048
DEPTH = 2

MEM_LEN = 256
MIX_WIDTH = D_MODEL
A_WIDTH = MIX_WIDTH // 2
HGRN_HEAD_DIM = 128
HGRN_HEADS = A_WIDTH // HGRN_HEAD_DIM
HGRN_CHUNK = 64
B_WIDTH = MIX_WIDTH - A_WIDTH
CONV_WIDTH = 31
C_WIDTH = MIX_WIDTH // 2
MOBA_HEAD_DIM = 64
MOBA_HEADS = C_WIDTH // MOBA_HEAD_DIM
MOBA_BLOCK = 256
MOBA_TOPK = 3
MOBA_QCHUNK = 64
D_WIDTH = MIX_WIDTH - C_WIDTH
SGU_CHUNK = 128
SGU_GROUPS = 4
SGU_GROUP_DIM = D_WIDTH // SGU_GROUPS
XA_HEADS = 4
XA_HEAD_DIM = D_MODEL // XA_HEADS
FFN_HIDDEN = ((-(-8 * D_MODEL // 3) + 255) // 256) * 256
EVEN_IN = 4 * A_WIDTH + 2 * B_WIDTH
ODD_IN = 3 * C_WIDTH + 2 * D_WIDTH
N_EVEN = (DEPTH + 1) // 2
N_ODD = DEPTH // 2
EPS = 1e-6

kernel_name = 'hybrid_hgrn2_conv_moba_sgu_trunk'


def _rmsnorm(x, g):
    xf = x.astype(jnp.float32)
    y = xf * lax.rsqrt(jnp.mean(xf * xf, axis=-1, keepdims=True) + EPS)
    return (y * g.astype(jnp.float32)).astype(x.dtype)


def _layernorm(x, g, b):
    xf = x.astype(jnp.float32)
    mu = jnp.mean(xf, axis=-1, keepdims=True)
    var = jnp.mean(jnp.square(xf - mu), axis=-1, keepdims=True)
    y = (xf - mu) * lax.rsqrt(var + EPS) * g.astype(jnp.float32) + b.astype(jnp.float32)
    return y.astype(x.dtype)


def _hgrn2_chunkwise(q, f, v):
    bsz, seq, _ = q.shape
    n_chunks = seq // HGRN_CHUNK

    def heads(t):
        t = t.astype(jnp.float32).reshape(bsz, n_chunks, HGRN_CHUNK, HGRN_HEADS, HGRN_HEAD_DIM)
        return t.transpose(1, 0, 3, 2, 4)

    qf, ff, vf = heads(q), heads(f), heads(v)
    cum = jnp.cumsum(jnp.log(ff), axis=3)
    kf = 1.0 - ff
    q_in = qf * jnp.exp(cum)
    k_in = kf * jnp.exp(-cum)
    causal = jnp.tril(jnp.ones((HGRN_CHUNK, HGRN_CHUNK), dtype=bool))
    att = jnp.where(causal, jnp.einsum('nbhcd,nbhsd->nbhcs', q_in, k_in), 0.0)
    o_intra = jnp.einsum('nbhcs,nbhse->nbhce', att, vf)
    cum_last = cum[..., -1:, :]
    chunk_kv = jnp.einsum('nbhsd,nbhse->nbhde', kf * jnp.exp(cum_last - cum), vf)
    decay = jnp.exp(cum_last[..., 0, :])

    def step(state, xs):
        q_n, kv_n, d_n = xs
        o_n = jnp.einsum('bhcd,bhde->bhce', q_n, state)
        return d_n[..., None] * state + kv_n, o_n

    state0 = jnp.zeros((bsz, HGRN_HEADS, HGRN_HEAD_DIM, HGRN_HEAD_DIM), jnp.float32)
    _, o_inter = lax.scan(step, state0, (q_in, chunk_kv, decay))
    o = (o_intra + o_inter).transpose(1, 0, 3, 2, 4)
    return o.reshape(bsz, seq, HGRN_HEADS, HGRN_HEAD_DIM)


def _causal_depthwise_conv(x, w, b):
    y = lax.conv_general_dilated(
        x, w[:, None, :], window_strides=(1,), padding=[(CONV_WIDTH - 1, 0)],
        dimension_numbers=('NWC', 'WIO', 'NWC'), feature_group_count=x.shape[-1])
    return y + b


def _mixer_hgrn2_conv(h, w_in, w_out, lb, out_norm, dw_w, dw_b, ln_g, ln_b):
    bsz, seq, _ = h.shape
    proj = h @ w_in
    qz, fz, iz, gz, glu_a, glu_b = jnp.split(
        proj, [A_WIDTH, 2 * A_WIDTH, 3 * A_WIDTH, 4 * A_WIDTH, 4 * A_WIDTH + B_WIDTH], axis=-1)
    f = lb + (1.0 - lb) * jax.nn.sigmoid(fz.astype(jnp.float32))
    o = _hgrn2_chunkwise(jax.nn.silu(qz), f, iz)
    o = o * lax.rsqrt(jnp.mean(o * o, axis=-1, keepdims=True) + EPS)
    o_a = (o.reshape(bsz, seq, A_WIDTH) * out_norm.astype(jnp.float32)
           * jax.nn.silu(gz.astype(jnp.float32))).astype(h.dtype)
    c = glu_a * jax.nn.sigmoid(glu_b)
    c = _causal_depthwise_conv(c, dw_w, dw_b)
    o_b = jax.nn.silu(_layernorm(c, ln_g, ln_b))
    return jnp.concatenate([o_a, o_b], axis=-1) @ w_out


def _moba_attention(q, k, v):
    bsz, seq, n_h, hd = q.shape
    n_blk = -(-seq // MOBA_BLOCK)
    s_pad = n_blk * MOBA_BLOCK
    pad = s_pad - seq
    if pad:
        cfg = ((0, 0), (0, pad), (0, 0), (0, 0))
        q, k, v = jnp.pad(q, cfg), jnp.pad(k, cfg), jnp.pad(v, cfg)
    qh = q.transpose(0, 2, 1, 3)
    kb = k.transpose(0, 2, 1, 3).reshape(bsz, n_h, n_blk, MOBA_BLOCK, hd)
    vb = v.transpose(0, 2, 1, 3).reshape(bsz, n_h, n_blk, MOBA_BLOCK, hd)
    topk = min(MOBA_TOPK, n_blk - 1)
    scale = MOBA_HEAD_DIM ** -0.5
    if topk > 0:
        k_mean = jnp.mean(kb.astype(jnp.float32), axis=3)
        blk_score = jnp.einsum('bhqd,bhnd->bhqn', qh.astype(jnp.float32), k_mean)
        q_blk = jnp.arange(s_pad) // MOBA_BLOCK
        fully_past = jnp.arange(n_blk)[None, :] < q_blk[:, None]
        blk_score = jnp.where(fully_past, blk_score, -jnp.inf)
        _, idx = lax.top_k(blk_score, topk)
        idx = idx.astype(jnp.int32)
    else:
        idx = jnp.zeros((bsz, n_h, s_pad, 0), jnp.int32)
    n_qc = s_pad // MOBA_QCHUNK
    h_ar = jnp.arange(n_h)[:, None, None]

    def per_batch(args):
        q_b, kb_b, vb_b, idx_b = args

        def per_chunk(c):
            start = c * MOBA_QCHUNK
            q_c = lax.dynamic_slice_in_dim(q_b, start, MOBA_QCHUNK, axis=1)
            jq = start // MOBA_BLOCK
            k_own = lax.dynamic_index_in_dim(kb_b, jq, axis=1, keepdims=False)
            v_own = lax.dynamic_index_in_dim(vb_b, jq, axis=1, keepdims=False)
            qpos = start + jnp.arange(MOBA_QCHUNK)
            kpos = jq * MOBA_BLOCK + jnp.arange(MOBA_BLOCK)
            s_own = jnp.einsum('hqd,hpd->hqp', q_c, k_own).astype(jnp.float32) * scale
            s_own = jnp.where(kpos[None, :] <= qpos[:, None], s_own, -jnp.inf)
            if topk > 0:
                idx_c = lax.dynamic_slice_in_dim(idx_b, start, MOBA_QCHUNK, axis=1)
                kg = kb_b[h_ar, idx_c]
                vg = vb_b[h_ar, idx_c]
                s_sel = jnp.einsum('hqd,hqkpd->hqkp', q_c, kg).astype(jnp.float32) * scale
                s_sel = jnp.where((idx_c < jq)[..., None], s_sel, -jnp.inf)
                s_sel = s_sel.reshape(n_h, MOBA_QCHUNK, topk * MOBA_BLOCK)
                p = jax.nn.softmax(jnp.concatenate([s_sel, s_own], axis=-1), axis=-1).astype(v_own.dtype)
                p_sel = p[..., :topk * MOBA_BLOCK].reshape(n_h, MOBA_QCHUNK, topk, MOBA_BLOCK)
                o = (jnp.einsum('hqkp,hqkpe->hqe', p_sel, vg)
                     + jnp.einsum('hqp,hpe->hqe', p[..., topk * MOBA_BLOCK:], v_own))
            else:
                p = jax.nn.softmax(s_own, axis=-1).astype(v_own.dtype)
                o = jnp.einsum('hqp,hpe->hqe', p, v_own)
            return o

        out = lax.map(per_chunk, jnp.arange(n_qc))
        return out.transpose(1, 0, 2, 3).reshape(n_h, s_pad, hd)

    out = lax.map(per_batch, (qh, kb, vb, idx))
    return out.transpose(0, 2, 1, 3)[:, :seq]


def _mixer_moba_sgu(h, w_in, w_out, sgu_ln_g, sgu_ln_b, sgu_w, sgu_b):
    bsz, seq, _ = h.shape
    proj = h @ w_in
    qz, kz, vz, uz, zz = jnp.split(
        proj, [C_WIDTH, 2 * C_WIDTH, 3 * C_WIDTH, 3 * C_WIDTH + D_WIDTH], axis=-1)
    hs = (bsz, seq, MOBA_HEADS, MOBA_HEAD_DIM)
    o_c = _moba_attention(qz.reshape(hs), kz.reshape(hs), vz.reshape(hs)).reshape(bsz, seq, C_WIDTH)
    u = jax.nn.gelu(uz, approximate=False)
    z = jax.nn.gelu(zz, approximate=False).reshape(bsz, seq, SGU_GROUPS, SGU_GROUP_DIM)
    z = _layernorm(z, sgu_ln_g.reshape(SGU_GROUPS, SGU_GROUP_DIM), sgu_ln_b.reshape(SGU_GROUPS, SGU_GROUP_DIM))
    zc = z.reshape(bsz, seq // SGU_CHUNK, SGU_CHUNK, SGU_GROUPS, SGU_GROUP_DIM)
    w_s = jnp.where(jnp.tril(jnp.ones((SGU_CHUNK, SGU_CHUNK), dtype=bool)), sgu_w, 0.0)
    mixed = jnp.einsum('gts,bnsgc->bntgc', w_s.astype(zc.dtype), zc) + sgu_b.T[None, None, :, :, None]
    o_d = u * mixed.reshape(bsz, seq, D_WIDTH)
    return jnp.concatenate([o_c, o_d], axis=-1) @ w_out


def _cross_attention(h, mem_n, wq, wkv, wo):
    bsz, seq, _ = h.shape
    q = (h @ wq).reshape(bsz, seq, XA_HEADS, XA_HEAD_DIM)
    k, v = jnp.split(mem_n @ wkv, 2, axis=-1)
    k = k.reshape(bsz, -1, XA_HEADS, XA_HEAD_DIM)
    v = v.reshape(bsz, -1, XA_HEADS, XA_HEAD_DIM)
    s = jnp.einsum('bshd,bmhd->bhsm', q, k).astype(jnp.float32) * (XA_HEAD_DIM ** -0.5)
    p = jax.nn.softmax(s, axis=-1).astype(v.dtype)
    o = jnp.einsum('bhsm,bmhd->bshd', p, v).reshape(bsz, seq, D_MODEL)
    return o @ wo


def _swiglu(h, w_in, w_out):
    a, g = jnp.split(h @ w_in, 2, axis=-1)
    return (jax.nn.silu(a) * g) @ w_out


def setup_inputs(seed: int = 0) -> dict:
    key = jax.random.key(seed)
    ks = jax.random.split(key, 32)

    def nrm(k, shape, scale):
        return jax.random.normal(k, shape, jnp.float32) * scale

    def gain(k, shape):
        return 1.0 + 0.02 * jax.random.normal(k, shape, jnp.float32)

    return {
        'x': nrm(ks[0], (BATCH, SEQ, D_MODEL), 1.0),
        'mem': nrm(ks[1], (BATCH, MEM_LEN, D_MODEL), 1.0),
        'norm_mix': gain(ks[2], (DEPTH, D_MODEL)),
        'norm_xattn': gain(ks[3], (DEPTH, D_MODEL)),
        'norm_ffn': gain(ks[4], (DEPTH, D_MODEL)),
        'mem_norm': gain(ks[5], (D_MODEL,)),
        'final_norm': gain(ks[6], (D_MODEL,)),
        'w_in_ab': nrm(ks[7], (N_EVEN, D_MODEL, EVEN_IN), D_MODEL ** -0.5),
        'w_out_ab': nrm(ks[8], (N_EVEN, MIX_WIDTH, D_MODEL), MIX_WIDTH ** -0.5),
        'hgrn_lower_bounds': nrm(ks[9], (DEPTH + 1, A_WIDTH), 0.1),
        'hgrn_out_norm': gain(ks[10], (N_EVEN, A_WIDTH)),
        'conv_dw_w': nrm(ks[11], (N_EVEN, CONV_WIDTH, B_WIDTH), CONV_WIDTH ** -0.5),
        'conv_dw_b': nrm(ks[12], (N_EVEN, B_WIDTH), 0.02),
        'conv_ln_g': gain(ks[13], (N_EVEN, B_WIDTH)),
        'conv_ln_b': nrm(ks[14], (N_EVEN, B_WIDTH), 0.02),
        'w_in_cd': nrm(ks[15], (N_ODD, D_MODEL, ODD_IN), D_MODEL ** -0.5),
        'w_out_cd': nrm(ks[16], (N_ODD, MIX_WIDTH, D_MODEL), MIX_WIDTH ** -0.5),
        'sgu_ln_g': gain(ks[17], (N_ODD, D_WIDTH)),
        'sgu_ln_b': nrm(ks[18], (N_ODD, D_WIDTH), 0.02),
        'sgu_w': nrm(ks[19], (N_ODD, SGU_GROUPS, SGU_CHUNK, SGU_CHUNK), SGU_CHUNK ** -0.5),
        'sgu_b': gain(ks[20], (N_ODD, SGU_GROUPS, SGU_CHUNK)),
        'xa_wq': nrm(ks[21], (DEPTH, D_MODEL, D_MODEL), D_MODEL ** -0.5),
        'xa_wkv': nrm(ks[22], (DEPTH, D_MODEL, 2 * D_MODEL), D_MODEL ** -0.5),
        'xa_wo': nrm(ks[23], (DEPTH, D_MODEL, D_MODEL), D_MODEL ** -0.5),
        'ffn_w_in': nrm(ks[24], (DEPTH, D_MODEL, 2 * FFN_HIDDEN), D_MODEL ** -0.5),
        'ffn_w_out': nrm(ks[25], (DEPTH, FFN_HIDDEN, D_MODEL), FFN_HIDDEN ** -0.5),
    }


def reference(x, mem, norm_mix, norm_xattn, norm_ffn, mem_norm, final_norm,
              w_in_ab, w_out_ab, hgrn_lower_bounds, hgrn_out_norm,
              conv_dw_w, conv_dw_b, conv_ln_g, conv_ln_b,
              w_in_cd, w_out_cd, sgu_ln_g, sgu_ln_b, sgu_w, sgu_b,
              xa_wq, xa_wkv, xa_wo, ffn_w_in, ffn_w_out):
    lb_all = jnp.cumsum(jax.nn.softmax(hgrn_lower_bounds.astype(jnp.float32), axis=0), axis=0)
    mem_n = _rmsnorm(mem, mem_norm)
    for l in range(DEPTH):
        h = _rmsnorm(x, norm_mix[l])
        if l % 2 == 0:
            e = l // 2
            x = x + _mixer_hgrn2_conv(h, w_in_ab[e], w_out_ab[e], lb_all[l], hgrn_out_norm[e],
                                      conv_dw_w[e], conv_dw_b[e], conv_ln_g[e], conv_ln_b[e])
        else:
            o = l // 2
            x = x + _mixer_moba_sgu(h, w_in_cd[o], w_out_cd[o], sgu_ln_g[o], sgu_ln_b[o],
                                    sgu_w[o], sgu_b[o])
        x = x + _cross_attention(_rmsnorm(x, norm_xattn[l]), mem_n, xa_wq[l], xa_wkv[l], xa_wo[l])
        x = x + _swiglu(_rmsnorm(x, norm_ffn[l]), ffn_w_in[l], ffn_w_out[l])
    return _rmsnorm(x, final_norm)
```

```cpp
#include <hip/hip_runtime.h>
#include <cstdio>
#include <cstdint>
#include <cmath>
namespace pg8 {
#define PG8_LAS __attribute__((address_space(3)))
typedef unsigned short bf16_t;
typedef short bf16x8 __attribute__((ext_vector_type(8)));
typedef float f32x4 __attribute__((ext_vector_type(4)));
typedef unsigned u32x4 __attribute__((ext_vector_type(4)));
constexpr int BM = 256, BK = 64, HALF = 128, HTB = HALF * BK * 2  , STAGE_BYTES = 8 * HTB, NXCD = 8, WGM = 8;

__host__ __device__ __forceinline__ int lds_byte(int r, int c) { const int st = (r >> 4) * 2 + (c >> 5), rr = r & 15, cc = c & 31, ob = rr * 64 + cc * 2; return st * 1024 + (ob ^ (((ob >> 9) & 1) << 5)); }
__host__ __device__ __forceinline__ void stage_rc(int b, int& R, int& C) { const int st = b / 1024, sb = b % 1024, swz = sb ^ (((sb >> 9) & 1) << 5); R = (st >> 1) * 16 + swz / 64; C = (st & 1) * 32 + (swz % 64) / 2; }
__host__ __device__ __forceinline__ int perm32(int rho) { const int n = rho >> 4, i = rho & 15; return 8 * (i >> 2) + 4 * n + (i & 3); }

struct Unit { int pm, pn; unsigned aoff, boff; };
struct Gemm { const bf16_t* A; const bf16_t* Bt; int K, lda, ldb; };

struct StaticOrder {
    int nM, nN, nwg, G, c, lda, ldb, bbatch;
    __host__ __device__ void init(int M, int N, int G_, int c_, int lda_, int ldb_, int bbatch_ = 0) { nM = M / BM; nN = N / BM; nwg = nM * nN; G = G_; c = c_; lda = lda_; ldb = ldb_; bbatch = bbatch_; }
    __host__ __device__ bool next(int i, Unit& u) const {
        const long L = (long)i * G + c; if (L >= nwg) return false;
        int wgid = (int)L; { const int q = nwg / NXCD, r = nwg % NXCD, xcd = wgid % NXCD, off = wgid / NXCD; wgid = (xcd < r ? xcd * (q + 1) : r * (q + 1) + (xcd - r) * q) + off; }
        const int nig = WGM * nN, gid = wgid / nig, fm = gid * WGM, gsz = (nM - fm) < WGM ? (nM - fm) : WGM;
        u.pm = fm + ((wgid % nig) % gsz); u.pn = (wgid % nig) / gsz;
        u.aoff = (unsigned)u.pm * (unsigned)(BM * lda); u.boff = ((unsigned)u.pn * BM + (unsigned)(u.pm >> 3) * (unsigned)bbatch) * (unsigned)ldb; return true;
    }
    __device__ __forceinline__ void a_ready(const Unit&) const {}
    __device__ __forceinline__ void done(const Unit&) const {}
};

typedef _Float16 h16x8 __attribute__((ext_vector_type(8))); typedef _Float16 h16x2 __attribute__((ext_vector_type(2))); typedef float f32x2c __attribute__((ext_vector_type(2)));
__device__ __forceinline__ unsigned cvt_pk_bf16(float lo, float hi) { const f32x2c v = {lo, hi}; const h16x2 h = __builtin_convertvector(v, h16x2); return __builtin_bit_cast(unsigned, h); }
typedef float f32x2 __attribute__((ext_vector_type(2)));
__device__ __forceinline__ f32x2 gelu_pk(f32x2 v) {
    const f32x2 av = __builtin_elementwise_abs(v), d = av * 0.2316418882f + 1.0f;
    f32x2 t; t.x = __builtin_amdgcn_rcpf(d.x); t.y = __builtin_amdgcn_rcpf(d.y);
    f32x2 q = t * 0.5307027145f + (-0.7265760135f); q = q * t + 0.7107068705f; q = q * t + (-0.142248368f); q = q * t + 0.127414796f; q = q * t;
    const f32x2 s = (v * v) * (-0.72134752044f);
    f32x2 e; e.x = __builtin_amdgcn_exp2f(s.x); e.y = __builtin_amdgcn_exp2f(s.y);
    const f32x2 m = v * (q * e), r = v - m;
    f32x2 o; o.x = v.x < 0.f ? m.x : r.x; o.y = v.y < 0.f ? m.y : r.y; return o;
}


constexpr int RM = 32768;
constexpr float EPS_ = 1e-6f, LOG2E_ = 1.4426950408889634f;
__device__ __forceinline__ float sigm(float x) { return __builtin_amdgcn_rcpf(1.0f + __builtin_amdgcn_exp2f(-x * LOG2E_)); }
__device__ __forceinline__ float silu_(float x) { return x * sigm(x); }
__device__ __forceinline__ u32x4 pack8(const f32x4 a, const f32x4 b) { u32x4 w; w.x = cvt_pk_bf16(a[0], a[1]); w.y = cvt_pk_bf16(a[2], a[3]); w.z = cvt_pk_bf16(b[0], b[1]); w.w = cvt_pk_bf16(b[2], b[3]); return w; }
__device__ __forceinline__ void row_scales(const float* ssq, int pm, int wr, int lane, float (&v)[2]) {
#pragma unroll
    for (int ai = 0; ai < 2; ++ai) v[ai] = 1.0f / sqrtf(ssq[pm * BM + ai * HALF + wr * 64 + lane] * (1.0f / 1024.0f) + EPS_);
}
#define ROWSCALE(ai, m) __shfl(rv[ai], 16 * (m) + fr)
#define ROWFENCE() asm volatile("" ::: "memory")
struct EpiIn0 {
    static constexpr bool PERM = true, AFTER_DRAIN = false;
    bf16_t* P; const float* ssq; const float* lb;
    __device__ __forceinline__ void operator()(const f32x4 (&acc)[2][2][4][2], const Unit& u, int wr, int wc, int fr, int fq) const {
        float rv[2]; row_scales(ssq, u.pm, wr, fq * 16 + fr, rv);
        const int row0 = u.pm * BM + wr * 64 + fr, pn = u.pn;
        if (pn < 8) {
            const int typ = pn >> 1;
#pragma unroll
            for (int bj = 0; bj < 2; ++bj) { const int col0 = pn * BM + bj * HALF + wc * 32 + 8 * fq;
                f32x4 l0 = (f32x4){0.f, 0.f, 0.f, 0.f}, l1 = l0;
                if (typ == 1) { l0 = 1.0f - *(const f32x4*)(lb + col0 - 512); l1 = 1.0f - *(const f32x4*)(lb + col0 - 508); }
#pragma unroll
                for (int ai = 0; ai < 2; ++ai)
#pragma unroll
                    for (int m = 0; m < 4; ++m) { const float r = ROWSCALE(ai, m); f32x4 v0 = acc[ai][bj][m][0] * r, v1 = acc[ai][bj][m][1] * r;
                        if (typ == 0 || typ == 3) {
#pragma unroll
                            for (int i = 0; i < 4; ++i) { v0[i] = silu_(v0[i]); v1[i] = silu_(v1[i]); } }
                        else if (typ == 1) {
#pragma unroll
                            for (int i = 0; i < 4; ++i) { v0[i] = l0[i] * sigm(-v0[i]); v1[i] = l1[i] * sigm(-v1[i]); } }
                        *(u32x4*)(P + (size_t)(row0 + ai * HALF + m * 16) * 2560 + col0) = pack8(v0, v1); ROWFENCE(); } }
        } else {
            const int col0 = 2048 + (pn - 8) * HALF + wc * 32 + 8 * fq;
#pragma unroll
            for (int ai = 0; ai < 2; ++ai)
#pragma unroll
                for (int m = 0; m < 4; ++m) { const float r = ROWSCALE(ai, m); f32x4 v0, v1;
#pragma unroll
                    for (int i = 0; i < 4; ++i) { v0[i] = (acc[ai][0][m][0][i] * r) * sigm(acc[ai][1][m][0][i] * r); v1[i] = (acc[ai][0][m][1][i] * r) * sigm(acc[ai][1][m][1][i] * r); }
                    *(u32x4*)(P + (size_t)(row0 + ai * HALF + m * 16) * 2560 + col0) = pack8(v0, v1); ROWFENCE(); }
        }
    }
};
struct EpiIn1 {
    static constexpr bool PERM = true, AFTER_DRAIN = false;
    bf16_t* P; const float* ssq; float* kpart; float qscale;
    __device__ __forceinline__ void operator()(const f32x4 (&acc)[2][2][4][2], const Unit& u, int wr, int wc, int fr, int fq) const {
        float rv[2]; row_scales(ssq, u.pm, wr, fq * 16 + fr, rv);
        const int row0 = u.pm * BM + wr * 64 + fr, pn = u.pn;
        const int typ = pn < 2 ? 0 : (pn < 4 ? 1 : (pn < 6 ? 2 : 3));
#pragma unroll
        for (int bj = 0; bj < 2; ++bj) { const int col0 = pn * BM + bj * HALF + wc * 32 + 8 * fq;
            f32x4 cs0 = (f32x4){0.f, 0.f, 0.f, 0.f}, cs1 = cs0;
#pragma unroll
            for (int ai = 0; ai < 2; ++ai)
#pragma unroll
                for (int m = 0; m < 4; ++m) { const float r = ROWSCALE(ai, m); f32x4 v0 = acc[ai][bj][m][0] * r, v1 = acc[ai][bj][m][1] * r;
                    if (typ == 0) { v0 = v0 * qscale; v1 = v1 * qscale; }
                    else if (typ == 1) { cs0 += v0; cs1 += v1; }
                    else if (typ == 3) { f32x2 a = gelu_pk((f32x2){v0[0], v0[1]}), b = gelu_pk((f32x2){v0[2], v0[3]}), c = gelu_pk((f32x2){v1[0], v1[1]}), d = gelu_pk((f32x2){v1[2], v1[3]});
                        v0 = (f32x4){a.x, a.y, b.x, b.y}; v1 = (f32x4){c.x, c.y, d.x, d.y}; }
                    *(u32x4*)(P + (size_t)(row0 + ai * HALF + m * 16) * 2560 + col0) = pack8(v0, v1); ROWFENCE(); }
            if (typ == 1) {
#pragma unroll
                for (int i = 0; i < 4; ++i) {
#pragma unroll
                    for (int o = 1; o < 16; o <<= 1) { cs0[i] += __shfl_xor(cs0[i], o); cs1[i] += __shfl_xor(cs1[i], o); } }
                if (fr == 0) { float* kp = kpart + (size_t)(u.pm * 2 + wr) * 512 + (col0 - 512); *(f32x4*)kp = cs0; *(f32x4*)(kp + 4) = cs1; }
            } }
    }
};
struct EpiRes {
    static constexpr bool PERM = true, AFTER_DRAIN = false;
    bf16_t* xb; float* outf; float* ssqw;
    __device__ __forceinline__ void operator()(const f32x4 (&acc)[2][2][4][2], const Unit& u, int wr, int wc, int fr, int fq) const {
        const int row0 = u.pm * BM + wr * 64 + fr;
#pragma unroll
        for (int ai = 0; ai < 2; ++ai)
#pragma unroll
            for (int m = 0; m < 4; ++m) { const int row = row0 + ai * HALF + m * 16; float ss = 0.f;
#pragma unroll
                for (int bj = 0; bj < 2; ++bj) { const size_t off = (size_t)row * 1024 + u.pn * BM + bj * HALF + wc * 32 + 8 * fq;
                    const u32x4 b = *(const u32x4*)(xb + off);
                    const h16x8 bh = __builtin_bit_cast(h16x8, b);
                    const f32x4 b0 = (f32x4){(float)bh[0], (float)bh[1], (float)bh[2], (float)bh[3]};
                    const f32x4 b1 = (f32x4){(float)bh[4], (float)bh[5], (float)bh[6], (float)bh[7]};
                    const f32x4 v0 = b0 + acc[ai][bj][m][0], v1 = b1 + acc[ai][bj][m][1];
                    ss += (v0[0] * v0[0] + v0[1] * v0[1]) + (v0[2] * v0[2] + v0[3] * v0[3]) + (v1[0] * v1[0] + v1[1] * v1[1]) + (v1[2] * v1[2] + v1[3] * v1[3]);
                    if (outf) { *(f32x4*)(outf + off) = v0; *(f32x4*)(outf + off + 4) = v1; }
                    else *(u32x4*)(xb + off) = pack8(v0, v1); }
                ss += __shfl_xor(ss, 16); ss += __shfl_xor(ss, 32);
                if (fq == 0) atomicAdd(ssqw + row, ss);
                ROWFENCE(); }
    }
};
struct EpiFfn {
    static constexpr bool PERM = true, AFTER_DRAIN = false;
    bf16_t* H; const float* ssq;
    __device__ __forceinline__ void operator()(const f32x4 (&acc)[2][2][4][2], const Unit& u, int wr, int wc, int fr, int fq) const {
        float rv[2]; row_scales(ssq, u.pm, wr, fq * 16 + fr, rv);
        const int row0 = u.pm * BM + wr * 64 + fr, col0 = u.pn * HALF + wc * 32 + 8 * fq;
#pragma unroll
        for (int ai = 0; ai < 2; ++ai)
#pragma unroll
            for (int m = 0; m < 4; ++m) { const float r = ROWSCALE(ai, m); f32x4 v0, v1;
#pragma unroll
                for (int i = 0; i < 4; ++i) { v0[i] = silu_(acc[ai][0][m][0][i] * r) * (acc[ai][1][m][0][i] * r); v1[i] = silu_(acc[ai][0][m][1][i] * r) * (acc[ai][1][m][1][i] * r); }
                *(u32x4*)(H + (size_t)(row0 + ai * HALF + m * 16) * 2816 + col0) = pack8(v0, v1); ROWFENCE(); }
    }
};
struct SubOrder {
    int G, c, mode;
    __device__ __forceinline__ bool next(int i, Unit& u) const {
        const int L = i * G + c; if (L >= 256) return false;
        const unsigned b = L >> 4, h = (L >> 2) & 3, t = L & 3; u.pm = L; u.pn = 0;
        const unsigned x = (b * 256u) * 1024u + h * 256u, y = (t * 256u) * 1024u + h * 256u;
        u.aoff = mode == 0 ? x : y; u.boff = mode == 0 ? y : x; return true;
    }
    __device__ __forceinline__ void a_ready(const Unit&) const {}
    __device__ __forceinline__ void done(const Unit&) const {}
};
struct EpiSub {
    static constexpr bool PERM = true, AFTER_DRAIN = false;
    bf16_t* O; int mode;
    __device__ __forceinline__ void operator()(const f32x4 (&acc)[2][2][4][2], const Unit& u, int wr, int wc, int fr, int fq) const {
        const int L = u.pm, b = L >> 4, h = (L >> 2) & 3, t = L & 3;
        const int rb = b * 1024 + (mode == 0 ? h : t) * 256 + wr * 64 + fr, cb = (mode == 0 ? t : h) * 256 + wc * 32 + 8 * fq;
#pragma unroll
        for (int ai = 0; ai < 2; ++ai)
#pragma unroll
            for (int m = 0; m < 4; ++m)
#pragma unroll
                for (int bj = 0; bj < 2; ++bj) *(u32x4*)(O + (size_t)(rb + ai * HALF + m * 16) * 1024 + cb + bj * HALF) = pack8(acc[ai][bj][m][0], acc[ai][bj][m][1]);
    }
};
struct EpiSoftmax {
    static constexpr bool PERM = true, AFTER_DRAIN = false;
    bf16_t* P; const float* ssq; PG8_LAS float* scr;
    __device__ __forceinline__ void operator()(f32x4 (&acc)[2][2][4][2], const Unit& u, int wr, int wc, int fr, int fq) const {
        float rv[2]; row_scales(ssq, u.pm, wr, fq * 16 + fr, rv);
        PG8_LAS float* MX = scr; PG8_LAS float* SM = scr + 1024;
        float mx[2][4];
#pragma unroll
        for (int ai = 0; ai < 2; ++ai)
#pragma unroll
            for (int m = 0; m < 4; ++m) { const float r = ROWSCALE(ai, m); float v = -3.0e38f;
#pragma unroll
                for (int bj = 0; bj < 2; ++bj)
#pragma unroll
                    for (int n = 0; n < 2; ++n) { acc[ai][bj][m][n] = acc[ai][bj][m][n] * r; const f32x4 x = acc[ai][bj][m][n]; v = fmaxf(v, fmaxf(fmaxf(x[0], x[1]), fmaxf(x[2], x[3]))); }
                v = fmaxf(v, __shfl_xor(v, 16)); v = fmaxf(v, __shfl_xor(v, 32));
                if (fq == 0) MX[(ai * HALF + wr * 64 + m * 16 + fr) * 4 + wc] = v; }
        asm volatile("s_waitcnt lgkmcnt(0)" ::: "memory"); __builtin_amdgcn_s_barrier(); asm volatile("" ::: "memory");
#pragma unroll
        for (int ai = 0; ai < 2; ++ai)
#pragma unroll
            for (int m = 0; m < 4; ++m) { const f32x4 q = *(const PG8_LAS f32x4*)(MX + (ai * HALF + wr * 64 + m * 16 + fr) * 4); const float mm = fmaxf(fmaxf(q[0], q[1]), fmaxf(q[2], q[3])); float sm = 0.f;
#pragma unroll
                for (int bj = 0; bj < 2; ++bj)
#pragma unroll
                    for (int n = 0; n < 2; ++n) { f32x4 x = acc[ai][bj][m][n];
#pragma unroll
                        for (int i = 0; i < 4; ++i) { x[i] = __builtin_amdgcn_exp2f(x[i] - mm); sm += x[i]; }
                        acc[ai][bj][m][n] = x; }
                sm += __shfl_xor(sm, 16); sm += __shfl_xor(sm, 32);
                if (fq == 0) SM[(ai * HALF + wr * 64 + m * 16 + fr) * 4 + wc] = sm; }
        asm volatile("s_waitcnt lgkmcnt(0)" ::: "memory"); __builtin_amdgcn_s_barrier(); asm volatile("" ::: "memory");
        const int row0 = u.pm * BM + wr * 64 + fr;
#pragma unroll
        for (int ai = 0; ai < 2; ++ai)
#pragma unroll
            for (int m = 0; m < 4; ++m) { const f32x4 q = *(const PG8_LAS f32x4*)(SM + (ai * HALF + wr * 64 + m * 16 + fr) * 4); const float inv = __builtin_amdgcn_rcpf((q[0] + q[1]) + (q[2] + q[3]));
#pragma unroll
                for (int bj = 0; bj < 2; ++bj) *(u32x4*)(P + (size_t)(row0 + ai * HALF + m * 16) * 1024 + u.pn * BM + bj * HALF + wc * 32 + 8 * fq) = pack8(acc[ai][bj][m][0] * inv, acc[ai][bj][m][1] * inv);
                ROWFENCE(); }
    }
};
struct EpiK {
    static constexpr bool PERM = true, AFTER_DRAIN = false;
    bf16_t* O; const float* rmem;
    __device__ __forceinline__ void operator()(const f32x4 (&acc)[2][2][4][2], const Unit& u, int wr, int wc, int fr, int fq) const {
        const int row0 = u.pm * BM + wr * 64 + fr;
#pragma unroll
        for (int ai = 0; ai < 2; ++ai)
#pragma unroll
            for (int m = 0; m < 4; ++m) { const int row = row0 + ai * HALF + m * 16; const float r = rmem[row];
#pragma unroll
                for (int bj = 0; bj < 2; ++bj) *(u32x4*)(O + (size_t)row * 1024 + u.pn * BM + bj * HALF + wc * 32 + 8 * fq) = pack8(acc[ai][bj][m][0] * r, acc[ai][bj][m][1] * r); }
    }
};
template <class Epi, class Sched, bool ALIGN_EPI = false, bool SP2 = false>
__device__ __forceinline__ void gemm_phase(PG8_LAS unsigned char* lds, const Gemm g, const Sched& S, const Epi& E) {
    int tid_ = threadIdx.x; asm volatile("" : "+v"(tid_));
    const int tid = tid_, wid = __builtin_amdgcn_readfirstlane(tid >> 6), lane = tid & 63, wr = wid >> 2, wc = wid & 3, fr = lane & 15, fq = lane >> 4;
    const int K = g.K, nt = K / BK;
    unsigned voffA[2], voffB[2];
#pragma unroll
    for (int i = 0; i < 2; ++i) { int R, C; stage_rc(tid * 16 + i * 8192, R, C); const int Rb = Epi::PERM ? ((R & ~31) + perm32(R & 31)) : R;
        voffA[i] = (unsigned)(R * g.lda + C) * 2u; voffB[i] = (unsigned)(Rb * g.ldb + C) * 2u; }
    const size_t kstep = (size_t)(BK * 2);
    const size_t hstepA = (size_t)HALF * g.lda * 2, hstepB = (size_t)HALF * g.ldb * 2;
    const unsigned ldsw = (unsigned)wid * 1024u;
    const int aoff = lds_byte(wr * 64 + fr, fq * 8), boff = lds_byte(wc * 32 + fr, fq * 8);
#define PG8_SA(b, h) (((b) * 2 + (h)) * HTB)
#define PG8_SB(b, h) ((4 + (b) * 2 + (h)) * HTB)
#define PG8_STAGE(bufoff, gbase, voff) do { _Pragma("unroll") for (int _i = 0; _i < 2; ++_i) \
        __builtin_amdgcn_global_load_lds((const unsigned*)((const char*)(gbase) + (voff)[_i]), (PG8_LAS unsigned*)(lds + (bufoff) + ldsw + _i * 8192), 16, 0, 0); } while (0)
#define PG8_LDA(dst, b, h) do { _Pragma("unroll") for (int m = 0; m < 4; ++m) _Pragma("unroll") for (int k = 0; k < 2; ++k) dst[m][k] = *(const PG8_LAS bf16x8*)(lds + PG8_SA(b, h) + aoff + m * 2048 + k * 1024); } while (0)
#define PG8_LDB(dst, b, h) do { _Pragma("unroll") for (int n = 0; n < 2; ++n) _Pragma("unroll") for (int k = 0; k < 2; ++k) dst[n][k] = *(const PG8_LAS bf16x8*)(lds + PG8_SB(b, h) + boff + n * 2048 + k * 1024); } while (0)
#define PG8_MMA(ai, bj, At, Bt) do { __builtin_amdgcn_s_setprio(1); _Pragma("unroll") for (int m = 0; m < 4; ++m) _Pragma("unroll") for (int n = 0; n < 2; ++n) _Pragma("unroll") for (int k = 0; k < 2; ++k) \
        acc[ai][bj][m][n] = __builtin_amdgcn_mfma_f32_16x16x32_f16(__builtin_bit_cast(h16x8, Bt[n][k]), __builtin_bit_cast(h16x8, At[m][k]), acc[ai][bj][m][n], 0, 0, 0); __builtin_amdgcn_s_setprio(0); } while (0)
#define PG8_WAIT_V(n) asm volatile("s_waitcnt vmcnt(" #n ")" ::: "memory")
#define PG8_WAIT_L(n) asm volatile("s_waitcnt lgkmcnt(" #n ")" ::: "memory")
#define PG8_BAR __builtin_amdgcn_s_barrier()
#define PG8_SCHED __builtin_amdgcn_sched_barrier(0)
    Unit cur, nxt; int ui = 0;
    if (!S.next(0, cur)) return;
    f32x4 acc[2][2][4][2];
#pragma unroll
    for (int a = 0; a < 2; ++a)
#pragma unroll
        for (int b = 0; b < 2; ++b)
#pragma unroll
            for (int m = 0; m < 4; ++m)
#pragma unroll
                for (int n = 0; n < 2; ++n) acc[a][b][m][n] = (f32x4){0.f, 0.f, 0.f, 0.f};
    bf16x8 At[4][2], B0[2][2], B1[2][2];
    const char* cA = (const char*)g.A + (size_t)cur.aoff * 2; const char* cB = (const char*)g.Bt + (size_t)cur.boff * 2;
    S.a_ready(cur);
    if constexpr (SP2) {
        PG8_STAGE(PG8_SB(0, 0), cB, voffB); PG8_STAGE(PG8_SB(0, 1), cB + hstepB, voffB); PG8_STAGE(PG8_SA(0, 0), cA, voffA); PG8_STAGE(PG8_SA(0, 1), cA + hstepA, voffA);
        if (wr == 1) PG8_BAR;
        PG8_WAIT_V(2); PG8_BAR;
        PG8_STAGE(PG8_SB(1, 0), cB + kstep, voffB); PG8_STAGE(PG8_SA(1, 0), cA + kstep, voffA); PG8_STAGE(PG8_SB(1, 1), cB + hstepB + kstep, voffB);
        PG8_WAIT_V(6); PG8_BAR;
    } else {
        PG8_STAGE(PG8_SB(0, 0), cB, voffB); PG8_STAGE(PG8_SA(0, 0), cA, voffA); PG8_STAGE(PG8_SB(0, 1), cB + hstepB, voffB); PG8_STAGE(PG8_SA(0, 1), cA + hstepA, voffA);
        if (wr == 1) PG8_BAR;
        PG8_WAIT_V(4); PG8_BAR;
        PG8_STAGE(PG8_SB(1, 0), cB + kstep, voffB); PG8_STAGE(PG8_SA(1, 0), cA + kstep, voffA); PG8_STAGE(PG8_SB(1, 1), cB + hstepB + kstep, voffB);
        PG8_WAIT_V(6); PG8_BAR;
    }
    for (;;) {
        const bool has_next = S.next(ui + 1, nxt);
        const char* nA = has_next ? (const char*)g.A + (size_t)nxt.aoff * 2 : cA; const char* nB = has_next ? (const char*)g.Bt + (size_t)nxt.boff * 2 : cB;
        for (int t = 0; t < nt; t += 2) {
            const bool last = (t == nt - 2);
            const char* a1 = cA + (size_t)(t + 1) * kstep;
            const char* a2 = last ? nA : cA + (size_t)(t + 2) * kstep; const char* b2 = last ? nB : cB + (size_t)(t + 2) * kstep;
            const char* a3 = a2 + kstep; const char* b3 = b2 + kstep;
            if (last && has_next) S.a_ready(nxt);
            if constexpr (SP2) {
            PG8_LDB(B0, 0, 0); PG8_LDB(B1, 0, 1); PG8_SCHED; PG8_LDA(At, 0, 0); PG8_STAGE(PG8_SA(1, 1), a1 + hstepA, voffA);
            PG8_WAIT_V(8); PG8_WAIT_L(0); PG8_BAR; PG8_MMA(0, 0, At, B0); PG8_MMA(0, 1, At, B1); PG8_BAR; PG8_SCHED;
            PG8_LDA(At, 0, 1); PG8_STAGE(PG8_SB(0, 0), b2, voffB); PG8_STAGE(PG8_SB(0, 1), b2 + hstepB, voffB); PG8_STAGE(PG8_SA(0, 0), a2, voffA);
            PG8_WAIT_V(8); PG8_WAIT_L(0); PG8_BAR; PG8_MMA(1, 0, At, B0); PG8_MMA(1, 1, At, B1); PG8_BAR; PG8_SCHED;
            PG8_LDB(B0, 1, 0); PG8_LDB(B1, 1, 1); PG8_SCHED; PG8_LDA(At, 1, 0); PG8_STAGE(PG8_SA(0, 1), a2 + hstepA, voffA);
            PG8_WAIT_V(8); PG8_WAIT_L(0); PG8_BAR; PG8_MMA(0, 0, At, B0); PG8_MMA(0, 1, At, B1); PG8_BAR; PG8_SCHED;
            PG8_LDA(At, 1, 1); PG8_STAGE(PG8_SB(1, 0), b3, voffB); PG8_STAGE(PG8_SB(1, 1), b3 + hstepB, voffB); PG8_STAGE(PG8_SA(1, 0), a3, voffA);
            PG8_WAIT_V(8); PG8_WAIT_L(0); PG8_BAR; PG8_MMA(1, 0, At, B0); PG8_MMA(1, 1, At, B1); PG8_BAR; PG8_SCHED;
            } else {
            PG8_LDB(B0, 0, 0); PG8_SCHED; PG8_LDA(At, 0, 0); PG8_STAGE(PG8_SA(1, 1), a1 + hstepA, voffA);
            PG8_WAIT_L(8); PG8_BAR; PG8_WAIT_L(0); PG8_MMA(0, 0, At, B0); PG8_BAR; PG8_SCHED;
            PG8_LDB(B1, 0, 1); PG8_STAGE(PG8_SB(0, 0), b2, voffB);
            PG8_BAR; PG8_WAIT_L(0); PG8_MMA(0, 1, At, B1); PG8_BAR;
            PG8_LDA(At, 0, 1); PG8_STAGE(PG8_SA(0, 0), a2, voffA);
            PG8_BAR; PG8_WAIT_L(0); PG8_MMA(1, 0, At, B0); PG8_BAR; PG8_SCHED;
            PG8_STAGE(PG8_SB(0, 1), b2 + hstepB, voffB);
            PG8_WAIT_V(6); PG8_BAR; PG8_MMA(1, 1, At, B1); PG8_BAR;
            PG8_LDB(B0, 1, 0); PG8_SCHED; PG8_LDA(At, 1, 0); PG8_STAGE(PG8_SA(0, 1), a2 + hstepA, voffA);
            PG8_WAIT_L(8); PG8_BAR; PG8_WAIT_L(0); PG8_MMA(0, 0, At, B0); PG8_BAR; PG8_SCHED;
            PG8_LDB(B1, 1, 1); PG8_STAGE(PG8_SB(1, 0), b3, voffB);
            PG8_BAR; PG8_WAIT_L(0); PG8_MMA(0, 1, At, B1); PG8_BAR;
            PG8_LDA(At, 1, 1); PG8_STAGE(PG8_SA(1, 0), a3, voffA);
            PG8_BAR; PG8_WAIT_L(0); PG8_MMA(1, 0, At, B0); PG8_BAR; PG8_SCHED;
            PG8_STAGE(PG8_SB(1, 1), b3 + hstepB, voffB);
            PG8_WAIT_V(6); PG8_BAR; PG8_MMA(1, 1, At, B1); PG8_BAR;
            }
        }
        if constexpr (ALIGN_EPI) { if (wr == 0) PG8_BAR; }
        if constexpr (!Epi::AFTER_DRAIN) { E(acc, cur, wr, wc, fr, fq); S.done(cur); }
        if (!has_next) break;
#pragma unroll
        for (int a = 0; a < 2; ++a)
#pragma unroll
            for (int b = 0; b < 2; ++b)
#pragma unroll
                for (int m = 0; m < 4; ++m)
#pragma unroll
                    for (int n = 0; n < 2; ++n) acc[a][b][m][n] = (f32x4){0.f, 0.f, 0.f, 0.f};
        cur = nxt; cA = nA; cB = nB; ++ui;
        if constexpr (ALIGN_EPI) { if (wr == 1) PG8_BAR; }
    }
    PG8_WAIT_V(0);
    if constexpr (!ALIGN_EPI) { if (wr == 0) PG8_BAR; }
    PG8_BAR;
    if constexpr (Epi::AFTER_DRAIN) { E.fused(acc, cur, wr, wc, fr, fq, lds, wid, lane); S.done(cur); }
#undef PG8_SA
#undef PG8_SB
#undef PG8_STAGE
#undef PG8_LDA
#undef PG8_LDB
#undef PG8_MMA
#undef PG8_WAIT_V
#undef PG8_WAIT_L
#undef PG8_BAR
#undef PG8_SCHED
}
}

constexpr int NWAVES = 8;
constexpr int BATCH = 16, SEQ = 2048, DM = 1024, MROWS = BATCH * SEQ, MEMLEN = 256, MMEM = BATCH * MEMLEN, FFH = 2816, PW = 2560;
constexpr float EPS = 1e-6f, LOG2E = 1.4426950408889634f;
constexpr float C2M = 0.125f * LOG2E;
constexpr float C2X = 0.0625f * LOG2E;
constexpr float NEGBIG = -1.0e30f;
constexpr int NPH = 16;
#ifndef MK_ONE_LAUNCH
#define MK_ONE_LAUNCH 1
#endif

constexpr size_t MiB = 1u << 20;
constexpr size_t WS_CTL = 0, CTL_ZERO_BYTES = 64 * 1024;
constexpr size_t WS_LB = 1 * MiB, WS_RMEM = 1 * MiB + 4096, WS_SGUW = 1 * MiB + 65536, WS_KPART = 1 * MiB + 512 * 1024;
constexpr size_t WS_SSQ = 2 * MiB;
constexpr size_t WS_WIN0 = 4 * MiB, WS_WOUT0 = 10 * MiB, WS_WIN1 = 12 * MiB, WS_WOUT1 = 17 * MiB, WS_WQ = 19 * MiB, WS_WO = 23 * MiB, WS_WK = 27 * MiB, WS_WV = 31 * MiB,
                 WS_WFI = 35 * MiB, WS_WFO = 57 * MiB;
constexpr size_t WS_MEMB = 68 * MiB, WS_KB = 76 * MiB, WS_VT = 92 * MiB;
constexpr size_t WS_XB = 112 * MiB, WS_BIG = 176 * MiB, WS_MIX = 352 * MiB, WS_QO = 416 * MiB, WS_END = 480 * MiB;
constexpr int CW_BAR = 1024;

constexpr int RING_BYTES = 131072, LDS_BYTES = 147456, LDSCTL_OFF = LDS_BYTES - 512, MISC_OFF = LDSCTL_OFF;

#define GAS __attribute__((address_space(1)))
#define LAS __attribute__((address_space(3)))
typedef unsigned short bf16;
typedef unsigned v4u __attribute__((ext_vector_type(4)));
typedef unsigned v2u __attribute__((ext_vector_type(2)));
typedef float f32x4 __attribute__((ext_vector_type(4)));
typedef float f32x16 __attribute__((ext_vector_type(16)));
typedef short bf16x8 __attribute__((ext_vector_type(8)));
typedef short s16x4 __attribute__((ext_vector_type(4)));
typedef GAS unsigned gu32;
#define LDS_WAIT() asm volatile("s_waitcnt lgkmcnt(0)" ::: "memory")
#define VM_WAIT() asm volatile("s_waitcnt vmcnt(0)" ::: "memory")
__device__ __forceinline__ float bf2f(unsigned short b) { return __uint_as_float(((unsigned)b) << 16); }
__device__ __forceinline__ float bflo(unsigned w) { return __uint_as_float(w << 16); }
__device__ __forceinline__ float bfhi(unsigned w) { return __uint_as_float(w & 0xffff0000u); }
typedef float f32x2_t __attribute__((ext_vector_type(2))); typedef __bf16 bf16x2_t __attribute__((ext_vector_type(2)));
__device__ __forceinline__ unsigned pk2(float lo, float hi) { f32x2_t v = {lo, hi}; bf16x2_t b = __builtin_convertvector(v, bf16x2_t); return __builtin_bit_cast(unsigned, b); }
typedef _Float16 h16x8 __attribute__((ext_vector_type(8))); typedef _Float16 h16x2 __attribute__((ext_vector_type(2)));
__device__ __forceinline__ unsigned pk2h(float lo, float hi) { f32x2_t v = {lo, hi}; h16x2 h = __builtin_convertvector(v, h16x2); return __builtin_bit_cast(unsigned, h); }
__device__ __forceinline__ float h2f(unsigned short b) { return (float)__builtin_bit_cast(_Float16, b); }
__device__ __forceinline__ float hlo(unsigned w) { return (float)__builtin_bit_cast(h16x2, w)[0]; }
__device__ __forceinline__ float hhi(unsigned w) { return (float)__builtin_bit_cast(h16x2, w)[1]; }
__device__ __forceinline__ float fexp2(float x) { return __builtin_amdgcn_exp2f(x); }
__device__ __forceinline__ float fexp(float x) { return __builtin_amdgcn_exp2f(x * LOG2E); }
__device__ __forceinline__ float sigm(float x) { return __builtin_amdgcn_rcpf(1.0f + __builtin_amdgcn_exp2f(-x * LOG2E)); }
__device__ __forceinline__ float wave_sum(float v) {
#pragma unroll
    for (int o = 1; o < 64; o <<= 1) v += __shfl_xor(v, o);
    return v;
}
#define MFMA32(a, b, c) __builtin_amdgcn_mfma_f32_32x32x16_bf16((a), (b), (c), 0, 0, 0)
#define MFMA32H(a, b, c) __builtin_amdgcn_mfma_f32_32x32x16_f16(__builtin_bit_cast(h16x8, (a)), __builtin_bit_cast(h16x8, (b)), (c), 0, 0, 0)
__device__ __forceinline__ bf16x8 ldsfrag(const LAS unsigned char* p) { return *(const LAS bf16x8*)p; }
__device__ __forceinline__ bf16x8 ldsfrag2(const LAS unsigned char* p0, const LAS unsigned char* p1) {
    const s16x4 lo = *(const LAS s16x4*)p0, hi = *(const LAS s16x4*)p1;
    return (bf16x8){lo[0], lo[1], lo[2], lo[3], hi[0], hi[1], hi[2], hi[3]};
}
__device__ __forceinline__ bf16x8 packfrag(const f32x16& p, int s2) {
    v4u w; w.x = pk2h(p[8 * s2 + 0], p[8 * s2 + 1]); w.y = pk2h(p[8 * s2 + 2], p[8 * s2 + 3]); w.z = pk2h(p[8 * s2 + 4], p[8 * s2 + 5]); w.w = pk2h(p[8 * s2 + 6], p[8 * s2 + 7]);
    return __builtin_bit_cast(bf16x8, w);
}
template <int NKS> __device__ __forceinline__ void mma_lds(f32x16& acc, const LAS unsigned char* pa, const LAS unsigned char* pb) {
    bf16x8 fa[NKS], fb[NKS];
#pragma unroll
    for (int ks = 0; ks < NKS; ++ks) { fa[ks] = ldsfrag(pa + ks * 32); fb[ks] = ldsfrag(pb + ks * 32); }
#pragma unroll
    for (int ks = 0; ks < NKS; ++ks) acc = MFMA32(fa[ks], fb[ks], acc);
}
#define XB_TMO      128
#define XB_XCNT(j)  (256  + 64 * (j))
#define XB_XSUB(j)  (1280 + 64 * (j))
#define XB_XGEN(j)  (2304 + 64 * (j))
#define XB_TOP      3328
#define XB_TOPGEN   3392
#define XCD_BAR_WORDS 3456
#define XB_SPIN_CAP (1u << 18)

__device__ __forceinline__ unsigned xb_ld(unsigned* p)              { return __hip_atomic_load(p, __ATOMIC_RELAXED, __HIP_MEMORY_SCOPE_AGENT); }
__device__ __forceinline__ unsigned xb_add(unsigned* p, unsigned v) { return __hip_atomic_fetch_add(p, v, __ATOMIC_RELAXED, __HIP_MEMORY_SCOPE_AGENT); }
__device__ __forceinline__ unsigned xb_xcc_id() { return (unsigned)__builtin_amdgcn_s_getreg((3 << 11) | 20) & 0xFu; }
#define XB_SPIN(cond, bar) do { unsigned _sp = 0; while (cond) { __builtin_amdgcn_s_sleep(1); \
    if ((++_sp & 255u) == 0u) { if (xb_ld(&(bar)[XB_TMO])) break; if (_sp > XB_SPIN_CAP) { atomicAdd(&(bar)[XB_TMO], 1u); break; } } } } while (0)

struct XcdBarrier {
    unsigned* bar; unsigned x;
    volatile LAS unsigned* st;
};

__device__ __forceinline__ XcdBarrier xcd_barrier_post(unsigned* bar, volatile LAS unsigned* st) {
    XcdBarrier b; b.bar = bar; b.x = xb_xcc_id(); b.st = st;
    if (threadIdx.x == 0) (void)xb_add(&bar[XB_XCNT(b.x)], 1u);
    return b;
}
__device__ __forceinline__ void xcd_barrier_complete(unsigned* bar, unsigned x, unsigned& nloc, unsigned& nx) {
    const unsigned G = gridDim.x * gridDim.y * gridDim.z;
    unsigned sum, cnt, mine, sp = 0u;
    for (;;) {
        sum = 0u; cnt = 0u; mine = 0u;
#pragma unroll
        for (unsigned j = 0; j < 16; ++j) { const unsigned c = xb_ld(&bar[XB_XCNT(j)]); sum += c; cnt += (c > 0u) ? 1u : 0u; mine = (j == x) ? c : mine; }
        if (sum == G) break;
        __builtin_amdgcn_s_sleep(1);
        if ((++sp & 255u) == 0u) { if (xb_ld(&bar[XB_TMO])) break; if (sp > XB_SPIN_CAP) { atomicAdd(&bar[XB_TMO], 1u); break; } }
    }
    nloc = mine > 0u ? mine : 1u; nx = cnt > 0u ? cnt : 1u;
}

__device__ __forceinline__ void xcd_barrier(const XcdBarrier& b) {
    asm volatile("s_waitcnt vmcnt(0)" ::: "memory");
    __syncthreads();
    if (threadIdx.x == 0) {
        unsigned* bar = b.bar;
        __builtin_amdgcn_s_waitcnt(0);
        unsigned nloc = b.st[0], nx = b.st[1];
        if (nloc == 0u) { xcd_barrier_complete(bar, b.x, nloc, nx); b.st[0] = nloc; b.st[1] = nx; }
        const unsigned old = xb_add(&bar[XB_XSUB(b.x)], 1u);
        const unsigned gen = old / nloc;
        if (old + 1u == (gen + 1u) * nloc) {
            __builtin_amdgcn_fence(__ATOMIC_RELEASE, "agent");
            asm volatile("s_waitcnt vmcnt(0)" ::: "memory");
            const unsigned og = xb_add(&bar[XB_TOP], 1u);
            const unsigned tg = og / nx;
            if (og + 1u == (tg + 1u) * nx) xb_add(&bar[XB_TOPGEN], 1u);
            else XB_SPIN(xb_ld(&bar[XB_TOPGEN]) == tg, bar);
            __builtin_amdgcn_fence(__ATOMIC_ACQUIRE, "agent");
            xb_add(&bar[XB_XGEN(b.x)], 1u);
            asm volatile("s_waitcnt vmcnt(0)" ::: "memory");
        } else {
            XB_SPIN(xb_ld(&bar[XB_XGEN(b.x)]) == gen, bar);
            __builtin_amdgcn_fence(__ATOMIC_ACQUIRE, "agent");
            asm volatile("s_waitcnt vmcnt(0)" ::: "memory");
        }
    }
    __syncthreads();
}

#define CAS __attribute__((address_space(4)))
struct Args { const float* in[26]; float* out; unsigned char* ws; int ph_lo, ph_hi; };
struct Frame {
    LAS unsigned char* lds;
    int tid, lane, wave, G, bid;
    const CAS struct Args* ka;
    float* out; unsigned char* ws;
};
#define WSP(T, off) ((T*)(F.ws + (off)))
#define WSPG(T, off) ((GAS T*)((GAS unsigned char*)F.ws + (off)))
#define INP(k) ((const GAS float*)F.ka->in[k])

__device__ __forceinline__ void tr_item(const GAS float* W, int ldw, int K, int scol0, int k0, GAS bf16* WT, int drow0, const GAS float* gain, LAS float* scr, int lane) {
    f32x4 v[8]; float gn[8];
#pragma unroll
    for (int i = 0; i < 8; ++i) { const int kk = 8 * i + (lane >> 3); v[i] = __builtin_nontemporal_load((const GAS f32x4*)(W + (size_t)(k0 + kk) * ldw + scol0 + 4 * (lane & 7))); gn[i] = gain ? gain[k0 + kk] : 1.0f; }
#pragma unroll
    for (int i = 0; i < 8; ++i) { const int kk = 8 * i + (lane >> 3); LAS float* d = scr + kk * 33 + 4 * (lane & 7);
        d[0] = v[i][0] * gn[i]; d[1] = v[i][1] * gn[i]; d[2] = v[i][2] * gn[i]; d[3] = v[i][3] * gn[i]; }
    LDS_WAIT(); asm volatile("" ::: "memory");
    const int c = lane & 7;
#pragma unroll
    for (int j = 0; j < 4; ++j) { const int n = (lane >> 3) + 8 * j; const LAS float* s = scr + (8 * c) * 33 + n;
        v4u o; o.x = pk2h(s[0 * 33], s[1 * 33]); o.y = pk2h(s[2 * 33], s[3 * 33]); o.z = pk2h(s[4 * 33], s[5 * 33]); o.w = pk2h(s[6 * 33], s[7 * 33]);
        *(GAS v4u*)(WT + (size_t)(drow0 + n) * K + k0 + 8 * c) = o; }
    LDS_WAIT(); asm volatile("" ::: "memory");
}
__device__ __forceinline__ bool tr_matrix(int& r, const GAS float* W, int ldw, int K, int N, int soff, int map, GAS bf16* WT, const GAS float* gain, LAS float* scr, int lane) {
    const int nblk = N / 32, cnt = (K / 64) * nblk;
    if (r >= cnt) { r -= cnt; return false; }
    const int kb = r / nblk, nb = r % nblk, d0 = 32 * nb; int sc = d0;
    if (map == 1 && d0 >= 2048) { const int q = d0 - 2048; sc = 2048 + ((q >> 7) & 1) * 512 + (q >> 8) * 128 + (q & 127); }
    if (map == 2) sc = ((d0 >> 7) & 1) * FFH + (d0 >> 8) * 128 + (d0 & 127);
    tr_item(W, ldw, K, soff + sc, 64 * kb, WT, d0, gain, scr, lane);
    return true;
}
__device__ __forceinline__ void convert_rest(Frame& F, int wi, int nw) {
    LAS float* scr = (LAS float*)(F.lds + F.wave * 16384);
    const int lane = F.lane;
    constexpr int NITEMS = 512 + 1280 + 512 + 2 * (512 + 2816 + 1408);
    for (int it = wi; it < NITEMS; it += nw) {
        int r = it;
        if (tr_matrix(r, INP(8), DM, DM, DM, 0, 0, WSPG(bf16, WS_WOUT0), nullptr, scr, lane)) continue;
        if (tr_matrix(r, INP(15), PW, DM, PW, 0, 0, WSPG(bf16, WS_WIN1), INP(2) + DM, scr, lane)) continue;
        if (tr_matrix(r, INP(16), DM, DM, DM, 0, 0, WSPG(bf16, WS_WOUT1), nullptr, scr, lane)) continue;
        bool done = false;
#pragma unroll
        for (int l = 0; l < 2; ++l) {
            if (done) break;
            if (tr_matrix(r, INP(23) + (size_t)l * DM * DM, DM, DM, DM, 0, 0, WSPG(bf16, WS_WO) + (size_t)l * DM * DM, nullptr, scr, lane)) { done = true; break; }
            if (tr_matrix(r, INP(24) + (size_t)l * DM * 2 * FFH, 2 * FFH, DM, 2 * FFH, 0, 2, WSPG(bf16, WS_WFI) + (size_t)l * DM * 2 * FFH, INP(4) + l * DM, scr, lane)) { done = true; break; }
            if (tr_matrix(r, INP(25) + (size_t)l * FFH * DM, DM, FFH, DM, 0, 0, WSPG(bf16, WS_WFO) + (size_t)l * FFH * DM, nullptr, scr, lane)) { done = true; break; }
        }
    }
    for (int it = wi; it < 2 * DM; it += nw) {
        const int l = it >> 10, i = it & (DM - 1);
        const float gsc = INP(3)[l * DM + i] * C2X;
        const GAS f32x4* xr = (const GAS f32x4*)(INP(21) + ((size_t)l * DM + i) * DM) + lane;
        GAS v2u* o8 = (GAS v2u*)(WSPG(bf16, WS_WQ) + ((size_t)l * DM + i) * DM) + lane;
#pragma unroll
        for (int j = 0; j < 4; ++j) { const f32x4 v = __builtin_nontemporal_load(xr + 64 * j) * gsc; v2u w; w.x = pk2h(v[0], v[1]); w.y = pk2h(v[2], v[3]); o8[64 * j] = w; }
    }
    __syncthreads();
}
__device__ __forceinline__ void p0_prologue(Frame& F) {
    LAS float* scr = (LAS float*)(F.lds + F.wave * 16384);
    const int gw = F.bid * NWAVES + F.wave, NGW = F.G * NWAVES, lane = F.lane;
    for (int it = gw; it < 1536 + 2048; it += NGW) { int r = it;
        if (tr_matrix(r, INP(7), 3072, DM, 3072, 0, 1, WSPG(bf16, WS_WIN0), INP(2), scr, lane)) continue;
        bool done = false;
#pragma unroll
        for (int l = 0; l < 2; ++l) {
            if (done) break;
            if (tr_matrix(r, INP(22) + (size_t)l * DM * 2048, 2048, DM, DM, 0, 0, WSPG(bf16, WS_WK) + (size_t)l * DM * DM, INP(5), scr, lane)) { done = true; break; }
            if (tr_matrix(r, INP(22) + (size_t)l * DM * 2048, 2048, DM, DM, 1024, 0, WSPG(bf16, WS_WV) + (size_t)l * DM * DM, INP(5), scr, lane)) { done = true; break; }
        } }
    {   const GAS float* x = INP(0); GAS bf16* xb = WSPG(bf16, WS_XB); GAS float* ssq = WSPG(float, WS_SSQ);
        for (int m = gw; m < MROWS; m += NGW) {
            const GAS f32x4* xr = (const GAS f32x4*)(x + (size_t)m * DM) + lane; f32x4 v[4]; float s = 0.f;
#pragma unroll
            for (int j = 0; j < 4; ++j) { v[j] = __builtin_nontemporal_load(xr + 64 * j); s += (v[j][0] * v[j][0] + v[j][1] * v[j][1]) + (v[j][2] * v[j][2] + v[j][3] * v[j][3]); }
            s = wave_sum(s);
            GAS v2u* o8 = (GAS v2u*)(xb + (size_t)m * DM) + lane;
#pragma unroll
            for (int j = 0; j < 4; ++j) { v2u w; w.x = pk2h(v[j][0], v[j][1]); w.y = pk2h(v[j][2], v[j][3]); o8[64 * j] = w; }
            if (lane == 0) { ssq[m] = s; ssq[MROWS + m] = 0.f; }
        } }
    {   const GAS float* x = INP(1); GAS bf16* xb = WSPG(bf16, WS_MEMB); GAS float* rm = WSPG(float, WS_RMEM);
        for (int m = gw; m < MMEM; m += NGW) {
            const GAS f32x4* xr = (const GAS f32x4*)(x + (size_t)m * DM) + lane; f32x4 v[4]; float s = 0.f;
#pragma unroll
            for (int j = 0; j < 4; ++j) { v[j] = __builtin_nontemporal_load(xr + 64 * j); s += (v[j][0] * v[j][0] + v[j][1] * v[j][1]) + (v[j][2] * v[j][2] + v[j][3] * v[j][3]); }
            s = wave_sum(s);
            GAS v2u* o8 = (GAS v2u*)(xb + (size_t)m * DM) + lane;
#pragma unroll
            for (int j = 0; j < 4; ++j) { v2u w; w.x = pk2h(v[j][0], v[j][1]); w.y = pk2h(v[j][2], v[j][3]); o8[64 * j] = w; }
            if (lane == 0) rm[m] = 1.0f / sqrtf(s * (1.0f / DM) + EPS);
        } }
    {   const int idx = F.bid * (NWAVES * 64) + F.tid, NT = F.G * NWAVES * 64;
        for (int i = idx; i < 512; i += NT) { const float a0 = INP(9)[i], a1 = INP(9)[512 + i], a2 = INP(9)[1024 + i]; const float mx = fmaxf(a0, fmaxf(a1, a2));
            const float e0 = __expf(a0 - mx), e1 = __expf(a1 - mx), e2 = __expf(a2 - mx); WSPG(float, WS_LB)[i] = e0 / (e0 + e1 + e2); }
        for (int i = idx; i < 4 * 128 * 128; i += NT) { const int t = (i >> 7) & 127, s = i & 127; WSPG(bf16, WS_SGUW)[i] = (bf16)(s <= t ? (pk2h(INP(19)[i], 0.f) & 0xffffu) : 0u); }
    }
}

constexpr int HG_QIN = 0, HG_KIN = 17408, HG_KOT = 34816, HG_VTT = 53248, HG_ATT = 71680, HG_STT = 80896, HG_OST = 115712, HG_DEC = 133120, HG_SSQ = 133632;
constexpr int P128 = 272, P64 = 144;
__device__ __forceinline__ float wave_scan(float v) {
#define HG_DPP(ctrl, rmask) v += __builtin_bit_cast(float, __builtin_amdgcn_update_dpp(0, __builtin_bit_cast(int, v), (ctrl), (rmask), 0xf, false))
    HG_DPP(0x111, 0xf); HG_DPP(0x112, 0xf); HG_DPP(0x114, 0xf); HG_DPP(0x118, 0xf); HG_DPP(0x142, 0xa); HG_DPP(0x143, 0xc);
#undef HG_DPP
    return v;
}
__device__ __forceinline__ void hgrn_unit(Frame& F, int b, int h) {
    LAS unsigned char* L = F.lds;
    int tid_ = F.tid; asm volatile("" : "+v"(tid_));
    const int tid = tid_, lane = tid & 63, w = __builtin_amdgcn_readfirstlane(tid >> 6), l31 = lane & 31, hh = lane >> 5;
    const GAS bf16* P = WSPG(bf16, WS_BIG); GAS bf16* MIX = WSPG(bf16, WS_MIX);
    const int vs = tid >> 3, vec = (tid & 7) * 16;
    const int eb = w & 3, cb = w >> 2;
    f32x16 S0, S1;
#pragma unroll
    for (int r = 0; r < 16; ++r) { S0[r] = 0.f; S1[r] = 0.f; }
    for (int i = tid; i < 34816 / 16; i += 512) *(LAS v4u*)(L + HG_STT + i * 16) = (v4u){0u, 0u, 0u, 0u};
    float onorm[16];
#pragma unroll
    for (int j = 0; j < 16; ++j) onorm[j] = INP(10)[h * 128 + vec + j];
    LAS float* DEC = (LAS float*)(L + HG_DEC); LAS float* SSQ = (LAS float*)(L + HG_SSQ);
    const GAS bf16* pbase = P + ((size_t)b * SEQ + lane) * PW + h * 128 + 16 * w;
    const GAS bf16* gbase = P + ((size_t)b * SEQ + vs) * PW + 1536 + h * 128 + vec;
    v4u ra0, ra1, ra2, ra3, ra4, ra5, rb0, rb1, rb2, rb3, rb4, rb5, ga0, ga1, gb0, gb1;
    ra0 = *(const GAS v4u*)(pbase); ra1 = *(const GAS v4u*)(pbase + 8); ra2 = *(const GAS v4u*)(pbase + 512); ra3 = *(const GAS v4u*)(pbase + 520); ra4 = *(const GAS v4u*)(pbase + 1024); ra5 = *(const GAS v4u*)(pbase + 1032);
    {   const GAS bf16* p1 = pbase + (size_t)64 * PW;
        rb0 = *(const GAS v4u*)(p1); rb1 = *(const GAS v4u*)(p1 + 8); rb2 = *(const GAS v4u*)(p1 + 512); rb3 = *(const GAS v4u*)(p1 + 520); rb4 = *(const GAS v4u*)(p1 + 1024); rb5 = *(const GAS v4u*)(p1 + 1032); }
    ga0 = *(const GAS v4u*)(gbase); ga1 = *(const GAS v4u*)(gbase + 8); gb0 = *(const GAS v4u*)(gbase + (size_t)64 * PW); gb1 = *(const GAS v4u*)(gbase + (size_t)64 * PW + 8);
    auto chunk = [&](const int n, v4u& rq0, v4u& rq1, v4u& rk0, v4u& rk1, v4u& rv0, v4u& rv1, v4u& g0, v4u& g1) {
        const size_t m0 = (size_t)b * SEQ + n * 64;
        {   const unsigned qw[8] = {rq0.x, rq0.y, rq0.z, rq0.w, rq1.x, rq1.y, rq1.z, rq1.w}, kw[8] = {rk0.x, rk0.y, rk0.z, rk0.w, rk1.x, rk1.y, rk1.z, rk1.w}, vw[8] = {rv0.x, rv0.y, rv0.z, rv0.w, rv1.x, rv1.y, rv1.z, rv1.w};
            float kk[16], cm[16];
#pragma unroll
            for (int j2 = 0; j2 < 8; ++j2) { kk[2 * j2] = hlo(kw[j2]); kk[2 * j2 + 1] = hhi(kw[j2]); }
#pragma unroll
            for (int j = 0; j < 16; ++j) cm[j] = __builtin_amdgcn_logf(1.0f - kk[j]);
#define HG_STEP(ctrl, rmask) _Pragma("unroll") for (int j = 0; j < 16; ++j) cm[j] += __builtin_bit_cast(float, __builtin_amdgcn_update_dpp(0, __builtin_bit_cast(int, cm[j]), (ctrl), (rmask), 0xf, false))
            HG_STEP(0x111, 0xf); HG_STEP(0x112, 0xf); HG_STEP(0x114, 0xf); HG_STEP(0x118, 0xf); HG_STEP(0x142, 0xa); HG_STEP(0x143, 0xc);
#undef HG_STEP
            unsigned qo[8], ko[8]; float decv = 0.f;
#pragma unroll
            for (int j2 = 0; j2 < 8; ++j2) {
                float qi[2], ki[2];
#pragma unroll
                for (int t = 0; t < 2; ++t) { const int j = 2 * j2 + t;
                    const float e1 = fexp2(cm[j]), e2 = __builtin_amdgcn_rcpf(e1), dec = __builtin_bit_cast(float, __builtin_amdgcn_readlane(__builtin_bit_cast(int, e1), 63));
                    qi[t] = (t == 0 ? hlo(qw[j2]) : hhi(qw[j2])) * e1; ki[t] = kk[j] * e2;
                    *(LAS bf16*)(L + HG_KOT + (16 * w + j) * P64 + lane * 2) = (bf16)(pk2(ki[t] * dec, 0.f) & 0xffffu);
                    decv = lane == j ? dec : decv; }
                qo[j2] = pk2(qi[0], qi[1]); ko[j2] = pk2(ki[0], ki[1]);
                *(LAS bf16*)(L + HG_VTT + (16 * w + 2 * j2) * P64 + lane * 2) = (bf16)(pk2(hlo(vw[j2]), 0.f) & 0xffffu);
                *(LAS bf16*)(L + HG_VTT + (16 * w + 2 * j2 + 1) * P64 + lane * 2) = (bf16)(pk2(hhi(vw[j2]), 0.f) & 0xffffu);
            }
            if (lane < 16) DEC[16 * w + lane] = decv;
            *(LAS v4u*)(L + HG_QIN + lane * P128 + 32 * w) = (v4u){qo[0], qo[1], qo[2], qo[3]}; *(LAS v4u*)(L + HG_QIN + lane * P128 + 32 * w + 16) = (v4u){qo[4], qo[5], qo[6], qo[7]};
            *(LAS v4u*)(L + HG_KIN + lane * P128 + 32 * w) = (v4u){ko[0], ko[1], ko[2], ko[3]}; *(LAS v4u*)(L + HG_KIN + lane * P128 + 32 * w + 16) = (v4u){ko[4], ko[5], ko[6], ko[7]};
        }
        __syncthreads();
        {   const int n2c = n + 2 < 32 ? n + 2 : 31;
            const GAS bf16* pn = pbase + (size_t)n2c * 64 * PW;
            rq0 = *(const GAS v4u*)(pn); rq1 = *(const GAS v4u*)(pn + 8); rk0 = *(const GAS v4u*)(pn + 512); rk1 = *(const GAS v4u*)(pn + 520); rv0 = *(const GAS v4u*)(pn + 1024); rv1 = *(const GAS v4u*)(pn + 1032); }
        f32x16 o;
#pragma unroll
        for (int r = 0; r < 16; ++r) o[r] = 0.f;
        mma_lds<8>(o, L + HG_STT + (32 * eb + l31) * P128 + hh * 16, L + HG_QIN + (32 * cb + l31) * P128 + hh * 16);
        if (w < 3) {
            const int sb = w >> 1, cb2 = (w + 1) >> 1;
            f32x16 at;
#pragma unroll
            for (int r = 0; r < 16; ++r) at[r] = 0.f;
            mma_lds<8>(at, L + HG_KIN + (32 * sb + l31) * P128 + hh * 16, L + HG_QIN + (32 * cb2 + l31) * P128 + hh * 16);
            if (sb == cb2) {
#pragma unroll
                for (int r = 0; r < 16; ++r) { const int sl = (r & 3) + 8 * (r >> 2) + 4 * hh; if (sl > l31) at[r] = 0.f; } }
#pragma unroll
            for (int g4 = 0; g4 < 4; ++g4) *(LAS v2u*)(L + HG_ATT + (32 * cb2 + l31) * P64 + (32 * sb + 8 * g4 + 4 * hh) * 2) = (v2u){pk2(at[4 * g4], at[4 * g4 + 1]), pk2(at[4 * g4 + 2], at[4 * g4 + 3])};
        }
        __syncthreads();
        if (cb == 0) mma_lds<2>(o, L + HG_VTT + (32 * eb + l31) * P64 + hh * 16, L + HG_ATT + l31 * P64 + hh * 16);
        else         mma_lds<4>(o, L + HG_VTT + (32 * eb + l31) * P64 + hh * 16, L + HG_ATT + (32 + l31) * P64 + hh * 16);
#pragma unroll
        for (int i2 = 0; i2 < 2; ++i2) {
            const int dkb = 2 * cb + i2;
            f32x16& S = i2 == 0 ? S0 : S1;
#pragma unroll
            for (int g4 = 0; g4 < 4; ++g4) { const f32x4 d4 = *(const LAS f32x4*)(DEC + 32 * dkb + 8 * g4 + 4 * hh);
#pragma unroll
                for (int j = 0; j < 4; ++j) S[4 * g4 + j] *= d4[j]; }
            mma_lds<4>(S, L + HG_KOT + (32 * dkb + l31) * P64 + hh * 16, L + HG_VTT + (32 * eb + l31) * P64 + hh * 16);
#pragma unroll
            for (int g4 = 0; g4 < 4; ++g4) *(LAS v2u*)(L + HG_STT + (32 * eb + l31) * P128 + (32 * dkb + 8 * g4 + 4 * hh) * 2) = (v2u){pk2(S[4 * g4], S[4 * g4 + 1]), pk2(S[4 * g4 + 2], S[4 * g4 + 3])};
        }
        {   float ss = 0.f;
#pragma unroll
            for (int r = 0; r < 16; ++r) ss += o[r] * o[r];
            ss += __shfl_xor(ss, 32);
            if (hh == 0) SSQ[eb * 64 + 32 * cb + l31] = ss;
#pragma unroll
            for (int g4 = 0; g4 < 4; ++g4) *(LAS v2u*)(L + HG_OST + (32 * cb + l31) * P128 + (32 * eb + 8 * g4 + 4 * hh) * 2) = (v2u){pk2h(o[4 * g4], o[4 * g4 + 1]), pk2h(o[4 * g4 + 2], o[4 * g4 + 3])}; }
        __syncthreads();
        {   const int c = vs;
            const float rn = 1.0f / sqrtf(((SSQ[c] + SSQ[64 + c]) + (SSQ[128 + c] + SSQ[192 + c])) * (1.0f / 128.0f) + EPS);
            const v4u o0 = *(const LAS v4u*)(L + HG_OST + c * P128 + vec * 2), o1 = *(const LAS v4u*)(L + HG_OST + c * P128 + vec * 2 + 16);
            const unsigned ow[8] = {o0.x, o0.y, o0.z, o0.w, o1.x, o1.y, o1.z, o1.w}, gw[8] = {g0.x, g0.y, g0.z, g0.w, g1.x, g1.y, g1.z, g1.w};
            {   const int n2c = n + 2 < 32 ? n + 2 : 31; g0 = *(const GAS v4u*)(gbase + (size_t)n2c * 64 * PW); g1 = *(const GAS v4u*)(gbase + (size_t)n2c * 64 * PW + 8); }
            unsigned res[8];
#pragma unroll
            for (int j = 0; j < 8; ++j) res[j] = pk2h(hlo(ow[j]) * rn * onorm[2 * j] * hlo(gw[j]), hhi(ow[j]) * rn * onorm[2 * j + 1] * hhi(gw[j]));
            *(GAS v4u*)(MIX + (m0 + c) * DM + h * 128 + vec) = (v4u){res[0], res[1], res[2], res[3]};
            *(GAS v4u*)(MIX + (m0 + c) * DM + h * 128 + vec + 8) = (v4u){res[4], res[5], res[6], res[7]};
        }
    };
#pragma unroll 1
    for (int n2 = 0; n2 < 32; n2 += 2) { chunk(n2, ra0, ra1, ra2, ra3, ra4, ra5, ga0, ga1); chunk(n2 + 1, rb0, rb1, rb2, rb3, rb4, rb5, gb0, gb1); }
    __syncthreads();
}

__device__ __forceinline__ void reduce16x2(float (&a)[16], int lane) {
#pragma unroll
    for (int i = 0; i < 8; ++i) { const bool up = (lane & 32) != 0; const float send = up ? a[i] : a[i + 8]; const float keep = up ? a[i + 8] : a[i]; a[i] = keep + __shfl_xor(send, 32); }
#pragma unroll
    for (int i = 0; i < 4; ++i) { const bool up = (lane & 16) != 0; const float send = up ? a[i] : a[i + 4]; const float keep = up ? a[i + 4] : a[i]; a[i] = keep + __shfl_xor(send, 16); }
#pragma unroll
    for (int i = 0; i < 2; ++i) { const bool up = (lane & 8) != 0; const float send = up ? a[i] : a[i + 2]; const float keep = up ? a[i + 2] : a[i]; a[i] = keep + __shfl_xor(send, 8); }
    { const bool up = (lane & 4) != 0; const float send = up ? a[0] : a[1]; const float keep = up ? a[1] : a[0]; a[0] = keep + __shfl_xor(send, 4); }
    a[0] += __shfl_xor(a[0], 2); a[0] += __shfl_xor(a[0], 1);
}
constexpr int CV_CT = 0, CV_PART = 98304;
__device__ __forceinline__ void conv_tiles(Frame& F, int first, int stride) {
    if (first >= 512) return;
    LAS unsigned char* L = F.lds;
    int tid_ = F.tid; asm volatile("" : "+v"(tid_));
    const int tid = tid_, lane = tid & 63, w = __builtin_amdgcn_readfirstlane(tid >> 6);
    const GAS bf16* P = WSPG(bf16, WS_BIG); GAS unsigned* MIX32 = WSPG(unsigned, WS_MIX);
    const int cp = tid & 255, th = tid >> 8;
    float w0[31], w1[31];
#pragma unroll
    for (int k = 0; k < 31; ++k) { const f32x2_t ww = *(const GAS f32x2_t*)(INP(11) + k * 512 + 2 * cp); w0[k] = ww.x; w1[k] = ww.y; }
    const f32x2_t bias = *(const GAS f32x2_t*)(INP(12) + 2 * cp), lng = *(const GAS f32x2_t*)(INP(13) + 2 * cp), lnb = *(const GAS f32x2_t*)(INP(14) + 2 * cp);
    LAS float* PART = (LAS float*)(L + CV_PART);
    const LAS unsigned* CT32 = (const LAS unsigned*)(L + CV_CT);
    v4u rows[12];
    auto load_rows = [&](int tile) { const int b = tile >> 5, t0 = (tile & 31) * 64;
#pragma unroll
        for (int i = 0; i < 12; ++i) { const int idx = tid + 512 * i, j = idx >> 6, c16 = idx & 63, t = t0 - 30 + j;
            rows[i] = (v4u){0u, 0u, 0u, 0u}; if (idx < 94 * 64 && t >= 0) rows[i] = *(const GAS v4u*)(P + ((size_t)b * SEQ + t) * PW + 2048 + c16 * 8); } };
    auto store_rows = [&]() {
#pragma unroll
        for (int i = 0; i < 12; ++i) { const int idx = tid + 512 * i; if (idx < 94 * 64) *(LAS v4u*)(L + CV_CT + (idx >> 6) * 1024 + (idx & 63) * 16) = rows[i]; } };
    load_rows(first);
#pragma unroll 1
    for (int tile = first; tile < 512; tile += stride) {
        const int b = tile >> 5, t0 = (tile & 31) * 64; const size_t m0 = (size_t)b * SEQ + t0;
        store_rows();
        __syncthreads();
        if (tile + stride < 512) load_rows(tile + stride);
#pragma unroll 1
        for (int grp = 0; grp < 4; ++grp) {
            const int tok0 = 32 * th + 8 * grp;
            float a0[8], a1[8];
#pragma unroll
            for (int i = 0; i < 8; ++i) { a0[i] = bias.x; a1[i] = bias.y; }
#pragma unroll
            for (int jj = 0; jj < 38; ++jj) { const unsigned v = CT32[(tok0 + jj) * 256 + cp]; const float x0 = hlo(v), x1 = hhi(v);
#pragma unroll
                for (int i = 0; i < 8; ++i) { const int k = jj - i; if (k >= 0 && k <= 30) { a0[i] += w0[k] * x0; a1[i] += w1[k] * x1; } } }
            float st[16];
#pragma unroll
            for (int i = 0; i < 8; ++i) { st[i] = a0[i] + a1[i]; st[8 + i] = a0[i] * a0[i] + a1[i] * a1[i]; }
            reduce16x2(st, lane);
            if ((lane & 3) == 0) PART[((grp & 1) * 8 + w) * 16 + (8 * ((lane >> 5) & 1) + 4 * ((lane >> 4) & 1) + 2 * ((lane >> 3) & 1) + ((lane >> 2) & 1))] = st[0];
            __syncthreads();
#pragma unroll
            for (int i = 0; i < 8; ++i) {
                float s = 0.f, q = 0.f;
#pragma unroll
                for (int ww = 0; ww < 4; ++ww) { s += PART[((grp & 1) * 8 + 4 * th + ww) * 16 + i]; q += PART[((grp & 1) * 8 + 4 * th + ww) * 16 + 8 + i]; }
                const float mu = s * (1.0f / 512.0f), var = q * (1.0f / 512.0f) - mu * mu, rstd = 1.0f / sqrtf(fmaxf(var, 0.f) + EPS);
                float y0 = (a0[i] - mu) * rstd * lng.x + lnb.x, y1 = (a1[i] - mu) * rstd * lng.y + lnb.y;
                y0 *= sigm(y0); y1 *= sigm(y1);
                MIX32[(m0 + tok0 + i) * 512 + 256 + cp] = pk2h(y0, y1);
            }
        }
        __syncthreads();
    }
}

constexpr int MB_KP = 144, MB_VP = 520, MB_VOFF = 256 * MB_KP, MB_BUF = MB_VOFF + 64 * MB_VP, MB_KM = 2 * MB_BUF;
__device__ __forceinline__ void moba_unit(Frame& F, int b, int hd, int jq) {
    LAS unsigned char* L = F.lds;
    int tid_ = F.tid; asm volatile("" : "+v"(tid_));
    const int tid = tid_, lane = tid & 63, w = __builtin_amdgcn_readfirstlane(tid >> 6), l31 = lane & 31, hh = lane >> 5;
    const GAS bf16* P = WSPG(bf16, WS_BIG); GAS bf16* MIX = WSPG(bf16, WS_MIX); const GAS float* kpart = WSPG(float, WS_KPART);
    const size_t m0 = (size_t)b * SEQ + jq * 256;
    const size_t qrow = m0 + 32 * w + l31;
    bf16x8 qf[4];
#pragma unroll
    for (int ks = 0; ks < 4; ++ks) qf[ks] = *(const GAS bf16x8*)(P + qrow * PW + hd * 64 + 16 * ks + 8 * hh);
    LAS float* KM = (LAS float*)(L + MB_KM);
    if (tid < jq * 64) { const int n = tid >> 6, d = tid & 63, pm = b * 8 + n, col = hd * 64 + d;
        KM[n * 64 + d] = (kpart[(size_t)(pm * 2) * 512 + col] + kpart[(size_t)(pm * 2 + 1) * 512 + col]) * (1.0f / 256.0f); }
    const int skey = tid >> 3, sch = tid & 7, vkey = tid & 255, vch = tid >> 8;
    v4u kreg[4], vreg[4];
    auto stage_load = [&](int blk) { const size_t mk = (size_t)b * SEQ + blk * 256;
#pragma unroll
        for (int j = 0; j < 4; ++j) { kreg[j] = *(const GAS v4u*)(P + (mk + skey + 64 * j) * PW + 512 + hd * 64 + 8 * sch); vreg[j] = *(const GAS v4u*)(P + (mk + vkey) * PW + 1024 + hd * 64 + 8 * (vch + 2 * j)); } };
    auto stage_write = [&](int buf) {
#pragma unroll
        for (int j = 0; j < 4; ++j) { *(LAS v4u*)(L + buf * MB_BUF + (skey + 64 * j) * MB_KP + sch * 16) = kreg[j];
            const unsigned vw[4] = {vreg[j].x, vreg[j].y, vreg[j].z, vreg[j].w}; LAS unsigned char* vp = L + buf * MB_BUF + MB_VOFF + 8 * (vch + 2 * j) * MB_VP + vkey * 2;
#pragma unroll
            for (int e = 0; e < 4; ++e) { *(LAS bf16*)(vp + (2 * e) * MB_VP) = (bf16)(vw[e] & 0xffffu); *(LAS bf16*)(vp + (2 * e + 1) * MB_VP) = (bf16)(vw[e] >> 16); } } };
    stage_load(jq); stage_write(0);
    __syncthreads();
    unsigned sel = 0u;
    if (jq <= 3) sel = (1u << jq) - 1u;
    else {
        float sc[7];
#pragma unroll
        for (int n = 0; n < 7; ++n) { float p = 0.f;
            if (n < jq) {
#pragma unroll
                for (int ks = 0; ks < 4; ++ks)
#pragma unroll
                    for (int j = 0; j < 8; ++j) p += h2f((unsigned short)qf[ks][j]) * KM[n * 64 + 16 * ks + 8 * hh + j];
                p += __shfl_xor(p, 32); } else p = -INFINITY;
            sc[n] = p; }
#pragma unroll
        for (int n = 0; n < 7; ++n) { int rank = 0;
#pragma unroll
            for (int n2 = 0; n2 < 7; ++n2) if (n2 != n) rank += (sc[n2] > sc[n] || (sc[n2] == sc[n] && n2 < n)) ? 1 : 0;
            if (n < jq && rank < 3) sel |= 1u << n; }
    }
    float negm = 0.f, lrun = 0.f; bool first = true; f32x16 O0, O1;
#pragma unroll
    for (int r = 0; r < 16; ++r) { O0[r] = 0.f; O1[r] = 0.f; }
#pragma unroll 1
    for (int bi = 0; bi <= jq; ++bi) {
        const int buf = bi & 1;
        if (bi < jq) stage_load(bi);
        const bool own = bi == 0; const int blk = own ? jq : bi - 1;
        const bool mysel = own ? true : (((sel >> blk) & 1u) != 0u);
        const bool anysel = own ? true : (__ballot(mysel) != 0ull);
        const int nkt = own ? ((w >> 1) + 1) : (anysel ? 4 : 0);
#pragma unroll 1
        for (int kt = 0; kt < nkt; ++kt) {
            f32x16 p0, p1;
#pragma unroll
            for (int r = 0; r < 16; ++r) { p0[r] = negm; p1[r] = negm; }
            {   const LAS unsigned char* kb = L + buf * MB_BUF + (64 * kt + l31) * MB_KP + hh * 16;
                bf16x8 kfa[4], kfb[4];
#pragma unroll
                for (int ks = 0; ks < 4; ++ks) { kfa[ks] = ldsfrag(kb + ks * 32); kfb[ks] = ldsfrag(kb + 32 * MB_KP + ks * 32); }
#pragma unroll
                for (int ks = 0; ks < 4; ++ks) { p0 = MFMA32H(kfa[ks], qf[ks], p0); p1 = MFMA32H(kfb[ks], qf[ks], p1); } }
            bf16x8 vf[8];
            {   const LAS unsigned char* vb = L + buf * MB_BUF + MB_VOFF + l31 * MB_VP + hh * 8 + 128 * kt;
#pragma unroll
                for (int sub = 0; sub < 2; ++sub)
#pragma unroll
                    for (int s2 = 0; s2 < 2; ++s2) { const int ko = (32 * sub + 16 * s2) * 2;
                        vf[(sub * 2 + s2) * 2] = ldsfrag2(vb + ko, vb + ko + 16); vf[(sub * 2 + s2) * 2 + 1] = ldsfrag2(vb + 32 * MB_VP + ko, vb + 32 * MB_VP + ko + 16); } }
            if (own) { const int qrel = 32 * w + l31, kb0 = 64 * kt + 4 * hh;
                if (64 * kt + 63 > 32 * w) {
#pragma unroll
                    for (int r = 0; r < 16; ++r) { const int kv = kb0 + (r & 3) + 8 * (r >> 2); if (kv > qrel) p0[r] = NEGBIG; if (kv + 32 > qrel) p1[r] = NEGBIG; } }
            } else if (!mysel) {
#pragma unroll
                for (int r = 0; r < 16; ++r) { p0[r] = NEGBIG; p1[r] = NEGBIG; } }
            float mxa = fmaxf(p0[0], p1[0]), mxb = fmaxf(p0[1], p1[1]), mxc = fmaxf(p0[2], p1[2]), mxd = fmaxf(p0[3], p1[3]);
#pragma unroll
            for (int r = 4; r < 16; r += 4) { mxa = fmaxf(mxa, fmaxf(p0[r], p1[r])); mxb = fmaxf(mxb, fmaxf(p0[r + 1], p1[r + 1])); mxc = fmaxf(mxc, fmaxf(p0[r + 2], p1[r + 2])); mxd = fmaxf(mxd, fmaxf(p0[r + 3], p1[r + 3])); }
            float mx = fmaxf(fmaxf(mxa, mxb), fmaxf(mxc, mxd));
            mx = fmaxf(mx, __shfl_xor(mx, 32));
            if (first || !__all(mx <= 8.0f)) {
                const float delta = first ? mx : fmaxf(mx, 0.f);
                negm -= delta;
#pragma unroll
                for (int r = 0; r < 16; ++r) { p0[r] -= delta; p1[r] -= delta; }
                if (!first) { const float alpha = fexp2(-delta); lrun *= alpha;
#pragma unroll
                    for (int r = 0; r < 16; ++r) { O0[r] *= alpha; O1[r] *= alpha; } }
                first = false;
            }
            float rsa = 0.f, rsb = 0.f, rsc = 0.f, rsd = 0.f;
#pragma unroll
            for (int r = 0; r < 16; r += 4) { p0[r] = fexp2(p0[r]); p1[r] = fexp2(p1[r]); p0[r + 1] = fexp2(p0[r + 1]); p1[r + 1] = fexp2(p1[r + 1]); p0[r + 2] = fexp2(p0[r + 2]); p1[r + 2] = fexp2(p1[r + 2]); p0[r + 3] = fexp2(p0[r + 3]); p1[r + 3] = fexp2(p1[r + 3]);
                rsa += p0[r] + p1[r]; rsb += p0[r + 1] + p1[r + 1]; rsc += p0[r + 2] + p1[r + 2]; rsd += p0[r + 3] + p1[r + 3]; }
            float rs = (rsa + rsb) + (rsc + rsd);
            rs += __shfl_xor(rs, 32);
            lrun += rs;
#pragma unroll
            for (int sub = 0; sub < 2; ++sub)
#pragma unroll
                for (int s2 = 0; s2 < 2; ++s2) { const bf16x8 pb = packfrag(sub == 0 ? p0 : p1, s2);
                    O0 = MFMA32H(vf[(sub * 2 + s2) * 2], pb, O0);
                    O1 = MFMA32H(vf[(sub * 2 + s2) * 2 + 1], pb, O1); }
        }
        if (bi < jq) stage_write(buf ^ 1);
        __syncthreads();
    }
    {   const float inv = 1.0f / lrun;
        GAS bf16* op = MIX + qrow * DM + hd * 64 + 4 * hh;
#pragma unroll
        for (int g4 = 0; g4 < 4; ++g4) {
            *(GAS v2u*)(op + 8 * g4) = (v2u){pk2h(O0[4 * g4] * inv, O0[4 * g4 + 1] * inv), pk2h(O0[4 * g4 + 2] * inv, O0[4 * g4 + 3] * inv)};
            *(GAS v2u*)(op + 32 + 8 * g4) = (v2u){pk2h(O1[4 * g4] * inv, O1[4 * g4 + 1] * inv), pk2h(O1[4 * g4 + 2] * inv, O1[4 * g4 + 3] * inv)}; }
    }
}

constexpr int SG_ZT = 0, SG_STAT = 34816, SG_OT = 40960;
__device__ __forceinline__ void sgu_unit(Frame& F, int ucur, int unext, const v4u (&zr)[4], const v4u (&ur)[4], v4u (&nz)[4], v4u (&nu)[4]) {
    const int b = ucur >> 6, nc = (ucur >> 2) & 15, g = ucur & 3;
    LAS unsigned char* L = F.lds;
    int tid_ = F.tid; asm volatile("" : "+v"(tid_));
    const int tid = tid_, lane = tid & 63, w = __builtin_amdgcn_readfirstlane(tid >> 6), l31 = lane & 31, hh = lane >> 5;
    const GAS bf16* P = WSPG(bf16, WS_BIG); GAS bf16* MIX = WSPG(bf16, WS_MIX); const GAS bf16* Wb = WSPG(bf16, WS_SGUW) + g * 128 * 128;
    const size_t m0 = (size_t)b * SEQ + nc * 128;
    const int s = tid & 127, qt = tid >> 7, c0 = 32 * qt;
    const int tb0 = w >> 2;
    bf16x8 wf0[4], wf1[8];
#pragma unroll
    for (int ks = 0; ks < 4; ++ks) if (ks < 2 * (tb0 + 1)) wf0[ks] = *(const GAS bf16x8*)(Wb + (32 * tb0 + l31) * 128 + 8 * hh + 16 * ks);
#pragma unroll
    for (int ks = 0; ks < 8; ++ks) if (ks < 2 * (4 - tb0)) wf1[ks] = *(const GAS bf16x8*)(Wb + (32 * (3 - tb0) + l31) * 128 + 8 * hh + 16 * ks);
    if (unext >= 0) {
        const int b2 = unext >> 6, nc2 = (unext >> 2) & 15, g2 = unext & 3; const size_t m2 = (size_t)b2 * SEQ + nc2 * 128;
        const GAS bf16* zp = P + (m2 + s) * PW + 2048 + g2 * 128 + c0; const GAS bf16* up = P + (m2 + (tid >> 2)) * PW + 1536 + g2 * 128 + (tid & 3) * 32;
#pragma unroll
        for (int j4 = 0; j4 < 4; ++j4) { nz[j4] = *(const GAS v4u*)(zp + 8 * j4); nu[j4] = *(const GAS v4u*)(up + 8 * j4); } }
    float z[32];
#pragma unroll
    for (int j4 = 0; j4 < 4; ++j4) { const unsigned vw[4] = {zr[j4].x, zr[j4].y, zr[j4].z, zr[j4].w};
#pragma unroll
        for (int j = 0; j < 4; ++j) { z[8 * j4 + 2 * j] = hlo(vw[j]); z[8 * j4 + 2 * j + 1] = hhi(vw[j]); } }
    float sm = 0.f, sq = 0.f;
#pragma unroll
    for (int j = 0; j < 32; ++j) { sm += z[j]; sq += z[j] * z[j]; }
    LAS float* ST = (LAS float*)(L + SG_STAT);
    ST[(qt * 128 + s) * 2] = sm; ST[(qt * 128 + s) * 2 + 1] = sq;
    __syncthreads();
    {   float a = 0.f, q = 0.f;
#pragma unroll
        for (int k = 0; k < 4; ++k) { a += ST[(k * 128 + s) * 2]; q += ST[(k * 128 + s) * 2 + 1]; }
        const float mu = a * (1.0f / 128.0f), var = q * (1.0f / 128.0f) - mu * mu, rstd = 1.0f / sqrtf(fmaxf(var, 0.f) + EPS);
        const GAS float* lg = INP(17) + g * 128 + c0; const GAS float* lbp = INP(18) + g * 128 + c0;
#pragma unroll
        for (int j = 0; j < 32; ++j) *(LAS bf16*)(L + SG_ZT + (c0 + j) * P128 + s * 2) = (bf16)(pk2h((z[j] - mu) * rstd * lg[j] + lbp[j], 0.f) & 0xffffu);
    }
    __syncthreads();
    const int cb = w & 3;
#pragma unroll
    for (int it = 0; it < 2; ++it) {
        const int tb = it == 0 ? tb0 : 3 - tb0;
        f32x16 acc;
#pragma unroll
        for (int r = 0; r < 16; ++r) acc[r] = 0.f;
        const LAS unsigned char* zb = L + SG_ZT + (32 * cb + l31) * P128 + hh * 16;
        const int nks = 2 * (tb + 1);
#pragma unroll
        for (int ks = 0; ks < (it == 0 ? 4 : 8); ++ks) if (ks < nks) acc = MFMA32H(ldsfrag(zb + ks * 32), it == 0 ? wf0[ks] : wf1[ks], acc);
        const float bias = INP(20)[g * 128 + 32 * tb + l31];
#pragma unroll
        for (int g4 = 0; g4 < 4; ++g4) *(LAS v2u*)(L + SG_OT + (32 * tb + l31) * P128 + (32 * cb + 8 * g4 + 4 * hh) * 2) = (v2u){pk2h(acc[4 * g4] + bias, acc[4 * g4 + 1] + bias), pk2h(acc[4 * g4 + 2] + bias, acc[4 * g4 + 3] + bias)};
    }
    __syncthreads();
    {   const int t = tid >> 2, cc = (tid & 3) * 32;
        GAS bf16* op = MIX + (m0 + t) * DM + 512 + g * 128 + cc;
#pragma unroll
        for (int j4 = 0; j4 < 4; ++j4) { const v4u u = ur[j4], mx = *(const LAS v4u*)(L + SG_OT + t * P128 + (cc + 8 * j4) * 2);
            *(GAS v4u*)(op + 8 * j4) = (v4u){pk2h(hlo(u.x) * hlo(mx.x), hhi(u.x) * hhi(mx.x)), pk2h(hlo(u.y) * hlo(mx.y), hhi(u.y) * hhi(mx.y)), pk2h(hlo(u.z) * hlo(mx.z), hhi(u.z) * hhi(mx.z)), pk2h(hlo(u.w) * hlo(mx.w), hhi(u.w) * hhi(mx.w))}; }
    }
    __syncthreads();
}

__device__ __forceinline__ void sgu_units(Frame& F, int first, int stride) {
    if (first >= 1024) return;
    const int tid = F.tid, s = tid & 127, c0 = 32 * (tid >> 7);
    const GAS bf16* P = WSPG(bf16, WS_BIG);
    v4u za[4], ua[4], zb[4], ub[4];
    {   const int b = first >> 6, nc = (first >> 2) & 15, g = first & 3; const size_t m0 = (size_t)b * SEQ + nc * 128;
        const GAS bf16* zp = P + (m0 + s) * PW + 2048 + g * 128 + c0; const GAS bf16* up = P + (m0 + (tid >> 2)) * PW + 1536 + g * 128 + (tid & 3) * 32;
#pragma unroll
        for (int j4 = 0; j4 < 4; ++j4) { za[j4] = *(const GAS v4u*)(zp + 8 * j4); ua[j4] = *(const GAS v4u*)(up + 8 * j4); } }
#pragma unroll 1
    for (int u = first; u < 1024; u += 2 * stride) {
        const int u1 = u + stride, u2 = u + 2 * stride;
        sgu_unit(F, u, u1 < 1024 ? u1 : -1, za, ua, zb, ub);
        if (u1 < 1024) sgu_unit(F, u1, u2 < 1024 ? u2 : -1, zb, ub, za, ua);
    }
}

__device__ __forceinline__ void final_norm(Frame& F) {
    const int gw = F.bid * NWAVES + F.wave, NGW = F.G * NWAVES, lane = F.lane;
    const GAS float* ssq = WSPG(float, WS_SSQ); const GAS float* gn = INP(6);
    f32x4 gv[4];
#pragma unroll
    for (int j = 0; j < 4; ++j) gv[j] = *(const GAS f32x4*)(gn + 4 * lane + 256 * j);
    for (int m = gw; m < MROWS; m += NGW) {
        const float s = ssq[m];
        const float r = 1.0f / sqrtf(s * (1.0f / DM) + EPS);
        const GAS v2u* xr = (const GAS v2u*)(WSPG(bf16, WS_XB) + (size_t)m * DM) + lane; GAS f32x4* orow = (GAS f32x4*)(F.out + (size_t)m * DM) + lane;
#pragma unroll
        for (int j = 0; j < 4; ++j) { const v2u w = __builtin_nontemporal_load(xr + 64 * j); f32x4 v = (f32x4){hlo(w.x), hhi(w.x), hlo(w.y), hhi(w.y)}; v = v * r * gv[j]; __builtin_nontemporal_store(v, orow + 64 * j); }
    }
}


#ifdef DIS_HGRN
#define HGRN_CALL(...)
#else
#define HGRN_CALL hgrn_unit
#endif
#ifdef DIS_CONV
#define CONV_CALL(...)
#else
#define CONV_CALL conv_tiles
#endif
#ifdef DIS_MOBA
#define MOBA_CALL(...)
#else
#define MOBA_CALL moba_unit
#endif
#ifdef DIS_SGU
#define SGU_CALL(...)
#else
#define SGU_CALL sgu_units
#endif
#ifndef REP_HGRN
#define REP_HGRN 1
#endif
#ifndef REP_CONV
#define REP_CONV 1
#endif
#ifndef REP_MOBA
#define REP_MOBA 1
#endif
#ifndef REP_SGU
#define REP_SGU 1
#endif
#ifndef REP_FFN
#define REP_FFN 1
#endif
#ifndef REP_P0
#define REP_P0 1
#endif
#ifndef GSEL
#define GSEL 0
#endif
#ifdef DIS_GEMM
template <class Epi, class Sched, bool A, bool B> __device__ __forceinline__ void gemm_dummy(LAS unsigned char*, const pg8::Gemm, const Sched&, const Epi&) {}
#define GEMM_CALL gemm_dummy
#else
#define GEMM_CALL pg8::gemm_phase
#endif
__device__ __forceinline__ void sub_barrier(Frame& F, unsigned* cnt, unsigned n) {
    asm volatile("s_waitcnt vmcnt(0)" ::: "memory"); __syncthreads();
    if (F.tid == 0) {
        __threadfence();
        asm volatile("s_waitcnt vmcnt(0)" ::: "memory");
        (void)__hip_atomic_fetch_add(cnt, 1u, __ATOMIC_RELAXED, __HIP_MEMORY_SCOPE_AGENT);
        unsigned sp = 0;
        while (__hip_atomic_load(cnt, __ATOMIC_RELAXED, __HIP_MEMORY_SCOPE_AGENT) < n) { __builtin_amdgcn_s_sleep(2); if (++sp > (1u << 22)) break; }
        __threadfence();
        asm volatile("s_waitcnt vmcnt(0)" ::: "memory");
    }
    __syncthreads();
}
template <int l> __device__ __forceinline__ void layer_phases(Frame& F, const int lo, const int hi, const XcdBarrier& bar, const int vcu) {
#define IN(k) (lo <= (k) && (k) < hi)
#define SEAM(k) do { if (IN(k) && IN((k) + 1)) xcd_barrier(bar); } while (0)
#define PH_ENTER() asm volatile("" : "+s"(F.ws), "+s"(F.out))
#define XB WSP(bf16, WS_XB)
#define BIG WSP(bf16, WS_BIG)
#define MIX WSP(bf16, WS_MIX)
#define QO WSP(bf16, WS_QO)
#define SSQ WSP(float, WS_SSQ)

        constexpr int pb = l == 0 ? 2 : 9;
        if (l == 1) {
            if (IN(8)) { PH_ENTER();
                pg8::Gemm g{XB, WSP(bf16, WS_WIN1), DM, DM, DM}; pg8::StaticOrder S; S.init(MROWS, PW, F.G, F.bid, DM, DM);
                pg8::EpiIn1 E{BIG, SSQ + MROWS, WSP(float, WS_KPART), C2M};
                GEMM_CALL<pg8::EpiIn1, pg8::StaticOrder, true, true>(F.lds, g, S, E);
            } SEAM(8);
        }
        if (IN(pb)) { PH_ENTER();
            if (l == 0) {
                const int nh = F.G > 64 ? 64 : F.G;
                for (int rep = 0; rep < REP_HGRN; ++rep)
                if (F.bid < nh) { for (int u = F.bid; u < 64; u += nh) HGRN_CALL(F, u >> 2, u & 3); }
                for (int rep = 0; rep < REP_CONV; ++rep)
                {   const bool split = F.G > 64; const int g2 = split ? F.G - 64 : F.G, c2 = split ? F.bid - 64 : F.bid;
                    if (c2 >= 0) {
                        CONV_CALL(F, c2, g2);
#pragma unroll 1
                        for (int q = 0; q < 4; ++q) {
                            pg8::Gemm g{WSP(bf16, WS_MEMB), WSP(bf16, (q & 1) ? WS_WV : WS_WK) + (size_t)(q >> 1) * DM * DM, DM, DM, DM}; pg8::StaticOrder S; S.init(MMEM, DM, g2, (c2 + 4 * g2 - 64 * q) % g2, DM, DM);
                            pg8::EpiK E{WSP(bf16, (q & 1) ? WS_VT : WS_KB) + (size_t)(q >> 1) * MMEM * DM, WSP(float, WS_RMEM)};
                            GEMM_CALL<pg8::EpiK, pg8::StaticOrder, true, true>(F.lds, g, S, E); }
                        convert_rest(F, c2 * NWAVES + F.wave, g2 * NWAVES);
                        sub_barrier(F, (unsigned*)(F.ws + WS_CTL) + 900, (unsigned)g2);
                        {   int k256 = 256; asm volatile("" : "+s"(k256));
                            {   pg8::Gemm g{WSP(bf16, WS_KB), WSP(bf16, WS_WQ), k256, DM, DM}; pg8::SubOrder S{g2, (c2 + 64) % g2, 0};
                                pg8::EpiSub E{QO, 0};
                                GEMM_CALL<pg8::EpiSub, pg8::SubOrder, true, true>(F.lds, g, S, E); }
                            {   pg8::Gemm g{WSP(bf16, WS_WO), WSP(bf16, WS_VT), k256, DM, DM}; pg8::SubOrder S{g2, (c2 + 128) % g2, 1};
                                pg8::EpiSub E{QO + (size_t)16 * DM * DM, 1};
                                GEMM_CALL<pg8::EpiSub, pg8::SubOrder, true, true>(F.lds, g, S, E); } }
                    } }
            } else {
                for (int rep = 0; rep < REP_MOBA; ++rep)
                for (int p = vcu; p < 512; p += F.G) { const int b = p >> 5, hd = (p >> 2) & 7, pj = p & 3; MOBA_CALL(F, b, hd, 7 - pj); MOBA_CALL(F, b, hd, pj); }
                for (int rep = 0; rep < REP_SGU; ++rep)
                SGU_CALL(F, vcu, F.G);
            }
        } SEAM(pb);
        if (IN(pb + 1)) { PH_ENTER();
            if (l == 1) {
            int k256 = 256; asm volatile("" : "+s"(k256));
            {   pg8::Gemm g{WSP(bf16, WS_KB) + (size_t)l * MMEM * DM, WSP(bf16, WS_WQ) + (size_t)l * DM * DM, k256, DM, DM}; pg8::SubOrder S{F.G, F.bid, 0};
                pg8::EpiSub E{BIG, 0};
#ifndef DIS_SUB
                GEMM_CALL<pg8::EpiSub, pg8::SubOrder, true, true>(F.lds, g, S, E);
#endif
 }
            {   pg8::Gemm g{WSP(bf16, WS_WO) + (size_t)l * DM * DM, WSP(bf16, WS_VT) + (size_t)l * MMEM * DM, k256, DM, DM}; pg8::SubOrder S{F.G, F.bid, 1};
                pg8::EpiSub E{BIG + (size_t)16 * DM * DM, 1};
#ifndef DIS_SUB
                GEMM_CALL<pg8::EpiSub, pg8::SubOrder, true, true>(F.lds, g, S, E);
#endif
 }
            }
            pg8::Gemm g{MIX, WSP(bf16, l == 0 ? WS_WOUT0 : WS_WOUT1), DM, DM, DM}; pg8::StaticOrder S; S.init(MROWS, DM, F.G, F.bid, DM, DM);
            constexpr int j = 1 + 3 * l;
            for (int i = F.bid * (NWAVES * 64) + F.tid; i < MROWS; i += F.G * NWAVES * 64) (SSQ + ((j + 1) & 1) * MROWS)[i] = 0.f;
            pg8::EpiRes E{XB, nullptr, SSQ + (j & 1) * MROWS};
            GEMM_CALL<pg8::EpiRes, pg8::StaticOrder, true, true>(F.lds, g, S, E);
        } SEAM(pb + 1);
        if (IN(pb + 2)) { PH_ENTER();
            pg8::Gemm g{XB, l == 0 ? QO : BIG, DM, DM, DM}; pg8::StaticOrder S; S.init(MROWS, DM, F.G, F.bid, DM, DM, DM);
            pg8::EpiSoftmax E{MIX, SSQ + ((1 + 3 * l) & 1) * MROWS, (LAS float*)(F.lds + RING_BYTES)};
#ifndef DIS_SM
            GEMM_CALL<pg8::EpiSoftmax, pg8::StaticOrder, true, true>(F.lds, g, S, E);
#endif
        } SEAM(pb + 2);
        if (IN(pb + 3)) { PH_ENTER();
            pg8::Gemm g{MIX, (l == 0 ? QO : BIG) + (size_t)16 * DM * DM, DM, DM, DM}; pg8::StaticOrder S; S.init(MROWS, DM, F.G, F.bid, DM, DM, DM);
            constexpr int j = 2 + 3 * l;
            for (int i = F.bid * (NWAVES * 64) + F.tid; i < MROWS; i += F.G * NWAVES * 64) (SSQ + ((j + 1) & 1) * MROWS)[i] = 0.f;
            pg8::EpiRes E{XB, nullptr, SSQ + (j & 1) * MROWS};
            GEMM_CALL<pg8::EpiRes, pg8::StaticOrder, true, true>(F.lds, g, S, E);
        } SEAM(pb + 3);
        if (IN(pb + 4)) { PH_ENTER();
            pg8::Gemm g{XB, WSP(bf16, WS_WFI) + (size_t)l * DM * 2 * FFH, DM, DM, DM}; pg8::StaticOrder S; S.init(MROWS, 2 * FFH, F.G, F.bid, DM, DM);
            pg8::EpiFfn E{BIG, SSQ + ((2 + 3 * l) & 1) * MROWS};
            for (int rep = 0; rep < REP_FFN; ++rep)
            GEMM_CALL<pg8::EpiFfn, pg8::StaticOrder, true, true>(F.lds, g, S, E);
        } SEAM(pb + 4);
        if (IN(pb + 5)) { PH_ENTER();
            pg8::Gemm g{BIG, WSP(bf16, WS_WFO) + (size_t)l * FFH * DM, FFH, FFH, FFH}; pg8::StaticOrder S; S.init(MROWS, DM, F.G, F.bid, FFH, FFH);
            constexpr int j = 3 + 3 * l;
            for (int i = F.bid * (NWAVES * 64) + F.tid; i < MROWS; i += F.G * NWAVES * 64) (SSQ + ((j + 1) & 1) * MROWS)[i] = 0.f;
            pg8::EpiRes E{XB, nullptr, SSQ + (j & 1) * MROWS};
            GEMM_CALL<pg8::EpiRes, pg8::StaticOrder, true, true>(F.lds, g, S, E);
        } SEAM(pb + 5);

#undef IN
#undef SEAM
#undef PH_ENTER
#undef XB
#undef BIG
#undef MIX
#undef QO
#undef SSQ
}

__global__ void __launch_bounds__(NWAVES * 64, 2) fwd_kernel(Args args) {
    extern __shared__ __attribute__((aligned(16))) unsigned char lds[];
    Frame F;
    F.lds = (LAS unsigned char*)lds;
    F.tid = threadIdx.x; F.lane = F.tid & 63; F.wave = __builtin_amdgcn_readfirstlane(F.tid >> 6);
    F.G = gridDim.x; F.bid = blockIdx.x;
    F.ka = (const CAS Args*)__builtin_amdgcn_kernarg_segment_ptr();
    F.out = args.out; F.ws = args.ws;
    const int vcu = (F.G % 8 == 0) ? (F.bid % 8) * (F.G / 8) + F.bid / 8 : F.bid;
    volatile LAS unsigned* MISC = (volatile LAS unsigned*)(F.lds + MISC_OFF);
    for (int u = F.tid; u < (LDS_BYTES - LDSCTL_OFF) / 4; u += NWAVES * 64) ((LAS unsigned*)(F.lds + LDSCTL_OFF))[u] = 0u;
    __syncthreads();
    const int lo = args.ph_lo, hi = args.ph_hi;
    unsigned* barw = (unsigned*)(F.ws + WS_CTL) + CW_BAR;
    XcdBarrier bar; bar.bar = barw; bar.x = 0; bar.st = nullptr;
    if (hi - lo > 1) bar = xcd_barrier_post(barw, MISC + 8);
#define IN(k) (lo <= (k) && (k) < hi)
#define PH_ENTER() asm volatile("" : "+s"(F.ws), "+s"(F.out))
#define SEAM(k) do { if (IN(k) && IN((k) + 1)) xcd_barrier(bar); } while (0)
#define XB WSP(bf16, WS_XB)
#define BIG WSP(bf16, WS_BIG)
#define MIX WSP(bf16, WS_MIX)
#define QO WSP(bf16, WS_QO)
#define SSQ WSP(float, WS_SSQ)

    #ifndef DIS_P0
    for (int rep = 0; rep < REP_P0; ++rep)
    if (IN(0)) { PH_ENTER(); p0_prologue(F); }
#endif
    SEAM(0);

    if (IN(1)) { PH_ENTER();
        pg8::Gemm g{XB, WSP(bf16, WS_WIN0), DM, DM, DM}; pg8::StaticOrder S; S.init(MROWS, 3072, F.G, F.bid, DM, DM);
        pg8::EpiIn0 E{BIG, SSQ, WSP(float, WS_LB)};
        GEMM_CALL<pg8::EpiIn0, pg8::StaticOrder, true, true>(F.lds, g, S, E);
    } SEAM(1);

    layer_phases<0>(F, lo, hi, bar, vcu);
    layer_phases<1>(F, lo, hi, bar, vcu);
    #ifndef DIS_FIN
    if (IN(15)) final_norm(F);
#endif
#undef IN
#undef SEAM
#undef XB
#undef BIG
#undef MIX
#undef QO
#undef SSQ
}

extern "C" void kernel_launch(void* const* d_in, const int* in_sizes, int n_in, void* d_out, int out_size, void* d_ws, size_t ws_size, hipStream_t stream) {
    static int grid = 0;
    if (grid == 0) {
        if (n_in != 26 || in_sizes[0] != MROWS * DM || out_size != MROWS * DM || ws_size < WS_END) {
            fprintf(stderr, "kernel_launch: unexpected shapes (n_in %d, in0 %d, out %d, ws %zu); nothing launched\n", n_in, n_in > 0 ? in_sizes[0] : -1, out_size, ws_size); grid = -1; return; }
        int dev = 0, cus = 0;
        if (hipGetDevice(&dev) != hipSuccess || hipDeviceGetAttribute(&cus, hipDeviceAttributeMultiprocessorCount, dev) != hipSuccess) { fprintf(stderr, "kernel_launch: device query failed\n"); grid = -1; return; }
        if (hipFuncSetAttribute((const void*)fwd_kernel, hipFuncAttributeMaxDynamicSharedMemorySize, LDS_BYTES) != hipSuccess) { fprintf(stderr, "kernel_launch: hipFuncSetAttribute failed\n"); grid = -1; return; }
        (void)hipGetLastError();
        grid = cus > 256 ? 256 : cus;
    }
    if (grid < 0) return;
    (void)hipMemsetAsync((char*)d_ws + WS_CTL, 0, CTL_ZERO_BYTES, stream);
    Args a{};
    for (int i = 0; i < 26; ++i) a.in[i] = (const float*)d_in[i];
    a.out = (float*)d_out; a.ws = (unsigned char*)d_ws;
#if MK_ONE_LAUNCH
    a.ph_lo = 0; a.ph_hi = NPH;
    hipLaunchKernelGGL(fwd_kernel, dim3(grid), dim3(NWAVES * 64), LDS_BYTES, stream, a);
#else
    for (int p = 0; p < NPH; ++p) { a.ph_lo = p; a.ph_hi = p + 1; hipLaunchKernelGGL(fwd_kernel, dim3(grid), dim3(NWAVES * 64), LDS_BYTES, stream, a); }
#endif
}
```

```cpp
#include <hip/hip_runtime.h>
#include <cstdio>
#include <cstdint>
#include <cmath>
namespace pg8 {
#define PG8_LAS __attribute__((address_space(3)))
typedef unsigned short bf16_t;
typedef short bf16x8 __attribute__((ext_vector_type(8)));
typedef float f32x4 __attribute__((ext_vector_type(4)));
typedef unsigned u32x4 __attribute__((ext_vector_type(4)));
constexpr int BM = 256, BK = 64, HALF = 128, HTB = HALF * BK * 2  , STAGE_BYTES = 8 * HTB, NXCD = 8, WGM = 8;

__host__ __device__ __forceinline__ int lds_byte(int r, int c) { const int st = (r >> 4) * 2 + (c >> 5), rr = r & 15, cc = c & 31, ob = rr * 64 + cc * 2; return st * 1024 + (ob ^ (((ob >> 9) & 1) << 5)); }
__host__ __device__ __forceinline__ void stage_rc(int b, int& R, int& C) { const int st = b / 1024, sb = b % 1024, swz = sb ^ (((sb >> 9) & 1) << 5); R = (st >> 1) * 16 + swz / 64; C = (st & 1) * 32 + (swz % 64) / 2; }
__host__ __device__ __forceinline__ int perm32(int rho) { const int n = rho >> 4, i = rho & 15; return 8 * (i >> 2) + 4 * n + (i & 3); }

struct Unit { int pm, pn; unsigned aoff, boff; };
struct Gemm { const bf16_t* A; const bf16_t* Bt; int K, lda, ldb; };

struct StaticOrder {
    int nM, nN, nwg, G, c, lda, ldb, bbatch;
    __host__ __device__ void init(int M, int N, int G_, int c_, int lda_, int ldb_, int bbatch_ = 0) { nM = M / BM; nN = N / BM; nwg = nM * nN; G = G_; c = c_; lda = lda_; ldb = ldb_; bbatch = bbatch_; }
    __host__ __device__ bool next(int i, Unit& u) const {
        const long L = (long)i * G + c; if (L >= nwg) return false;
        int wgid = (int)L; { const int q = nwg / NXCD, r = nwg % NXCD, xcd = wgid % NXCD, off = wgid / NXCD; wgid = (xcd < r ? xcd * (q + 1) : r * (q + 1) + (xcd - r) * q) + off; }
        const int nig = WGM * nN, gid = wgid / nig, fm = gid * WGM, gsz = (nM - fm) < WGM ? (nM - fm) : WGM;
        u.pm = fm + ((wgid % nig) % gsz); u.pn = (wgid % nig) / gsz;
        u.aoff = (unsigned)u.pm * (unsigned)(BM * lda); u.boff = ((unsigned)u.pn * BM + (unsigned)(u.pm >> 3) * (unsigned)bbatch) * (unsigned)ldb; return true;
    }
    __device__ __forceinline__ void a_ready(const Unit&) const {}
    __device__ __forceinline__ void done(const Unit&) const {}
};

typedef _Float16 h16x8 __attribute__((ext_vector_type(8))); typedef _Float16 h16x2 __attribute__((ext_vector_type(2))); typedef float f32x2c __attribute__((ext_vector_type(2)));
__device__ __forceinline__ unsigned cvt_pk_bf16(float lo, float hi) { const f32x2c v = {lo, hi}; const h16x2 h = __builtin_convertvector(v, h16x2); return __builtin_bit_cast(unsigned, h); }
typedef float f32x2 __attribute__((ext_vector_type(2)));
__device__ __forceinline__ f32x2 gelu_pk(f32x2 v) {
    const f32x2 av = __builtin_elementwise_abs(v), d = av * 0.2316418882f + 1.0f;
    f32x2 t; t.x = __builtin_amdgcn_rcpf(d.x); t.y = __builtin_amdgcn_rcpf(d.y);
    f32x2 q = t * 0.5307027145f + (-0.7265760135f); q = q * t + 0.7107068705f; q = q * t + (-0.142248368f); q = q * t + 0.127414796f; q = q * t;
    const f32x2 s = (v * v) * (-0.72134752044f);
    f32x2 e; e.x = __builtin_amdgcn_exp2f(s.x); e.y = __builtin_amdgcn_exp2f(s.y);
    const f32x2 m = v * (q * e), r = v - m;
    f32x2 o; o.x = v.x < 0.f ? m.x : r.x; o.y = v.y < 0.f ? m.y : r.y; return o;
}


constexpr int RM = 32768;
constexpr float EPS_ = 1e-6f, LOG2E_ = 1.4426950408889634f;
__device__ __forceinline__ float sigm(float x) { return __builtin_amdgcn_rcpf(1.0f + __builtin_amdgcn_exp2f(-x * LOG2E_)); }
__device__ __forceinline__ float silu_(float x) { return x * sigm(x); }
__device__ __forceinline__ u32x4 pack8(const f32x4 a, const f32x4 b) { u32x4 w; w.x = cvt_pk_bf16(a[0], a[1]); w.y = cvt_pk_bf16(a[2], a[3]); w.z = cvt_pk_bf16(b[0], b[1]); w.w = cvt_pk_bf16(b[2], b[3]); return w; }
__device__ __forceinline__ void row_scales(const float* ssq, int pm, int wr, int lane, float (&v)[2]) {
#pragma unroll
    for (int ai = 0; ai < 2; ++ai) v[ai] = 1.0f / sqrtf(ssq[pm * BM + ai * HALF + wr * 64 + lane] * (1.0f / 1024.0f) + EPS_);
}
#define ROWSCALE(ai, m) __shfl(rv[ai], 16 * (m) + fr)
#define ROWFENCE() asm volatile("" ::: "memory")
__device__ __forceinline__ f32x2 swiglu_pk(f32x2 a, f32x2 g) {
    const f32x2 t = a * (-LOG2E_); f32x2 e; e.x = __builtin_amdgcn_exp2f(t.x); e.y = __builtin_amdgcn_exp2f(t.y);
    const f32x2 d = e + 1.0f; f32x2 s; s.x = __builtin_amdgcn_rcpf(d.x); s.y = __builtin_amdgcn_rcpf(d.y);
    return (a * g) * s;
}
__device__ __forceinline__ f32x2 xsig_pk(f32x2 x, f32x2 y) {
    const f32x2 t = y * (-LOG2E_); f32x2 e; e.x = __builtin_amdgcn_exp2f(t.x); e.y = __builtin_amdgcn_exp2f(t.y);
    const f32x2 d = e + 1.0f; f32x2 s; s.x = __builtin_amdgcn_rcpf(d.x); s.y = __builtin_amdgcn_rcpf(d.y);
    return x * s;
}
__device__ __forceinline__ f32x4 xsig4(const f32x4 x, const f32x4 y) { const f32x2 lo = xsig_pk((f32x2){x[0], x[1]}, (f32x2){y[0], y[1]}), hi = xsig_pk((f32x2){x[2], x[3]}, (f32x2){y[2], y[3]}); return (f32x4){lo.x, lo.y, hi.x, hi.y}; }
struct EpiIn0 {
    static constexpr bool PERM = true, AFTER_DRAIN = false;
    bf16_t* P; const float* ssq; const float* lb;
    __device__ __forceinline__ void operator()(const f32x4 (&acc)[2][2][4][2], const Unit& u, int wr, int wc, int fr, int fq) const {
        float rv[2]; row_scales(ssq, u.pm, wr, fq * 16 + fr, rv);
        const int row0 = u.pm * BM + wr * 64 + fr, pn = u.pn;
        if (pn < 8) {
            const int typ = pn >> 1;
#pragma unroll
            for (int bj = 0; bj < 2; ++bj) { const int col0 = pn * BM + bj * HALF + wc * 32 + 8 * fq;
                f32x4 l0 = (f32x4){0.f, 0.f, 0.f, 0.f}, l1 = l0;
                if (typ == 1) { l0 = 1.0f - *(const f32x4*)(lb + col0 - 512); l1 = 1.0f - *(const f32x4*)(lb + col0 - 508); }
#pragma unroll
                for (int ai = 0; ai < 2; ++ai)
#pragma unroll
                    for (int m = 0; m < 4; ++m) { const float r = ROWSCALE(ai, m); f32x4 v0 = acc[ai][bj][m][0] * r, v1 = acc[ai][bj][m][1] * r;
                        if (typ == 0 || typ == 3) { v0 = xsig4(v0, v0); v1 = xsig4(v1, v1); }
                        else if (typ == 1) { v0 = xsig4(l0, -v0); v1 = xsig4(l1, -v1); }
                        *(u32x4*)(P + (size_t)(row0 + ai * HALF + m * 16) * 2560 + col0) = pack8(v0, v1); ROWFENCE(); } }
        } else {
            const int col0 = 2048 + (pn - 8) * HALF + wc * 32 + 8 * fq;
#pragma unroll
            for (int ai = 0; ai < 2; ++ai)
#pragma unroll
                for (int m = 0; m < 4; ++m) { const float r = ROWSCALE(ai, m);
                    const f32x4 v0 = xsig4(acc[ai][0][m][0] * r, acc[ai][1][m][0] * r), v1 = xsig4(acc[ai][0][m][1] * r, acc[ai][1][m][1] * r);
                    *(u32x4*)(P + (size_t)(row0 + ai * HALF + m * 16) * 2560 + col0) = pack8(v0, v1); ROWFENCE(); }
        }
    }
};
struct EpiIn1 {
    static constexpr bool PERM = true, AFTER_DRAIN = false;
    bf16_t* P; const float* ssq; float* kpart; float qscale;
    __device__ __forceinline__ void operator()(const f32x4 (&acc)[2][2][4][2], const Unit& u, int wr, int wc, int fr, int fq) const {
        float rv[2]; row_scales(ssq, u.pm, wr, fq * 16 + fr, rv);
        const int row0 = u.pm * BM + wr * 64 + fr, pn = u.pn;
        const int typ = pn < 2 ? 0 : (pn < 4 ? 1 : (pn < 6 ? 2 : 3));
#pragma unroll
        for (int bj = 0; bj < 2; ++bj) { const int col0 = pn * BM + bj * HALF + wc * 32 + 8 * fq;
            f32x4 cs0 = (f32x4){0.f, 0.f, 0.f, 0.f}, cs1 = cs0;
#pragma unroll
            for (int ai = 0; ai < 2; ++ai)
#pragma unroll
                for (int m = 0; m < 4; ++m) { const float r = ROWSCALE(ai, m); f32x4 v0 = acc[ai][bj][m][0] * r, v1 = acc[ai][bj][m][1] * r;
                    if (typ == 0) { v0 = v0 * qscale; v1 = v1 * qscale; }
                    else if (typ == 1) { cs0 += v0; cs1 += v1; }
                    else if (typ == 3) { f32x2 a = gelu_pk((f32x2){v0[0], v0[1]}), b = gelu_pk((f32x2){v0[2], v0[3]}), c = gelu_pk((f32x2){v1[0], v1[1]}), d = gelu_pk((f32x2){v1[2], v1[3]});
                        v0 = (f32x4){a.x, a.y, b.x, b.y}; v1 = (f32x4){c.x, c.y, d.x, d.y}; }
                    *(u32x4*)(P + (size_t)(row0 + ai * HALF + m * 16) * 2560 + col0) = pack8(v0, v1); ROWFENCE(); }
            if (typ == 1) {
#pragma unroll
                for (int i = 0; i < 4; ++i) {
#pragma unroll
                    for (int o = 1; o < 16; o <<= 1) { cs0[i] += __shfl_xor(cs0[i], o); cs1[i] += __shfl_xor(cs1[i], o); } }
                if (fr == 0) { float* kp = kpart + (size_t)(u.pm * 2 + wr) * 512 + (col0 - 512); *(f32x4*)kp = cs0; *(f32x4*)(kp + 4) = cs1; }
            } }
    }
};
struct EpiRes {
    static constexpr bool PERM = true, AFTER_DRAIN = false;
    bf16_t* xb; float* outf; float* ssqw;
    __device__ __forceinline__ void operator()(const f32x4 (&acc)[2][2][4][2], const Unit& u, int wr, int wc, int fr, int fq) const {
        const int row0 = u.pm * BM + wr * 64 + fr;
#pragma unroll
        for (int ai = 0; ai < 2; ++ai)
#pragma unroll
            for (int m = 0; m < 4; ++m) { const int row = row0 + ai * HALF + m * 16; float ss = 0.f;
#pragma unroll
                for (int bj = 0; bj < 2; ++bj) { const size_t off = (size_t)row * 1024 + u.pn * BM + bj * HALF + wc * 32 + 8 * fq;
                    const u32x4 b = *(const u32x4*)(xb + off);
                    const h16x8 bh = __builtin_bit_cast(h16x8, b);
                    const f32x4 b0 = (f32x4){(float)bh[0], (float)bh[1], (float)bh[2], (float)bh[3]};
                    const f32x4 b1 = (f32x4){(float)bh[4], (float)bh[5], (float)bh[6], (float)bh[7]};
                    const f32x4 v0 = b0 + acc[ai][bj][m][0], v1 = b1 + acc[ai][bj][m][1];
                    ss += (v0[0] * v0[0] + v0[1] * v0[1]) + (v0[2] * v0[2] + v0[3] * v0[3]) + (v1[0] * v1[0] + v1[1] * v1[1]) + (v1[2] * v1[2] + v1[3] * v1[3]);
                    if (outf) { *(f32x4*)(outf + off) = v0; *(f32x4*)(outf + off + 4) = v1; }
                    else *(u32x4*)(xb + off) = pack8(v0, v1); }
                ss += __shfl_xor(ss, 16); ss += __shfl_xor(ss, 32);
                if (fq == 0) atomicAdd(ssqw + row, ss);
                ROWFENCE(); }
    }
};
struct EpiFfn {
    static constexpr bool PERM = true, AFTER_DRAIN = false;
    bf16_t* H; const float* ssq;
    __device__ __forceinline__ void operator()(const f32x4 (&acc)[2][2][4][2], const Unit& u, int wr, int wc, int fr, int fq) const {
        float rv[2]; row_scales(ssq, u.pm, wr, fq * 16 + fr, rv);
        const int row0 = u.pm * BM + wr * 64 + fr, col0 = u.pn * HALF + wc * 32 + 8 * fq;
#pragma unroll
        for (int ai = 0; ai < 2; ++ai)
#pragma unroll
            for (int m = 0; m < 4; ++m) { const float r = ROWSCALE(ai, m);
                const f32x4 a0 = acc[ai][0][m][0] * r, a1 = acc[ai][0][m][1] * r, g0 = acc[ai][1][m][0] * r, g1 = acc[ai][1][m][1] * r;
                const f32x2 p0 = swiglu_pk((f32x2){a0[0], a0[1]}, (f32x2){g0[0], g0[1]}), p1 = swiglu_pk((f32x2){a0[2], a0[3]}, (f32x2){g0[2], g0[3]}),
                            p2 = swiglu_pk((f32x2){a1[0], a1[1]}, (f32x2){g1[0], g1[1]}), p3 = swiglu_pk((f32x2){a1[2], a1[3]}, (f32x2){g1[2], g1[3]});
                *(u32x4*)(H + (size_t)(row0 + ai * HALF + m * 16) * 2816 + col0) = pack8((f32x4){p0.x, p0.y, p1.x, p1.y}, (f32x4){p2.x, p2.y, p3.x, p3.y}); ROWFENCE(); }
    }
};
struct SubOrder {
    int G, c, mode;
    __device__ __forceinline__ bool next(int i, Unit& u) const {
        const int L = i * G + c; if (L >= 256) return false;
        const unsigned b = L >> 4, h = (L >> 2) & 3, t = L & 3; u.pm = L; u.pn = 0;
        const unsigned x = (b * 256u) * 1024u + h * 256u, y = (t * 256u) * 1024u + h * 256u;
        u.aoff = mode == 0 ? x : y; u.boff = mode == 0 ? y : x; return true;
    }
    __device__ __forceinline__ void a_ready(const Unit&) const {}
    __device__ __forceinline__ void done(const Unit&) const {}
};
struct EpiSub {
    static constexpr bool PERM = true, AFTER_DRAIN = false;
    bf16_t* O; int mode;
    __device__ __forceinline__ void operator()(const f32x4 (&acc)[2][2][4][2], const Unit& u, int wr, int wc, int fr, int fq) const {
        const int L = u.pm, b = L >> 4, h = (L >> 2) & 3, t = L & 3;
        const int rb = b * 1024 + (mode == 0 ? h : t) * 256 + wr * 64 + fr, cb = (mode == 0 ? t : h) * 256 + wc * 32 + 8 * fq;
#pragma unroll
        for (int ai = 0; ai < 2; ++ai)
#pragma unroll
            for (int m = 0; m < 4; ++m)
#pragma unroll
                for (int bj = 0; bj < 2; ++bj) *(u32x4*)(O + (size_t)(rb + ai * HALF + m * 16) * 1024 + cb + bj * HALF) = pack8(acc[ai][bj][m][0], acc[ai][bj][m][1]);
    }
};
struct EpiSoftmax {
    static constexpr bool PERM = true, AFTER_DRAIN = false;
    bf16_t* P; const float* ssq; PG8_LAS float* scr;
    __device__ __forceinline__ void operator()(f32x4 (&acc)[2][2][4][2], const Unit& u, int wr, int wc, int fr, int fq) const {
        float rv[2]; row_scales(ssq, u.pm, wr, fq * 16 + fr, rv);
        PG8_LAS float* MX = scr; PG8_LAS float* SM = scr + 1024;
        float mx[2][4];
#pragma unroll
        for (int ai = 0; ai < 2; ++ai)
#pragma unroll
            for (int m = 0; m < 4; ++m) { const float r = ROWSCALE(ai, m); float v = -3.0e38f;
#pragma unroll
                for (int bj = 0; bj < 2; ++bj)
#pragma unroll
                    for (int n = 0; n < 2; ++n) { acc[ai][bj][m][n] = acc[ai][bj][m][n] * r; const f32x4 x = acc[ai][bj][m][n]; v = fmaxf(v, fmaxf(fmaxf(x[0], x[1]), fmaxf(x[2], x[3]))); }
                v = fmaxf(v, __shfl_xor(v, 16)); v = fmaxf(v, __shfl_xor(v, 32));
                if (fq == 0) MX[(ai * HALF + wr * 64 + m * 16 + fr) * 4 + wc] = v; }
        asm volatile("s_waitcnt lgkmcnt(0)" ::: "memory"); __builtin_amdgcn_s_barrier(); asm volatile("" ::: "memory");
#pragma unroll
        for (int ai = 0; ai < 2; ++ai)
#pragma unroll
            for (int m = 0; m < 4; ++m) { const f32x4 q = *(const PG8_LAS f32x4*)(MX + (ai * HALF + wr * 64 + m * 16 + fr) * 4); const float mm = fmaxf(fmaxf(q[0], q[1]), fmaxf(q[2], q[3])); float sm = 0.f;
#pragma unroll
                for (int bj = 0; bj < 2; ++bj)
#pragma unroll
                    for (int n = 0; n < 2; ++n) { f32x4 x = acc[ai][bj][m][n];
#pragma unroll
                        for (int i = 0; i < 4; ++i) { x[i] = __builtin_amdgcn_exp2f(x[i] - mm); sm += x[i]; }
                        acc[ai][bj][m][n] = x; }
                sm += __shfl_xor(sm, 16); sm += __shfl_xor(sm, 32);
                if (fq == 0) SM[(ai * HALF + wr * 64 + m * 16 + fr) * 4 + wc] = sm; }
        asm volatile("s_waitcnt lgkmcnt(0)" ::: "memory"); __builtin_amdgcn_s_barrier(); asm volatile("" ::: "memory");
        const int row0 = u.pm * BM + wr * 64 + fr;
#pragma unroll
        for (int ai = 0; ai < 2; ++ai)
#pragma unroll
            for (int m = 0; m < 4; ++m) { const f32x4 q = *(const PG8_LAS f32x4*)(SM + (ai * HALF + wr * 64 + m * 16 + fr) * 4); const float inv = __builtin_amdgcn_rcpf((q[0] + q[1]) + (q[2] + q[3]));
#pragma unroll
                for (int bj = 0; bj < 2; ++bj) *(u32x4*)(P + (size_t)(row0 + ai * HALF + m * 16) * 1024 + u.pn * BM + bj * HALF + wc * 32 + 8 * fq) = pack8(acc[ai][bj][m][0] * inv, acc[ai][bj][m][1] * inv);
                ROWFENCE(); }
    }
};
struct EpiK {
    static constexpr bool PERM = true, AFTER_DRAIN = false;
    bf16_t* O; const float* rmem;
    __device__ __forceinline__ void operator()(const f32x4 (&acc)[2][2][4][2], const Unit& u, int wr, int wc, int fr, int fq) const {
        const int row0 = u.pm * BM + wr * 64 + fr;
#pragma unroll
        for (int ai = 0; ai < 2; ++ai)
#pragma unroll
            for (int m = 0; m < 4; ++m) { const int row = row0 + ai * HALF + m * 16; const float r = rmem[row];
#pragma unroll
                for (int bj = 0; bj < 2; ++bj) *(u32x4*)(O + (size_t)row * 1024 + u.pn * BM + bj * HALF + wc * 32 + 8 * fq) = pack8(acc[ai][bj][m][0] * r, acc[ai][bj][m][1] * r); }
    }
};
template <class Epi, class Sched, bool ALIGN_EPI = false, bool SP2 = false>
__device__ __forceinline__ void gemm_phase(PG8_LAS unsigned char* lds, const Gemm g, const Sched& S, const Epi& E) {
    int tid_ = threadIdx.x; asm volatile("" : "+v"(tid_));
    const int tid = tid_, wid = __builtin_amdgcn_readfirstlane(tid >> 6), lane = tid & 63, wr = wid >> 2, wc = wid & 3, fr = lane & 15, fq = lane >> 4;
    const int K = g.K, nt = K / BK;
    unsigned voffA[2], voffB[2];
#pragma unroll
    for (int i = 0; i < 2; ++i) { int R, C; stage_rc(tid * 16 + i * 8192, R, C); const int Rb = Epi::PERM ? ((R & ~31) + perm32(R & 31)) : R;
        voffA[i] = (unsigned)(R * g.lda + C) * 2u; voffB[i] = (unsigned)(Rb * g.ldb + C) * 2u; }
    const size_t kstep = (size_t)(BK * 2);
    const size_t hstepA = (size_t)HALF * g.lda * 2, hstepB = (size_t)HALF * g.ldb * 2;
    const unsigned ldsw = (unsigned)wid * 1024u;
    const int aoff = lds_byte(wr * 64 + fr, fq * 8), boff = lds_byte(wc * 32 + fr, fq * 8);
#define PG8_SA(b, h) (((b) * 2 + (h)) * HTB)
#define PG8_SB(b, h) ((4 + (b) * 2 + (h)) * HTB)
#define PG8_STAGE(bufoff, gbase, voff) do { _Pragma("unroll") for (int _i = 0; _i < 2; ++_i) \
        __builtin_amdgcn_global_load_lds((const unsigned*)((const char*)(gbase) + (voff)[_i]), (PG8_LAS unsigned*)(lds + (bufoff) + ldsw + _i * 8192), 16, 0, 0); } while (0)
#define PG8_LDA(dst, b, h) do { _Pragma("unroll") for (int m = 0; m < 4; ++m) _Pragma("unroll") for (int k = 0; k < 2; ++k) dst[m][k] = *(const PG8_LAS bf16x8*)(lds + PG8_SA(b, h) + aoff + m * 2048 + k * 1024); } while (0)
#define PG8_LDB(dst, b, h) do { _Pragma("unroll") for (int n = 0; n < 2; ++n) _Pragma("unroll") for (int k = 0; k < 2; ++k) dst[n][k] = *(const PG8_LAS bf16x8*)(lds + PG8_SB(b, h) + boff + n * 2048 + k * 1024); } while (0)
#define PG8_MMA(ai, bj, At, Bt) do { __builtin_amdgcn_s_setprio(1); _Pragma("unroll") for (int m = 0; m < 4; ++m) _Pragma("unroll") for (int n = 0; n < 2; ++n) _Pragma("unroll") for (int k = 0; k < 2; ++k) \
        acc[ai][bj][m][n] = __builtin_amdgcn_mfma_f32_16x16x32_f16(__builtin_bit_cast(h16x8, Bt[n][k]), __builtin_bit_cast(h16x8, At[m][k]), acc[ai][bj][m][n], 0, 0, 0); __builtin_amdgcn_s_setprio(0); } while (0)
#define PG8_WAIT_V(n) asm volatile("s_waitcnt vmcnt(" #n ")" ::: "memory")
#define PG8_WAIT_L(n) asm volatile("s_waitcnt lgkmcnt(" #n ")" ::: "memory")
#define PG8_BAR __builtin_amdgcn_s_barrier()
#define PG8_SCHED __builtin_amdgcn_sched_barrier(0)
    Unit cur, nxt; int ui = 0;
    if (!S.next(0, cur)) return;
    f32x4 acc[2][2][4][2];
#pragma unroll
    for (int a = 0; a < 2; ++a)
#pragma unroll
        for (int b = 0; b < 2; ++b)
#pragma unroll
            for (int m = 0; m < 4; ++m)
#pragma unroll
                for (int n = 0; n < 2; ++n) acc[a][b][m][n] = (f32x4){0.f, 0.f, 0.f, 0.f};
    bf16x8 At[4][2], B0[2][2], B1[2][2];
    const char* cA = (const char*)g.A + (size_t)cur.aoff * 2; const char* cB = (const char*)g.Bt + (size_t)cur.boff * 2;
    S.a_ready(cur);
    if constexpr (SP2) {
        PG8_STAGE(PG8_SB(0, 0), cB, voffB); PG8_STAGE(PG8_SB(0, 1), cB + hstepB, voffB); PG8_STAGE(PG8_SA(0, 0), cA, voffA); PG8_STAGE(PG8_SA(0, 1), cA + hstepA, voffA);
        if (wr == 1) PG8_BAR;
        PG8_WAIT_V(2); PG8_BAR;
        PG8_STAGE(PG8_SB(1, 0), cB + kstep, voffB); PG8_STAGE(PG8_SA(1, 0), cA + kstep, voffA); PG8_STAGE(PG8_SB(1, 1), cB + hstepB + kstep, voffB);
        PG8_WAIT_V(6); PG8_BAR;
    } else {
        PG8_STAGE(PG8_SB(0, 0), cB, voffB); PG8_STAGE(PG8_SA(0, 0), cA, voffA); PG8_STAGE(PG8_SB(0, 1), cB + hstepB, voffB); PG8_STAGE(PG8_SA(0, 1), cA + hstepA, voffA);
        if (wr == 1) PG8_BAR;
        PG8_WAIT_V(4); PG8_BAR;
        PG8_STAGE(PG8_SB(1, 0), cB + kstep, voffB); PG8_STAGE(PG8_SA(1, 0), cA + kstep, voffA); PG8_STAGE(PG8_SB(1, 1), cB + hstepB + kstep, voffB);
        PG8_WAIT_V(6); PG8_BAR;
    }
    for (;;) {
        const bool has_next = S.next(ui + 1, nxt);
        const char* nA = has_next ? (const char*)g.A + (size_t)nxt.aoff * 2 : cA; const char* nB = has_next ? (const char*)g.Bt + (size_t)nxt.boff * 2 : cB;
        for (int t = 0; t < nt; t += 2) {
            const bool last = (t == nt - 2);
            const char* a1 = cA + (size_t)(t + 1) * kstep;
            const char* a2 = last ? nA : cA + (size_t)(t + 2) * kstep; const char* b2 = last ? nB : cB + (size_t)(t + 2) * kstep;
            const char* a3 = a2 + kstep; const char* b3 = b2 + kstep;
            if (last && has_next) S.a_ready(nxt);
            if constexpr (SP2) {
            PG8_LDB(B0, 0, 0); PG8_LDB(B1, 0, 1); PG8_SCHED; PG8_LDA(At, 0, 0); PG8_STAGE(PG8_SA(1, 1), a1 + hstepA, voffA);
            PG8_WAIT_V(8); PG8_WAIT_L(0); PG8_BAR; PG8_MMA(0, 0, At, B0); PG8_MMA(0, 1, At, B1); PG8_BAR; PG8_SCHED;
            PG8_LDA(At, 0, 1); PG8_STAGE(PG8_SB(0, 0), b2, voffB); PG8_STAGE(PG8_SB(0, 1), b2 + hstepB, voffB); PG8_STAGE(PG8_SA(0, 0), a2, voffA);
            PG8_WAIT_V(8); PG8_WAIT_L(0); PG8_BAR; PG8_MMA(1, 0, At, B0); PG8_MMA(1, 1, At, B1); PG8_BAR; PG8_SCHED;
            PG8_LDB(B0, 1, 0); PG8_LDB(B1, 1, 1); PG8_SCHED; PG8_LDA(At, 1, 0); PG8_STAGE(PG8_SA(0, 1), a2 + hstepA, voffA);
            PG8_WAIT_V(8); PG8_WAIT_L(0); PG8_BAR; PG8_MMA(0, 0, At, B0); PG8_MMA(0, 1, At, B1); PG8_BAR; PG8_SCHED;
            PG8_LDA(At, 1, 1); PG8_STAGE(PG8_SB(1, 0), b3, voffB); PG8_STAGE(PG8_SB(1, 1), b3 + hstepB, voffB); PG8_STAGE(PG8_SA(1, 0), a3, voffA);
            PG8_WAIT_V(8); PG8_WAIT_L(0); PG8_BAR; PG8_MMA(1, 0, At, B0); PG8_MMA(1, 1, At, B1); PG8_BAR; PG8_SCHED;
            } else {
            PG8_LDB(B0, 0, 0); PG8_SCHED; PG8_LDA(At, 0, 0); PG8_STAGE(PG8_SA(1, 1), a1 + hstepA, voffA);
            PG8_WAIT_L(8); PG8_BAR; PG8_WAIT_L(0); PG8_MMA(0, 0, At, B0); PG8_BAR; PG8_SCHED;
            PG8_LDB(B1, 0, 1); PG8_STAGE(PG8_SB(0, 0), b2, voffB);
            PG8_BAR; PG8_WAIT_L(0); PG8_MMA(0, 1, At, B1); PG8_BAR;
            PG8_LDA(At, 0, 1); PG8_STAGE(PG8_SA(0, 0), a2, voffA);
            PG8_BAR; PG8_WAIT_L(0); PG8_MMA(1, 0, At, B0); PG8_BAR; PG8_SCHED;
            PG8_STAGE(PG8_SB(0, 1), b2 + hstepB, voffB);
            PG8_WAIT_V(6); PG8_BAR; PG8_MMA(1, 1, At, B1); PG8_BAR;
            PG8_LDB(B0, 1, 0); PG8_SCHED; PG8_LDA(At, 1, 0); PG8_STAGE(PG8_SA(0, 1), a2 + hstepA, voffA);
            PG8_WAIT_L(8); PG8_BAR; PG8_WAIT_L(0); PG8_MMA(0, 0, At, B0); PG8_BAR; PG8_SCHED;
            PG8_LDB(B1, 1, 1); PG8_STAGE(PG8_SB(1, 0), b3, voffB);
            PG8_BAR; PG8_WAIT_L(0); PG8_MMA(0, 1, At, B1); PG8_BAR;
            PG8_LDA(At, 1, 1); PG8_STAGE(PG8_SA(1, 0), a3, voffA);
            PG8_BAR; PG8_WAIT_L(0); PG8_MMA(1, 0, At, B0); PG8_BAR; PG8_SCHED;
            PG8_STAGE(PG8_SB(1, 1), b3 + hstepB, voffB);
            PG8_WAIT_V(6); PG8_BAR; PG8_MMA(1, 1, At, B1); PG8_BAR;
            }
        }
        if constexpr (ALIGN_EPI) { if (wr == 0) PG8_BAR; }
        if constexpr (!Epi::AFTER_DRAIN) { E(acc, cur, wr, wc, fr, fq); S.done(cur); }
        if (!has_next) break;
#pragma unroll
        for (int a = 0; a < 2; ++a)
#pragma unroll
            for (int b = 0; b < 2; ++b)
#pragma unroll
                for (int m = 0; m < 4; ++m)
#pragma unroll
                    for (int n = 0; n < 2; ++n) acc[a][b][m][n] = (f32x4){0.f, 0.f, 0.f, 0.f};
        cur = nxt; cA = nA; cB = nB; ++ui;
        if constexpr (ALIGN_EPI) { if (wr == 1) PG8_BAR; }
    }
    PG8_WAIT_V(0);
    if constexpr (!ALIGN_EPI) { if (wr == 0) PG8_BAR; }
    PG8_BAR;
    if constexpr (Epi::AFTER_DRAIN) { E.fused(acc, cur, wr, wc, fr, fq, lds, wid, lane); S.done(cur); }
#undef PG8_SA
#undef PG8_SB
#undef PG8_STAGE
#undef PG8_LDA
#undef PG8_LDB
#undef PG8_MMA
#undef PG8_WAIT_V
#undef PG8_WAIT_L
#undef PG8_BAR
#undef PG8_SCHED
}
}

constexpr int NWAVES = 8;
constexpr int BATCH = 16, SEQ = 2048, DM = 1024, MROWS = BATCH * SEQ, MEMLEN = 256, MMEM = BATCH * MEMLEN, FFH = 2816, PW = 2560;
constexpr float EPS = 1e-6f, LOG2E = 1.4426950408889634f;
constexpr float C2M = 0.125f * LOG2E;
constexpr float C2X = 0.0625f * LOG2E;
constexpr float NEGBIG = -1.0e30f;
constexpr int NPH = 16;
#ifndef MK_ONE_LAUNCH
#define MK_ONE_LAUNCH 1
#endif

constexpr size_t MiB = 1u << 20;
constexpr size_t WS_CTL = 0, CTL_ZERO_BYTES = 64 * 1024;
constexpr size_t WS_LB = 1 * MiB, WS_RMEM = 1 * MiB + 4096, WS_SGUW = 1 * MiB + 65536, WS_KPART = 1 * MiB + 512 * 1024;
constexpr size_t WS_SSQ = 2 * MiB;
constexpr size_t WS_WIN0 = 4 * MiB, WS_WOUT0 = 10 * MiB, WS_WIN1 = 12 * MiB, WS_WOUT1 = 17 * MiB, WS_WQ = 19 * MiB, WS_WO = 23 * MiB, WS_WK = 27 * MiB, WS_WV = 31 * MiB,
                 WS_WFI = 35 * MiB, WS_WFO = 57 * MiB;
constexpr size_t WS_MEMB = 68 * MiB, WS_KB = 76 * MiB, WS_VT = 92 * MiB;
constexpr size_t WS_XB = 112 * MiB, WS_BIG = 176 * MiB, WS_MIX = 352 * MiB, WS_QO = 416 * MiB, WS_END = 480 * MiB;
constexpr int CW_BAR = 1024;

constexpr int RING_BYTES = 131072, LDS_BYTES = 147456, LDSCTL_OFF = LDS_BYTES - 512, MISC_OFF = LDSCTL_OFF;

#define GAS __attribute__((address_space(1)))
#define LAS __attribute__((address_space(3)))
typedef unsigned short bf16;
typedef unsigned v4u __attribute__((ext_vector_type(4)));
typedef unsigned v2u __attribute__((ext_vector_type(2)));
typedef float f32x4 __attribute__((ext_vector_type(4)));
typedef float f32x16 __attribute__((ext_vector_type(16)));
typedef short bf16x8 __attribute__((ext_vector_type(8)));
typedef short s16x4 __attribute__((ext_vector_type(4)));
typedef GAS unsigned gu32;
#define LDS_WAIT() asm volatile("s_waitcnt lgkmcnt(0)" ::: "memory")
#define VM_WAIT() asm volatile("s_waitcnt vmcnt(0)" ::: "memory")
__device__ __forceinline__ float bf2f(unsigned short b) { return __uint_as_float(((unsigned)b) << 16); }
__device__ __forceinline__ float bflo(unsigned w) { return __uint_as_float(w << 16); }
__device__ __forceinline__ float bfhi(unsigned w) { return __uint_as_float(w & 0xffff0000u); }
typedef float f32x2_t __attribute__((ext_vector_type(2))); typedef __bf16 bf16x2_t __attribute__((ext_vector_type(2)));
__device__ __forceinline__ unsigned pk2(float lo, float hi) { f32x2_t v = {lo, hi}; bf16x2_t b = __builtin_convertvector(v, bf16x2_t); return __builtin_bit_cast(unsigned, b); }
typedef _Float16 h16x8 __attribute__((ext_vector_type(8))); typedef _Float16 h16x2 __attribute__((ext_vector_type(2)));
__device__ __forceinline__ unsigned pk2h(float lo, float hi) { f32x2_t v = {lo, hi}; h16x2 h = __builtin_convertvector(v, h16x2); return __builtin_bit_cast(unsigned, h); }
__device__ __forceinline__ float h2f(unsigned short b) { return (float)__builtin_bit_cast(_Float16, b); }
__device__ __forceinline__ float hlo(unsigned w) { return (float)__builtin_bit_cast(h16x2, w)[0]; }
__device__ __forceinline__ float hhi(unsigned w) { return (float)__builtin_bit_cast(h16x2, w)[1]; }
__device__ __forceinline__ float fexp2(float x) { return __builtin_amdgcn_exp2f(x); }
__device__ __forceinline__ float fexp(float x) { return __builtin_amdgcn_exp2f(x * LOG2E); }
__device__ __forceinline__ float sigm(float x) { return __builtin_amdgcn_rcpf(1.0f + __builtin_amdgcn_exp2f(-x * LOG2E)); }
__device__ __forceinline__ float wave_sum(float v) {
#pragma unroll
    for (int o = 1; o < 64; o <<= 1) v += __shfl_xor(v, o);
    return v;
}
#define MFMA32(a, b, c) __builtin_amdgcn_mfma_f32_32x32x16_bf16((a), (b), (c), 0, 0, 0)
#define MFMA32H(a, b, c) __builtin_amdgcn_mfma_f32_32x32x16_f16(__builtin_bit_cast(h16x8, (a)), __builtin_bit_cast(h16x8, (b)), (c), 0, 0, 0)
__device__ __forceinline__ bf16x8 ldsfrag(const LAS unsigned char* p) { return *(const LAS bf16x8*)p; }
__device__ __forceinline__ bf16x8 ldsfrag2(const LAS unsigned char* p0, const LAS unsigned char* p1) {
    const s16x4 lo = *(const LAS s16x4*)p0, hi = *(const LAS s16x4*)p1;
    return (bf16x8){lo[0], lo[1], lo[2], lo[3], hi[0], hi[1], hi[2], hi[3]};
}
__device__ __forceinline__ bf16x8 packfrag(const f32x16& p, int s2) {
    v4u w; w.x = pk2h(p[8 * s2 + 0], p[8 * s2 + 1]); w.y = pk2h(p[8 * s2 + 2], p[8 * s2 + 3]); w.z = pk2h(p[8 * s2 + 4], p[8 * s2 + 5]); w.w = pk2h(p[8 * s2 + 6], p[8 * s2 + 7]);
    return __builtin_bit_cast(bf16x8, w);
}
template <int NKS> __device__ __forceinline__ void mma_lds(f32x16& acc, const LAS unsigned char* pa, const LAS unsigned char* pb) {
    bf16x8 fa[NKS], fb[NKS];
#pragma unroll
    for (int ks = 0; ks < NKS; ++ks) { fa[ks] = ldsfrag(pa + ks * 32); fb[ks] = ldsfrag(pb + ks * 32); }
#pragma unroll
    for (int ks = 0; ks < NKS; ++ks) acc = MFMA32(fa[ks], fb[ks], acc);
}
#define XB_TMO      128
#define XB_XCNT(j)  (256  + 64 * (j))
#define XB_XSUB(j)  (1280 + 64 * (j))
#define XB_XGEN(j)  (2304 + 64 * (j))
#define XB_TOP      3328
#define XB_TOPGEN   3392
#define XCD_BAR_WORDS 3456
#define XB_SPIN_CAP (1u << 18)

__device__ __forceinline__ unsigned xb_ld(unsigned* p)              { return __hip_atomic_load(p, __ATOMIC_RELAXED, __HIP_MEMORY_SCOPE_AGENT); }
__device__ __forceinline__ unsigned xb_add(unsigned* p, unsigned v) { return __hip_atomic_fetch_add(p, v, __ATOMIC_RELAXED, __HIP_MEMORY_SCOPE_AGENT); }
__device__ __forceinline__ unsigned xb_xcc_id() { return (unsigned)__builtin_amdgcn_s_getreg((3 << 11) | 20) & 0xFu; }
#define XB_SPIN(cond, bar) do { unsigned _sp = 0; while (cond) { __builtin_amdgcn_s_sleep(1); \
    if ((++_sp & 255u) == 0u) { if (xb_ld(&(bar)[XB_TMO])) break; if (_sp > XB_SPIN_CAP) { atomicAdd(&(bar)[XB_TMO], 1u); break; } } } } while (0)

struct XcdBarrier {
    unsigned* bar; unsigned x;
    volatile LAS unsigned* st;
};

__device__ __forceinline__ XcdBarrier xcd_barrier_post(unsigned* bar, volatile LAS unsigned* st) {
    XcdBarrier b; b.bar = bar; b.x = xb_xcc_id(); b.st = st;
    if (threadIdx.x == 0) (void)xb_add(&bar[XB_XCNT(b.x)], 1u);
    return b;
}
__device__ __forceinline__ void xcd_barrier_complete(unsigned* bar, unsigned x, unsigned& nloc, unsigned& nx) {
    const unsigned G = gridDim.x * gridDim.y * gridDim.z;
    unsigned sum, cnt, mine, sp = 0u;
    for (;;) {
        sum = 0u; cnt = 0u; mine = 0u;
#pragma unroll
        for (unsigned j = 0; j < 16; ++j) { const unsigned c = xb_ld(&bar[XB_XCNT(j)]); sum += c; cnt += (c > 0u) ? 1u : 0u; mine = (j == x) ? c : mine; }
        if (sum == G) break;
        __builtin_amdgcn_s_sleep(1);
        if ((++sp & 255u) == 0u) { if (xb_ld(&bar[XB_TMO])) break; if (sp > XB_SPIN_CAP) { atomicAdd(&bar[XB_TMO], 1u); break; } }
    }
    nloc = mine > 0u ? mine : 1u; nx = cnt > 0u ? cnt : 1u;
}

__device__ __forceinline__ void xcd_barrier(const XcdBarrier& b) {
    asm volatile("s_waitcnt vmcnt(0)" ::: "memory");
    __syncthreads();
    if (threadIdx.x == 0) {
        unsigned* bar = b.bar;
        __builtin_amdgcn_s_waitcnt(0);
        unsigned nloc = b.st[0], nx = b.st[1];
        if (nloc == 0u) { xcd_barrier_complete(bar, b.x, nloc, nx); b.st[0] = nloc; b.st[1] = nx; }
        const unsigned old = xb_add(&bar[XB_XSUB(b.x)], 1u);
        const unsigned gen = old / nloc;
        if (old + 1u == (gen + 1u) * nloc) {
            __builtin_amdgcn_fence(__ATOMIC_RELEASE, "agent");
            asm volatile("s_waitcnt vmcnt(0)" ::: "memory");
            const unsigned og = xb_add(&bar[XB_TOP], 1u);
            const unsigned tg = og / nx;
            if (og + 1u == (tg + 1u) * nx) xb_add(&bar[XB_TOPGEN], 1u);
            else XB_SPIN(xb_ld(&bar[XB_TOPGEN]) == tg, bar);
            __builtin_amdgcn_fence(__ATOMIC_ACQUIRE, "agent");
            xb_add(&bar[XB_XGEN(b.x)], 1u);
            asm volatile("s_waitcnt vmcnt(0)" ::: "memory");
        } else {
            XB_SPIN(xb_ld(&bar[XB_XGEN(b.x)]) == gen, bar);
            __builtin_amdgcn_fence(__ATOMIC_ACQUIRE, "agent");
            asm volatile("s_waitcnt vmcnt(0)" ::: "memory");
        }
    }
    __syncthreads();
}

#define CAS __attribute__((address_space(4)))
struct Args { const float* in[26]; float* out; unsigned char* ws; int ph_lo, ph_hi; };
struct Frame {
    LAS unsigned char* lds;
    int tid, lane, wave, G, bid;
    const CAS struct Args* ka;
    float* out; unsigned char* ws;
};
#define WSP(T, off) ((T*)(F.ws + (off)))
#define WSPG(T, off) ((GAS T*)((GAS unsigned char*)F.ws + (off)))
#define INP(k) ((const GAS float*)F.ka->in[k])

__device__ __forceinline__ void tr_item(const GAS float* W, int ldw, int K, int scol0, int k0, GAS bf16* WT, int drow0, const GAS float* gain, LAS float* scr, int lane) {
    f32x4 v[8]; float gn[8];
#pragma unroll
    for (int i = 0; i < 8; ++i) { const int kk = 8 * i + (lane >> 3); v[i] = __builtin_nontemporal_load((const GAS f32x4*)(W + (size_t)(k0 + kk) * ldw + scol0 + 4 * (lane & 7))); gn[i] = gain ? gain[k0 + kk] : 1.0f; }
#pragma unroll
    for (int i = 0; i < 8; ++i) { const int kk = 8 * i + (lane >> 3); LAS float* d = scr + kk * 33 + 4 * (lane & 7);
        d[0] = v[i][0] * gn[i]; d[1] = v[i][1] * gn[i]; d[2] = v[i][2] * gn[i]; d[3] = v[i][3] * gn[i]; }
    LDS_WAIT(); asm volatile("" ::: "memory");
    const int c = lane & 7;
#pragma unroll
    for (int j = 0; j < 4; ++j) { const int n = (lane >> 3) + 8 * j; const LAS float* s = scr + (8 * c) * 33 + n;
        v4u o; o.x = pk2h(s[0 * 33], s[1 * 33]); o.y = pk2h(s[2 * 33], s[3 * 33]); o.z = pk2h(s[4 * 33], s[5 * 33]); o.w = pk2h(s[6 * 33], s[7 * 33]);
        *(GAS v4u*)(WT + (size_t)(drow0 + n) * K + k0 + 8 * c) = o; }
    LDS_WAIT(); asm volatile("" ::: "memory");
}
__device__ __forceinline__ bool tr_matrix(int& r, const GAS float* W, int ldw, int K, int N, int soff, int map, GAS bf16* WT, const GAS float* gain, LAS float* scr, int lane) {
    const int nblk = N / 32, cnt = (K / 64) * nblk;
    if (r >= cnt) { r -= cnt; return false; }
    const int kb = r / nblk, nb = r % nblk, d0 = 32 * nb; int sc = d0;
    if (map == 1 && d0 >= 2048) { const int q = d0 - 2048; sc = 2048 + ((q >> 7) & 1) * 512 + (q >> 8) * 128 + (q & 127); }
    if (map == 2) sc = ((d0 >> 7) & 1) * FFH + (d0 >> 8) * 128 + (d0 & 127);
    tr_item(W, ldw, K, soff + sc, 64 * kb, WT, d0, gain, scr, lane);
    return true;
}
__device__ __forceinline__ void convert_rest(Frame& F, int wi, int nw) {
    LAS float* scr = (LAS float*)(F.lds + F.wave * 16384);
    const int lane = F.lane;
    constexpr int NITEMS = 512 + 1280 + 512 + 2 * (512 + 2816 + 1408);
    for (int it = wi; it < NITEMS; it += nw) {
        int r = it;
        if (tr_matrix(r, INP(8), DM, DM, DM, 0, 0, WSPG(bf16, WS_WOUT0), nullptr, scr, lane)) continue;
        if (tr_matrix(r, INP(15), PW, DM, PW, 0, 0, WSPG(bf16, WS_WIN1), INP(2) + DM, scr, lane)) continue;
        if (tr_matrix(r, INP(16), DM, DM, DM, 0, 0, WSPG(bf16, WS_WOUT1), nullptr, scr, lane)) continue;
        bool done = false;
#pragma unroll
        for (int l = 0; l < 2; ++l) {
            if (done) break;
            if (tr_matrix(r, INP(23) + (size_t)l * DM * DM, DM, DM, DM, 0, 0, WSPG(bf16, WS_WO) + (size_t)l * DM * DM, nullptr, scr, lane)) { done = true; break; }
            if (tr_matrix(r, INP(24) + (size_t)l * DM * 2 * FFH, 2 * FFH, DM, 2 * FFH, 0, 2, WSPG(bf16, WS_WFI) + (size_t)l * DM * 2 * FFH, INP(4) + l * DM, scr, lane)) { done = true; break; }
            if (tr_matrix(r, INP(25) + (size_t)l * FFH * DM, DM, FFH, DM, 0, 0, WSPG(bf16, WS_WFO) + (size_t)l * FFH * DM, nullptr, scr, lane)) { done = true; break; }
        }
    }
    for (int it = wi; it < 2 * DM; it += nw) {
        const int l = it >> 10, i = it & (DM - 1);
        const float gsc = INP(3)[l * DM + i] * C2X;
        const GAS f32x4* xr = (const GAS f32x4*)(INP(21) + ((size_t)l * DM + i) * DM) + lane;
        GAS v2u* o8 = (GAS v2u*)(WSPG(bf16, WS_WQ) + ((size_t)l * DM + i) * DM) + lane;
#pragma unroll
        for (int j = 0; j < 4; ++j) { const f32x4 v = __builtin_nontemporal_load(xr + 64 * j) * gsc; v2u w; w.x = pk2h(v[0], v[1]); w.y = pk2h(v[2], v[3]); o8[64 * j] = w; }
    }
    __syncthreads();
}
__device__ __forceinline__ void p0_prologue(Frame& F) {
    LAS float* scr = (LAS float*)(F.lds + F.wave * 16384);
    const int gw = F.bid * NWAVES + F.wave, NGW = F.G * NWAVES, lane = F.lane;
    for (int it = gw; it < 1536 + 2048; it += NGW) { int r = it;
        if (tr_matrix(r, INP(7), 3072, DM, 3072, 0, 1, WSPG(bf16, WS_WIN0), INP(2), scr, lane)) continue;
        bool done = false;
#pragma unroll
        for (int l = 0; l < 2; ++l) {
            if (done) break;
            if (tr_matrix(r, INP(22) + (size_t)l * DM * 2048, 2048, DM, DM, 0, 0, WSPG(bf16, WS_WK) + (size_t)l * DM * DM, INP(5), scr, lane)) { done = true; break; }
            if (tr_matrix(r, INP(22) + (size_t)l * DM * 2048, 2048, DM, DM, 1024, 0, WSPG(bf16, WS_WV) + (size_t)l * DM * DM, INP(5), scr, lane)) { done = true; break; }
        } }
    {   const GAS float* x = INP(0); GAS bf16* xb = WSPG(bf16, WS_XB); GAS float* ssq = WSPG(float, WS_SSQ);
        for (int m = gw; m < MROWS; m += NGW) {
            const GAS f32x4* xr = (const GAS f32x4*)(x + (size_t)m * DM) + lane; f32x4 v[4]; float s = 0.f;
#pragma unroll
            for (int j = 0; j < 4; ++j) { v[j] = __builtin_nontemporal_load(xr + 64 * j); s += (v[j][0] * v[j][0] + v[j][1] * v[j][1]) + (v[j][2] * v[j][2] + v[j][3] * v[j][3]); }
            s = wave_sum(s);
            GAS v2u* o8 = (GAS v2u*)(xb + (size_t)m * DM) + lane;
#pragma unroll
            for (int j = 0; j < 4; ++j) { v2u w; w.x = pk2h(v[j][0], v[j][1]); w.y = pk2h(v[j][2], v[j][3]); o8[64 * j] = w; }
            if (lane == 0) { ssq[m] = s; ssq[MROWS + m] = 0.f; }
        } }
    {   const GAS float* x = INP(1); GAS bf16* xb = WSPG(bf16, WS_MEMB); GAS float* rm = WSPG(float, WS_RMEM);
        for (int m = gw; m < MMEM; m += NGW) {
            const GAS f32x4* xr = (const GAS f32x4*)(x + (size_t)m * DM) + lane; f32x4 v[4]; float s = 0.f;
#pragma unroll
            for (int j = 0; j < 4; ++j) { v[j] = __builtin_nontemporal_load(xr + 64 * j); s += (v[j][0] * v[j][0] + v[j][1] * v[j][1]) + (v[j][2] * v[j][2] + v[j][3] * v[j][3]); }
            s = wave_sum(s);
            GAS v2u* o8 = (GAS v2u*)(xb + (size_t)m * DM) + lane;
#pragma unroll
            for (int j = 0; j < 4; ++j) { v2u w; w.x = pk2h(v[j][0], v[j][1]); w.y = pk2h(v[j][2], v[j][3]); o8[64 * j] = w; }
            if (lane == 0) rm[m] = 1.0f / sqrtf(s * (1.0f / DM) + EPS);
        } }
    {   const int idx = F.bid * (NWAVES * 64) + F.tid, NT = F.G * NWAVES * 64;
        for (int i = idx; i < 512; i += NT) { const float a0 = INP(9)[i], a1 = INP(9)[512 + i], a2 = INP(9)[1024 + i]; const float mx = fmaxf(a0, fmaxf(a1, a2));
            const float e0 = __expf(a0 - mx), e1 = __expf(a1 - mx), e2 = __expf(a2 - mx); WSPG(float, WS_LB)[i] = e0 / (e0 + e1 + e2); }
        for (int i = idx; i < 4 * 128 * 128; i += NT) { const int t = (i >> 7) & 127, s = i & 127; WSPG(bf16, WS_SGUW)[i] = (bf16)(s <= t ? (pk2h(INP(19)[i], 0.f) & 0xffffu) : 0u); }
    }
}

constexpr int HG_QIN = 0, HG_KIN = 17408, HG_KOT = 34816, HG_VTT = 53248, HG_ATT = 71680, HG_STT = 80896, HG_OST = 115712, HG_DEC = 133120, HG_SSQ = 133632;
constexpr int P128 = 272, P64 = 144;
__device__ __forceinline__ float wave_scan(float v) {
#define HG_DPP(ctrl, rmask) v += __builtin_bit_cast(float, __builtin_amdgcn_update_dpp(0, __builtin_bit_cast(int, v), (ctrl), (rmask), 0xf, false))
    HG_DPP(0x111, 0xf); HG_DPP(0x112, 0xf); HG_DPP(0x114, 0xf); HG_DPP(0x118, 0xf); HG_DPP(0x142, 0xa); HG_DPP(0x143, 0xc);
#undef HG_DPP
    return v;
}
__device__ __forceinline__ void hgrn_unit(Frame& F, int b, int h) {
    LAS unsigned char* L = F.lds;
    int tid_ = F.tid; asm volatile("" : "+v"(tid_));
    const int tid = tid_, lane = tid & 63, w = __builtin_amdgcn_readfirstlane(tid >> 6), l31 = lane & 31, hh = lane >> 5;
    const GAS bf16* P = WSPG(bf16, WS_BIG); GAS bf16* MIX = WSPG(bf16, WS_MIX);
    const int vs = tid >> 3, vec = (tid & 7) * 16;
    const int eb = w & 3, cb = w >> 2;
    f32x16 S0, S1;
#pragma unroll
    for (int r = 0; r < 16; ++r) { S0[r] = 0.f; S1[r] = 0.f; }
    for (int i = tid; i < 34816 / 16; i += 512) *(LAS v4u*)(L + HG_STT + i * 16) = (v4u){0u, 0u, 0u, 0u};
    float onorm[16];
#pragma unroll
    for (int j = 0; j < 16; ++j) onorm[j] = INP(10)[h * 128 + vec + j];
    LAS float* DEC = (LAS float*)(L + HG_DEC); LAS float* SSQ = (LAS float*)(L + HG_SSQ);
    const GAS bf16* pbase = P + ((size_t)b * SEQ + lane) * PW + h * 128 + 16 * w;
    const GAS bf16* gbase = P + ((size_t)b * SEQ + vs) * PW + 1536 + h * 128 + vec;
    v4u ra0, ra1, ra2, ra3, ra4, ra5, rb0, rb1, rb2, rb3, rb4, rb5, ga0, ga1, gb0, gb1;
    ra0 = *(const GAS v4u*)(pbase); ra1 = *(const GAS v4u*)(pbase + 8); ra2 = *(const GAS v4u*)(pbase + 512); ra3 = *(const GAS v4u*)(pbase + 520); ra4 = *(const GAS v4u*)(pbase + 1024); ra5 = *(const GAS v4u*)(pbase + 1032);
    {   const GAS bf16* p1 = pbase + (size_t)64 * PW;
        rb0 = *(const GAS v4u*)(p1); rb1 = *(const GAS v4u*)(p1 + 8); rb2 = *(const GAS v4u*)(p1 + 512); rb3 = *(const GAS v4u*)(p1 + 520); rb4 = *(const GAS v4u*)(p1 + 1024); rb5 = *(const GAS v4u*)(p1 + 1032); }
    ga0 = *(const GAS v4u*)(gbase); ga1 = *(const GAS v4u*)(gbase + 8); gb0 = *(const GAS v4u*)(gbase + (size_t)64 * PW); gb1 = *(const GAS v4u*)(gbase + (size_t)64 * PW + 8);
    auto chunk = [&](const int n, v4u& rq0, v4u& rq1, v4u& rk0, v4u& rk1, v4u& rv0, v4u& rv1, v4u& g0, v4u& g1) {
        const size_t m0 = (size_t)b * SEQ + n * 64;
        {   const unsigned qw[8] = {rq0.x, rq0.y, rq0.z, rq0.w, rq1.x, rq1.y, rq1.z, rq1.w}, kw[8] = {rk0.x, rk0.y, rk0.z, rk0.w, rk1.x, rk1.y, rk1.z, rk1.w}, vw[8] = {rv0.x, rv0.y, rv0.z, rv0.w, rv1.x, rv1.y, rv1.z, rv1.w};
            float kk[16], cm[16];
#pragma unroll
            for (int j2 = 0; j2 < 8; ++j2) { kk[2 * j2] = hlo(kw[j2]); kk[2 * j2 + 1] = hhi(kw[j2]); }
#pragma unroll
            for (int j = 0; j < 16; ++j) cm[j] = __builtin_amdgcn_logf(1.0f - kk[j]);
#define HG_STEP(ctrl, rmask) _Pragma("unroll") for (int j = 0; j < 16; ++j) cm[j] += __builtin_bit_cast(float, __builtin_amdgcn_update_dpp(0, __builtin_bit_cast(int, cm[j]), (ctrl), (rmask), 0xf, false))
            HG_STEP(0x111, 0xf); HG_STEP(0x112, 0xf); HG_STEP(0x114, 0xf); HG_STEP(0x118, 0xf); HG_STEP(0x142, 0xa); HG_STEP(0x143, 0xc);
#undef HG_STEP
            unsigned qo[8], ko[8]; float decv = 0.f;
#pragma unroll
            for (int j2 = 0; j2 < 8; ++j2) {
                float qi[2], ki[2];
#pragma unroll
                for (int t = 0; t < 2; ++t) { const int j = 2 * j2 + t;
                    const float e1 = fexp2(cm[j]), e2 = __builtin_amdgcn_rcpf(e1), dec = __builtin_bit_cast(float, __builtin_amdgcn_readlane(__builtin_bit_cast(int, e1), 63));
                    qi[t] = (t == 0 ? hlo(qw[j2]) : hhi(qw[j2])) * e1; ki[t] = kk[j] * e2;
                    *(LAS bf16*)(L + HG_KOT + (16 * w + j) * P64 + lane * 2) = (bf16)(pk2(ki[t] * dec, 0.f) & 0xffffu);
                    decv = lane == j ? dec : decv; }
                qo[j2] = pk2(qi[0], qi[1]); ko[j2] = pk2(ki[0], ki[1]);
                *(LAS bf16*)(L + HG_VTT + (16 * w + 2 * j2) * P64 + lane * 2) = (bf16)(pk2(hlo(vw[j2]), 0.f) & 0xffffu);
                *(LAS bf16*)(L + HG_VTT + (16 * w + 2 * j2 + 1) * P64 + lane * 2) = (bf16)(pk2(hhi(vw[j2]), 0.f) & 0xffffu);
            }
            if (lane < 16) DEC[16 * w + lane] = decv;
            *(LAS v4u*)(L + HG_QIN + lane * P128 + 32 * w) = (v4u){qo[0], qo[1], qo[2], qo[3]}; *(LAS v4u*)(L + HG_QIN + lane * P128 + 32 * w + 16) = (v4u){qo[4], qo[5], qo[6], qo[7]};
            *(LAS v4u*)(L + HG_KIN + lane * P128 + 32 * w) = (v4u){ko[0], ko[1], ko[2], ko[3]}; *(LAS v4u*)(L + HG_KIN + lane * P128 + 32 * w + 16) = (v4u){ko[4], ko[5], ko[6], ko[7]};
        }
        __syncthreads();
        {   const int n2c = n + 2 < 32 ? n + 2 : 31;
            const GAS bf16* pn = pbase + (size_t)n2c * 64 * PW;
            rq0 = *(const GAS v4u*)(pn); rq1 = *(const GAS v4u*)(pn + 8); rk0 = *(const GAS v4u*)(pn + 512); rk1 = *(const GAS v4u*)(pn + 520); rv0 = *(const GAS v4u*)(pn + 1024); rv1 = *(const GAS v4u*)(pn + 1032); }
        f32x16 o;
#pragma unroll
        for (int r = 0; r < 16; ++r) o[r] = 0.f;
        mma_lds<8>(o, L + HG_STT + (32 * eb + l31) * P128 + hh * 16, L + HG_QIN + (32 * cb + l31) * P128 + hh * 16);
        if (w < 3) {
            const int sb = w >> 1, cb2 = (w + 1) >> 1;
            f32x16 at;
#pragma unroll
            for (int r = 0; r < 16; ++r) at[r] = 0.f;
            mma_lds<8>(at, L + HG_KIN + (32 * sb + l31) * P128 + hh * 16, L + HG_QIN + (32 * cb2 + l31) * P128 + hh * 16);
            if (sb == cb2) {
#pragma unroll
                for (int r = 0; r < 16; ++r) { const int sl = (r & 3) + 8 * (r >> 2) + 4 * hh; if (sl > l31) at[r] = 0.f; } }
#pragma unroll
            for (int g4 = 0; g4 < 4; ++g4) *(LAS v2u*)(L + HG_ATT + (32 * cb2 + l31) * P64 + (32 * sb + 8 * g4 + 4 * hh) * 2) = (v2u){pk2(at[4 * g4], at[4 * g4 + 1]), pk2(at[4 * g4 + 2], at[4 * g4 + 3])};
        }
        __syncthreads();
        if (cb == 0) mma_lds<2>(o, L + HG_VTT + (32 * eb + l31) * P64 + hh * 16, L + HG_ATT + l31 * P64 + hh * 16);
        else         mma_lds<4>(o, L + HG_VTT + (32 * eb + l31) * P64 + hh * 16, L + HG_ATT + (32 + l31) * P64 + hh * 16);
#pragma unroll
        for (int i2 = 0; i2 < 2; ++i2) {
            const int dkb = 2 * cb + i2;
            f32x16& S = i2 == 0 ? S0 : S1;
#pragma unroll
            for (int g4 = 0; g4 < 4; ++g4) { const f32x4 d4 = *(const LAS f32x4*)(DEC + 32 * dkb + 8 * g4 + 4 * hh);
#pragma unroll
                for (int j = 0; j < 4; ++j) S[4 * g4 + j] *= d4[j]; }
            mma_lds<4>(S, L + HG_KOT + (32 * dkb + l31) * P64 + hh * 16, L + HG_VTT + (32 * eb + l31) * P64 + hh * 16);
#pragma unroll
            for (int g4 = 0; g4 < 4; ++g4) *(LAS v2u*)(L + HG_STT + (32 * eb + l31) * P128 + (32 * dkb + 8 * g4 + 4 * hh) * 2) = (v2u){pk2(S[4 * g4], S[4 * g4 + 1]), pk2(S[4 * g4 + 2], S[4 * g4 + 3])};
        }
        {   float ss = 0.f;
#pragma unroll
            for (int r = 0; r < 16; ++r) ss += o[r] * o[r];
            ss += __shfl_xor(ss, 32);
            if (hh == 0) SSQ[eb * 64 + 32 * cb + l31] = ss;
#pragma unroll
            for (int g4 = 0; g4 < 4; ++g4) *(LAS v2u*)(L + HG_OST + (32 * cb + l31) * P128 + (32 * eb + 8 * g4 + 4 * hh) * 2) = (v2u){pk2h(o[4 * g4], o[4 * g4 + 1]), pk2h(o[4 * g4 + 2], o[4 * g4 + 3])}; }
        __syncthreads();
        {   const int c = vs;
            const float rn = 1.0f / sqrtf(((SSQ[c] + SSQ[64 + c]) + (SSQ[128 + c] + SSQ[192 + c])) * (1.0f / 128.0f) + EPS);
            const v4u o0 = *(const LAS v4u*)(L + HG_OST + c * P128 + vec * 2), o1 = *(const LAS v4u*)(L + HG_OST + c * P128 + vec * 2 + 16);
            const unsigned ow[8] = {o0.x, o0.y, o0.z, o0.w, o1.x, o1.y, o1.z, o1.w}, gw[8] = {g0.x, g0.y, g0.z, g0.w, g1.x, g1.y, g1.z, g1.w};
            {   const int n2c = n + 2 < 32 ? n + 2 : 31; g0 = *(const GAS v4u*)(gbase + (size_t)n2c * 64 * PW); g1 = *(const GAS v4u*)(gbase + (size_t)n2c * 64 * PW + 8); }
            unsigned res[8];
#pragma unroll
            for (int j = 0; j < 8; ++j) res[j] = pk2h(hlo(ow[j]) * rn * onorm[2 * j] * hlo(gw[j]), hhi(ow[j]) * rn * onorm[2 * j + 1] * hhi(gw[j]));
            *(GAS v4u*)(MIX + (m0 + c) * DM + h * 128 + vec) = (v4u){res[0], res[1], res[2], res[3]};
            *(GAS v4u*)(MIX + (m0 + c) * DM + h * 128 + vec + 8) = (v4u){res[4], res[5], res[6], res[7]};
        }
    };
#pragma unroll 1
    for (int n2 = 0; n2 < 32; n2 += 2) { chunk(n2, ra0, ra1, ra2, ra3, ra4, ra5, ga0, ga1); chunk(n2 + 1, rb0, rb1, rb2, rb3, rb4, rb5, gb0, gb1); }
    __syncthreads();
}

__device__ __forceinline__ void reduce16x2(float (&a)[16], int lane) {
#pragma unroll
    for (int i = 0; i < 8; ++i) { const bool up = (lane & 32) != 0; const float send = up ? a[i] : a[i + 8]; const float keep = up ? a[i + 8] : a[i]; a[i] = keep + __shfl_xor(send, 32); }
#pragma unroll
    for (int i = 0; i < 4; ++i) { const bool up = (lane & 16) != 0; const float send = up ? a[i] : a[i + 4]; const float keep = up ? a[i + 4] : a[i]; a[i] = keep + __shfl_xor(send, 16); }
#pragma unroll
    for (int i = 0; i < 2; ++i) { const bool up = (lane & 8) != 0; const float send = up ? a[i] : a[i + 2]; const float keep = up ? a[i + 2] : a[i]; a[i] = keep + __shfl_xor(send, 8); }
    { const bool up = (lane & 4) != 0; const float send = up ? a[0] : a[1]; const float keep = up ? a[1] : a[0]; a[0] = keep + __shfl_xor(send, 4); }
    a[0] += __shfl_xor(a[0], 2); a[0] += __shfl_xor(a[0], 1);
}
constexpr int CV_CT = 0, CV_PART = 98304;
__device__ __forceinline__ void conv_tiles(Frame& F, int first, int stride) {
    if (first >= 512) return;
    LAS unsigned char* L = F.lds;
    int tid_ = F.tid; asm volatile("" : "+v"(tid_));
    const int tid = tid_, lane = tid & 63, w = __builtin_amdgcn_readfirstlane(tid >> 6);
    const GAS bf16* P = WSPG(bf16, WS_BIG); GAS unsigned* MIX32 = WSPG(unsigned, WS_MIX);
    const int cp = tid & 255, th = tid >> 8;
    float w0[31], w1[31];
#pragma unroll
    for (int k = 0; k < 31; ++k) { const f32x2_t ww = *(const GAS f32x2_t*)(INP(11) + k * 512 + 2 * cp); w0[k] = ww.x; w1[k] = ww.y; }
    const f32x2_t bias = *(const GAS f32x2_t*)(INP(12) + 2 * cp), lng = *(const GAS f32x2_t*)(INP(13) + 2 * cp), lnb = *(const GAS f32x2_t*)(INP(14) + 2 * cp);
    LAS float* PART = (LAS float*)(L + CV_PART);
    const LAS unsigned* CT32 = (const LAS unsigned*)(L + CV_CT);
    v4u rows[12];
    auto load_rows = [&](int tile) { const int b = tile >> 5, t0 = (tile & 31) * 64;
#pragma unroll
        for (int i = 0; i < 12; ++i) { const int idx = tid + 512 * i, j = idx >> 6, c16 = idx & 63, t = t0 - 30 + j;
            rows[i] = (v4u){0u, 0u, 0u, 0u}; if (idx < 94 * 64 && t >= 0) rows[i] = *(const GAS v4u*)(P + ((size_t)b * SEQ + t) * PW + 2048 + c16 * 8); } };
    auto store_rows = [&]() {
#pragma unroll
        for (int i = 0; i < 12; ++i) { const int idx = tid + 512 * i; if (idx < 94 * 64) *(LAS v4u*)(L + CV_CT + (idx >> 6) * 1024 + (idx & 63) * 16) = rows[i]; } };
    load_rows(first);
#pragma unroll 1
    for (int tile = first; tile < 512; tile += stride) {
        const int b = tile >> 5, t0 = (tile & 31) * 64; const size_t m0 = (size_t)b * SEQ + t0;
        store_rows();
        __syncthreads();
        if (tile + stride < 512) load_rows(tile + stride);
#pragma unroll 1
        for (int grp = 0; grp < 4; ++grp) {
            const int tok0 = 32 * th + 8 * grp;
            float a0[8], a1[8];
#pragma unroll
            for (int i = 0; i < 8; ++i) { a0[i] = bias.x; a1[i] = bias.y; }
#pragma unroll
            for (int jj = 0; jj < 38; ++jj) { const unsigned v = CT32[(tok0 + jj) * 256 + cp]; const float x0 = hlo(v), x1 = hhi(v);
#pragma unroll
                for (int i = 0; i < 8; ++i) { const int k = jj - i; if (k >= 0 && k <= 30) { a0[i] += w0[k] * x0; a1[i] += w1[k] * x1; } } }
            float st[16];
#pragma unroll
            for (int i = 0; i < 8; ++i) { st[i] = a0[i] + a1[i]; st[8 + i] = a0[i] * a0[i] + a1[i] * a1[i]; }
            reduce16x2(st, lane);
            if ((lane & 3) == 0) PART[((grp & 1) * 8 + w) * 16 + (8 * ((lane >> 5) & 1) + 4 * ((lane >> 4) & 1) + 2 * ((lane >> 3) & 1) + ((lane >> 2) & 1))] = st[0];
            __syncthreads();
#pragma unroll
            for (int i = 0; i < 8; ++i) {
                float s = 0.f, q = 0.f;
#pragma unroll
                for (int ww = 0; ww < 4; ++ww) { s += PART[((grp & 1) * 8 + 4 * th + ww) * 16 + i]; q += PART[((grp & 1) * 8 + 4 * th + ww) * 16 + 8 + i]; }
                const float mu = s * (1.0f / 512.0f), var = q * (1.0f / 512.0f) - mu * mu, rstd = 1.0f / sqrtf(fmaxf(var, 0.f) + EPS);
                float y0 = (a0[i] - mu) * rstd * lng.x + lnb.x, y1 = (a1[i] - mu) * rstd * lng.y + lnb.y;
                y0 *= sigm(y0); y1 *= sigm(y1);
                MIX32[(m0 + tok0 + i) * 512 + 256 + cp] = pk2h(y0, y1);
            }
        }
        __syncthreads();
    }
}

constexpr int MB_KP = 144, MB_VP = 520, MB_VOFF = 256 * MB_KP, MB_BUF = MB_VOFF + 64 * MB_VP, MB_KM = 2 * MB_BUF;
__device__ __forceinline__ void moba_unit(Frame& F, int b, int hd, int jq) {
    LAS unsigned char* L = F.lds;
    int tid_ = F.tid; asm volatile("" : "+v"(tid_));
    const int tid = tid_, lane = tid & 63, w = __builtin_amdgcn_readfirstlane(tid >> 6), l31 = lane & 31, hh = lane >> 5;
    const GAS bf16* P = WSPG(bf16, WS_BIG); GAS bf16* MIX = WSPG(bf16, WS_MIX); const GAS float* kpart = WSPG(float, WS_KPART);
    const size_t m0 = (size_t)b * SEQ + jq * 256;
    const size_t qrow = m0 + 32 * w + l31;
    bf16x8 qf[4];
#pragma unroll
    for (int ks = 0; ks < 4; ++ks) qf[ks] = *(const GAS bf16x8*)(P + qrow * PW + hd * 64 + 16 * ks + 8 * hh);
    LAS float* KM = (LAS float*)(L + MB_KM);
    if (tid < jq * 64) { const int n = tid >> 6, d = tid & 63, pm = b * 8 + n, col = hd * 64 + d;
        KM[n * 64 + d] = (kpart[(size_t)(pm * 2) * 512 + col] + kpart[(size_t)(pm * 2 + 1) * 512 + col]) * (1.0f / 256.0f); }
    const int skey = tid >> 3, sch = tid & 7, vkey = tid & 255, vch = tid >> 8;
    v4u kreg[4], vreg[4];
    auto stage_load = [&](int blk) { const size_t mk = (size_t)b * SEQ + blk * 256;
#pragma unroll
        for (int j = 0; j < 4; ++j) { kreg[j] = *(const GAS v4u*)(P + (mk + skey + 64 * j) * PW + 512 + hd * 64 + 8 * sch); vreg[j] = *(const GAS v4u*)(P + (mk + vkey) * PW + 1024 + hd * 64 + 8 * (vch + 2 * j)); } };
    auto stage_write = [&](int buf) {
#pragma unroll
        for (int j = 0; j < 4; ++j) { *(LAS v4u*)(L + buf * MB_BUF + (skey + 64 * j) * MB_KP + sch * 16) = kreg[j];
            const unsigned vw[4] = {vreg[j].x, vreg[j].y, vreg[j].z, vreg[j].w}; LAS unsigned char* vp = L + buf * MB_BUF + MB_VOFF + 8 * (vch + 2 * j) * MB_VP + vkey * 2;
#pragma unroll
            for (int e = 0; e < 4; ++e) { *(LAS bf16*)(vp + (2 * e) * MB_VP) = (bf16)(vw[e] & 0xffffu); *(LAS bf16*)(vp + (2 * e + 1) * MB_VP) = (bf16)(vw[e] >> 16); } } };
    stage_load(jq); stage_write(0);
    __syncthreads();
    unsigned sel = 0u;
    if (jq <= 3) sel = (1u << jq) - 1u;
    else {
        float sc[7];
#pragma unroll
        for (int n = 0; n < 7; ++n) { float p = 0.f;
            if (n < jq) {
#pragma unroll
                for (int ks = 0; ks < 4; ++ks)
#pragma unroll
                    for (int j = 0; j < 8; ++j) p += h2f((unsigned short)qf[ks][j]) * KM[n * 64 + 16 * ks + 8 * hh + j];
                p += __shfl_xor(p, 32); } else p = -INFINITY;
            sc[n] = p; }
#pragma unroll
        for (int n = 0; n < 7; ++n) { int rank = 0;
#pragma unroll
            for (int n2 = 0; n2 < 7; ++n2) if (n2 != n) rank += (sc[n2] > sc[n] || (sc[n2] == sc[n] && n2 < n)) ? 1 : 0;
            if (n < jq && rank < 3) sel |= 1u << n; }
    }
    float negm = 0.f, lrun = 0.f; bool first = true; f32x16 O0, O1;
#pragma unroll
    for (int r = 0; r < 16; ++r) { O0[r] = 0.f; O1[r] = 0.f; }
#pragma unroll 1
    for (int bi = 0; bi <= jq; ++bi) {
        const int buf = bi & 1;
        if (bi < jq) stage_load(bi);
        const bool own = bi == 0; const int blk = own ? jq : bi - 1;
        const bool mysel = own ? true : (((sel >> blk) & 1u) != 0u);
        const bool anysel = own ? true : (__ballot(mysel) != 0ull);
        const int nkt = own ? ((w >> 1) + 1) : (anysel ? 4 : 0);
#pragma unroll 1
        for (int kt = 0; kt < nkt; ++kt) {
            f32x16 p0, p1;
#pragma unroll
            for (int r = 0; r < 16; ++r) { p0[r] = negm; p1[r] = negm; }
            {   const LAS unsigned char* kb = L + buf * MB_BUF + (64 * kt + l31) * MB_KP + hh * 16;
                bf16x8 kfa[4], kfb[4];
#pragma unroll
                for (int ks = 0; ks < 4; ++ks) { kfa[ks] = ldsfrag(kb + ks * 32); kfb[ks] = ldsfrag(kb + 32 * MB_KP + ks * 32); }
#pragma unroll
                for (int ks = 0; ks < 4; ++ks) { p0 = MFMA32H(kfa[ks], qf[ks], p0); p1 = MFMA32H(kfb[ks], qf[ks], p1); } }
            bf16x8 vf[8];
            {   const LAS unsigned char* vb = L + buf * MB_BUF + MB_VOFF + l31 * MB_VP + hh * 8 + 128 * kt;
#pragma unroll
                for (int sub = 0; sub < 2; ++sub)
#pragma unroll
                    for (int s2 = 0; s2 < 2; ++s2) { const int ko = (32 * sub + 16 * s2) * 2;
                        vf[(sub * 2 + s2) * 2] = ldsfrag2(vb + ko, vb + ko + 16); vf[(sub * 2 + s2) * 2 + 1] = ldsfrag2(vb + 32 * MB_VP + ko, vb + 32 * MB_VP + ko + 16); } }
            if (own) { const int qrel = 32 * w + l31, kb0 = 64 * kt + 4 * hh;
                if (64 * kt + 63 > 32 * w) {
#pragma unroll
                    for (int r = 0; r < 16; ++r) { const int kv = kb0 + (r & 3) + 8 * (r >> 2); if (kv > qrel) p0[r] = NEGBIG; if (kv + 32 > qrel) p1[r] = NEGBIG; } }
            } else if (!mysel) {
#pragma unroll
                for (int r = 0; r < 16; ++r) { p0[r] = NEGBIG; p1[r] = NEGBIG; } }
            float mxa = fmaxf(p0[0], p1[0]), mxb = fmaxf(p0[1], p1[1]), mxc = fmaxf(p0[2], p1[2]), mxd = fmaxf(p0[3], p1[3]);
#pragma unroll
            for (int r = 4; r < 16; r += 4) { mxa = fmaxf(mxa, fmaxf(p0[r], p1[r])); mxb = fmaxf(mxb, fmaxf(p0[r + 1], p1[r + 1])); mxc = fmaxf(mxc, fmaxf(p0[r + 2], p1[r + 2])); mxd = fmaxf(mxd, fmaxf(p0[r + 3], p1[r + 3])); }
            float mx = fmaxf(fmaxf(mxa, mxb), fmaxf(mxc, mxd));
            mx = fmaxf(mx, __shfl_xor(mx, 32));
            if (first || !__all(mx <= 8.0f)) {
                const float delta = first ? mx : fmaxf(mx, 0.f);
                negm -= delta;
#pragma unroll
                for (int r = 0; r < 16; ++r) { p0[r] -= delta; p1[r] -= delta; }
                if (!first) { const float alpha = fexp2(-delta); lrun *= alpha;
#pragma unroll
                    for (int r = 0; r < 16; ++r) { O0[r] *= alpha; O1[r] *= alpha; } }
                first = false;
            }
            float rsa = 0.f, rsb = 0.f, rsc = 0.f, rsd = 0.f;
#pragma unroll
            for (int r = 0; r < 16; r += 4) { p0[r] = fexp2(p0[r]); p1[r] = fexp2(p1[r]); p0[r + 1] = fexp2(p0[r + 1]); p1[r + 1] = fexp2(p1[r + 1]); p0[r + 2] = fexp2(p0[r + 2]); p1[r + 2] = fexp2(p1[r + 2]); p0[r + 3] = fexp2(p0[r + 3]); p1[r + 3] = fexp2(p1[r + 3]);
                rsa += p0[r] + p1[r]; rsb += p0[r + 1] + p1[r + 1]; rsc += p0[r + 2] + p1[r + 2]; rsd += p0[r + 3] + p1[r + 3]; }
            float rs = (rsa + rsb) + (rsc + rsd);
            rs += __shfl_xor(rs, 32);
            lrun += rs;
#pragma unroll
            for (int sub = 0; sub < 2; ++sub)
#pragma unroll
                for (int s2 = 0; s2 < 2; ++s2) { const bf16x8 pb = packfrag(sub == 0 ? p0 : p1, s2);
                    O0 = MFMA32H(vf[(sub * 2 + s2) * 2], pb, O0);
                    O1 = MFMA32H(vf[(sub * 2 + s2) * 2 + 1], pb, O1); }
        }
        if (bi < jq) stage_write(buf ^ 1);
        __syncthreads();
    }
    {   const float inv = 1.0f / lrun;
        GAS bf16* op = MIX + qrow * DM + hd * 64 + 4 * hh;
#pragma unroll
        for (int g4 = 0; g4 < 4; ++g4) {
            *(GAS v2u*)(op + 8 * g4) = (v2u){pk2h(O0[4 * g4] * inv, O0[4 * g4 + 1] * inv), pk2h(O0[4 * g4 + 2] * inv, O0[4 * g4 + 3] * inv)};
            *(GAS v2u*)(op + 32 + 8 * g4) = (v2u){pk2h(O1[4 * g4] * inv, O1[4 * g4 + 1] * inv), pk2h(O1[4 * g4 + 2] * inv, O1[4 * g4 + 3] * inv)}; }
    }
}

constexpr int SG_ZT = 0, SG_STAT = 34816, SG_OT = 40960;
__device__ __forceinline__ void sgu_unit(Frame& F, int ucur, int unext, const v4u (&zr)[4], const v4u (&ur)[4], v4u (&nz)[4], v4u (&nu)[4]) {
    const int b = ucur >> 6, nc = (ucur >> 2) & 15, g = ucur & 3;
    LAS unsigned char* L = F.lds;
    int tid_ = F.tid; asm volatile("" : "+v"(tid_));
    const int tid = tid_, lane = tid & 63, w = __builtin_amdgcn_readfirstlane(tid >> 6), l31 = lane & 31, hh = lane >> 5;
    const GAS bf16* P = WSPG(bf16, WS_BIG); GAS bf16* MIX = WSPG(bf16, WS_MIX); const GAS bf16* Wb = WSPG(bf16, WS_SGUW) + g * 128 * 128;
    const size_t m0 = (size_t)b * SEQ + nc * 128;
    const int s = tid & 127, qt = tid >> 7, c0 = 32 * qt;
    const int tb0 = w >> 2;
    bf16x8 wf0[4], wf1[8];
#pragma unroll
    for (int ks = 0; ks < 4; ++ks) if (ks < 2 * (tb0 + 1)) wf0[ks] = *(const GAS bf16x8*)(Wb + (32 * tb0 + l31) * 128 + 8 * hh + 16 * ks);
#pragma unroll
    for (int ks = 0; ks < 8; ++ks) if (ks < 2 * (4 - tb0)) wf1[ks] = *(const GAS bf16x8*)(Wb + (32 * (3 - tb0) + l31) * 128 + 8 * hh + 16 * ks);
    if (unext >= 0) {
        const int b2 = unext >> 6, nc2 = (unext >> 2) & 15, g2 = unext & 3; const size_t m2 = (size_t)b2 * SEQ + nc2 * 128;
        const GAS bf16* zp = P + (m2 + s) * PW + 2048 + g2 * 128 + c0; const GAS bf16* up = P + (m2 + (tid >> 2)) * PW + 1536 + g2 * 128 + (tid & 3) * 32;
#pragma unroll
        for (int j4 = 0; j4 < 4; ++j4) { nz[j4] = *(const GAS v4u*)(zp + 8 * j4); nu[j4] = *(const GAS v4u*)(up + 8 * j4); } }
    float z[32];
#pragma unroll
    for (int j4 = 0; j4 < 4; ++j4) { const unsigned vw[4] = {zr[j4].x, zr[j4].y, zr[j4].z, zr[j4].w};
#pragma unroll
        for (int j = 0; j < 4; ++j) { z[8 * j4 + 2 * j] = hlo(vw[j]); z[8 * j4 + 2 * j + 1] = hhi(vw[j]); } }
    float sm = 0.f, sq = 0.f;
#pragma unroll
    for (int j = 0; j < 32; ++j) { sm += z[j]; sq += z[j] * z[j]; }
    LAS float* ST = (LAS float*)(L + SG_STAT);
    ST[(qt * 128 + s) * 2] = sm; ST[(qt * 128 + s) * 2 + 1] = sq;
    __syncthreads();
    {   float a = 0.f, q = 0.f;
#pragma unroll
        for (int k = 0; k < 4; ++k) { a += ST[(k * 128 + s) * 2]; q += ST[(k * 128 + s) * 2 + 1]; }
        const float mu = a * (1.0f / 128.0f), var = q * (1.0f / 128.0f) - mu * mu, rstd = 1.0f / sqrtf(fmaxf(var, 0.f) + EPS);
        const GAS float* lg = INP(17) + g * 128 + c0; const GAS float* lbp = INP(18) + g * 128 + c0;
#pragma unroll
        for (int j = 0; j < 32; ++j) *(LAS bf16*)(L + SG_ZT + (c0 + j) * P128 + s * 2) = (bf16)(pk2h((z[j] - mu) * rstd * lg[j] + lbp[j], 0.f) & 0xffffu);
    }
    __syncthreads();
    const int cb = w & 3;
#pragma unroll
    for (int it = 0; it < 2; ++it) {
        const int tb = it == 0 ? tb0 : 3 - tb0;
        f32x16 acc;
#pragma unroll
        for (int r = 0; r < 16; ++r) acc[r] = 0.f;
        const LAS unsigned char* zb = L + SG_ZT + (32 * cb + l31) * P128 + hh * 16;
        const int nks = 2 * (tb + 1);
#pragma unroll
        for (int ks = 0; ks < (it == 0 ? 4 : 8); ++ks) if (ks < nks) acc = MFMA32H(ldsfrag(zb + ks * 32), it == 0 ? wf0[ks] : wf1[ks], acc);
        const float bias = INP(20)[g * 128 + 32 * tb + l31];
#pragma unroll
        for (int g4 = 0; g4 < 4; ++g4) *(LAS v2u*)(L + SG_OT + (32 * tb + l31) * P128 + (32 * cb + 8 * g4 + 4 * hh) * 2) = (v2u){pk2h(acc[4 * g4] + bias, acc[4 * g4 + 1] + bias), pk2h(acc[4 * g4 + 2] + bias, acc[4 * g4 + 3] + bias)};
    }
    __syncthreads();
    {   const int t = tid >> 2, cc = (tid & 3) * 32;
        GAS bf16* op = MIX + (m0 + t) * DM + 512 + g * 128 + cc;
#pragma unroll
        for (int j4 = 0; j4 < 4; ++j4) { const v4u u = ur[j4], mx = *(const LAS v4u*)(L + SG_OT + t * P128 + (cc + 8 * j4) * 2);
            *(GAS v4u*)(op + 8 * j4) = (v4u){pk2h(hlo(u.x) * hlo(mx.x), hhi(u.x) * hhi(mx.x)), pk2h(hlo(u.y) * hlo(mx.y), hhi(u.y) * hhi(mx.y)), pk2h(hlo(u.z) * hlo(mx.z), hhi(u.z) * hhi(mx.z)), pk2h(hlo(u.w) * hlo(mx.w), hhi(u.w) * hhi(mx.w))}; }
    }
    __syncthreads();
}

__device__ __forceinline__ void sgu_units(Frame& F, int first, int stride) {
    if (first >= 1024) return;
    const int tid = F.tid, s = tid & 127, c0 = 32 * (tid >> 7);
    const GAS bf16* P = WSPG(bf16, WS_BIG);
    v4u za[4], ua[4], zb[4], ub[4];
    {   const int b = first >> 6, nc = (first >> 2) & 15, g = first & 3; const size_t m0 = (size_t)b * SEQ + nc * 128;
        const GAS bf16* zp = P + (m0 + s) * PW + 2048 + g * 128 + c0; const GAS bf16* up = P + (m0 + (tid >> 2)) * PW + 1536 + g * 128 + (tid & 3) * 32;
#pragma unroll
        for (int j4 = 0; j4 < 4; ++j4) { za[j4] = *(const GAS v4u*)(zp + 8 * j4); ua[j4] = *(const GAS v4u*)(up + 8 * j4); } }
#pragma unroll 1
    for (int u = first; u < 1024; u += 2 * stride) {
        const int u1 = u + stride, u2 = u + 2 * stride;
        sgu_unit(F, u, u1 < 1024 ? u1 : -1, za, ua, zb, ub);
        if (u1 < 1024) sgu_unit(F, u1, u2 < 1024 ? u2 : -1, zb, ub, za, ua);
    }
}

__device__ __forceinline__ void final_norm(Frame& F) {
    const int gw = F.bid * NWAVES + F.wave, NGW = F.G * NWAVES, lane = F.lane;
    const GAS float* ssq = WSPG(float, WS_SSQ); const GAS float* gn = INP(6);
    f32x4 gv[4];
#pragma unroll
    for (int j = 0; j < 4; ++j) gv[j] = *(const GAS f32x4*)(gn + 4 * lane + 256 * j);
    for (int m = gw; m < MROWS; m += NGW) {
        const float s = ssq[m];
        const float r = 1.0f / sqrtf(s * (1.0f / DM) + EPS);
        const GAS v2u* xr = (const GAS v2u*)(WSPG(bf16, WS_XB) + (size_t)m * DM) + lane; GAS f32x4* orow = (GAS f32x4*)(F.out + (size_t)m * DM) + lane;
#pragma unroll
        for (int j = 0; j < 4; ++j) { const v2u w = __builtin_nontemporal_load(xr + 64 * j); f32x4 v = (f32x4){hlo(w.x), hhi(w.x), hlo(w.y), hhi(w.y)}; v = v * r * gv[j]; __builtin_nontemporal_store(v, orow + 64 * j); }
    }
}


#ifdef DIS_HGRN
#define HGRN_CALL(...)
#else
#define HGRN_CALL hgrn_unit
#endif
#ifdef DIS_CONV
#define CONV_CALL(...)
#else
#define CONV_CALL conv_tiles
#endif
#ifdef DIS_MOBA
#define MOBA_CALL(...)
#else
#define MOBA_CALL moba_unit
#endif
#ifdef DIS_SGU
#define SGU_CALL(...)
#else
#define SGU_CALL sgu_units
#endif
#ifndef REP_HGRN
#define REP_HGRN 1
#endif
#ifndef REP_CONV
#define REP_CONV 1
#endif
#ifndef REP_MOBA
#define REP_MOBA 1
#endif
#ifndef REP_SGU
#define REP_SGU 1
#endif
#ifndef REP_FFN
#define REP_FFN 1
#endif
#ifndef REP_P0
#define REP_P0 1
#endif
#ifndef GSEL
#define GSEL 0
#endif
#ifdef DIS_GEMM
template <class Epi, class Sched, bool A, bool B> __device__ __forceinline__ void gemm_dummy(LAS unsigned char*, const pg8::Gemm, const Sched&, const Epi&) {}
#define GEMM_CALL gemm_dummy
#else
#define GEMM_CALL pg8::gemm_phase
#endif
__device__ __forceinline__ void sub_barrier(Frame& F, unsigned* cnt, unsigned n) {
    asm volatile("s_waitcnt vmcnt(0)" ::: "memory"); __syncthreads();
    if (F.tid == 0) {
        __threadfence();
        asm volatile("s_waitcnt vmcnt(0)" ::: "memory");
        (void)__hip_atomic_fetch_add(cnt, 1u, __ATOMIC_RELAXED, __HIP_MEMORY_SCOPE_AGENT);
        unsigned sp = 0;
        while (__hip_atomic_load(cnt, __ATOMIC_RELAXED, __HIP_MEMORY_SCOPE_AGENT) < n) { __builtin_amdgcn_s_sleep(2); if (++sp > (1u << 22)) break; }
        __threadfence();
        asm volatile("s_waitcnt vmcnt(0)" ::: "memory");
    }
    __syncthreads();
}
template <int l> __device__ __forceinline__ void layer_phases(Frame& F, const int lo, const int hi, const XcdBarrier& bar, const int vcu) {
#define IN(k) (lo <= (k) && (k) < hi)
#define SEAM(k) do { if (IN(k) && IN((k) + 1)) xcd_barrier(bar); } while (0)
#define PH_ENTER() asm volatile("" : "+s"(F.ws), "+s"(F.out))
#define XB WSP(bf16, WS_XB)
#define BIG WSP(bf16, WS_BIG)
#define MIX WSP(bf16, WS_MIX)
#define QO WSP(bf16, WS_QO)
#define SSQ WSP(float, WS_SSQ)

        constexpr int pb = l == 0 ? 2 : 9;
        if (l == 1) {
            if (IN(8)) { PH_ENTER();
                pg8::Gemm g{XB, WSP(bf16, WS_WIN1), DM, DM, DM}; pg8::StaticOrder S; S.init(MROWS, PW, F.G, F.bid, DM, DM);
                pg8::EpiIn1 E{BIG, SSQ + MROWS, WSP(float, WS_KPART), C2M};
                GEMM_CALL<pg8::EpiIn1, pg8::StaticOrder, true, true>(F.lds, g, S, E);
            } SEAM(8);
        }
        if (IN(pb)) { PH_ENTER();
            if (l == 0) {
                const int nh = F.G > 64 ? 64 : F.G;
                for (int rep = 0; rep < REP_HGRN; ++rep)
                if (F.bid < nh) { for (int u = F.bid; u < 64; u += nh) HGRN_CALL(F, u >> 2, u & 3); }
                for (int rep = 0; rep < REP_CONV; ++rep)
                {   const bool split = F.G > 64; const int g2 = split ? F.G - 64 : F.G, c2 = split ? F.bid - 64 : F.bid;
                    if (c2 >= 0) {
                        CONV_CALL(F, c2, g2);
#pragma unroll 1
                        for (int q = 0; q < 4; ++q) {
                            pg8::Gemm g{WSP(bf16, WS_MEMB), WSP(bf16, (q & 1) ? WS_WV : WS_WK) + (size_t)(q >> 1) * DM * DM, DM, DM, DM}; pg8::StaticOrder S; S.init(MMEM, DM, g2, (c2 + 4 * g2 - 64 * q) % g2, DM, DM);
                            pg8::EpiK E{WSP(bf16, (q & 1) ? WS_VT : WS_KB) + (size_t)(q >> 1) * MMEM * DM, WSP(float, WS_RMEM)};
                            GEMM_CALL<pg8::EpiK, pg8::StaticOrder, true, true>(F.lds, g, S, E); }
                        convert_rest(F, c2 * NWAVES + F.wave, g2 * NWAVES);
                        sub_barrier(F, (unsigned*)(F.ws + WS_CTL) + 900, (unsigned)g2);
                        {   int k256 = 256; asm volatile("" : "+s"(k256));
                            {   pg8::Gemm g{WSP(bf16, WS_KB), WSP(bf16, WS_WQ), k256, DM, DM}; pg8::SubOrder S{g2, (c2 + 64) % g2, 0};
                                pg8::EpiSub E{QO, 0};
                                GEMM_CALL<pg8::EpiSub, pg8::SubOrder, true, true>(F.lds, g, S, E); }
                            {   pg8::Gemm g{WSP(bf16, WS_WO), WSP(bf16, WS_VT), k256, DM, DM}; pg8::SubOrder S{g2, (c2 + 128) % g2, 1};
                                pg8::EpiSub E{QO + (size_t)16 * DM * DM, 1};
                                GEMM_CALL<pg8::EpiSub, pg8::SubOrder, true, true>(F.lds, g, S, E); } }
                    } }
            } else {
                for (int rep = 0; rep < REP_MOBA; ++rep)
                for (int p = vcu; p < 512; p += F.G) { const int b = p >> 5, hd = (p >> 2) & 7, pj = p & 3; MOBA_CALL(F, b, hd, 7 - pj); MOBA_CALL(F, b, hd, pj); }
                for (int rep = 0; rep < REP_SGU; ++rep)
                SGU_CALL(F, vcu, F.G);
            }
        } SEAM(pb);
        if (IN(pb + 1)) { PH_ENTER();
            if (l == 1) {
            int k256 = 256; asm volatile("" : "+s"(k256));
            {   pg8::Gemm g{WSP(bf16, WS_KB) + (size_t)l * MMEM * DM, WSP(bf16, WS_WQ) + (size_t)l * DM * DM, k256, DM, DM}; pg8::SubOrder S{F.G, F.bid, 0};
                pg8::EpiSub E{BIG, 0};
#ifndef DIS_SUB
                GEMM_CALL<pg8::EpiSub, pg8::SubOrder, true, true>(F.lds, g, S, E);
#endif
 }
            {   pg8::Gemm g{WSP(bf16, WS_WO) + (size_t)l * DM * DM, WSP(bf16, WS_VT) + (size_t)l * MMEM * DM, k256, DM, DM}; pg8::SubOrder S{F.G, F.bid, 1};
                pg8::EpiSub E{BIG + (size_t)16 * DM * DM, 1};
#ifndef DIS_SUB
                GEMM_CALL<pg8::EpiSub, pg8::SubOrder, true, true>(F.lds, g, S, E);
#endif
 }
            }
            pg8::Gemm g{MIX, WSP(bf16, l == 0 ? WS_WOUT0 : WS_WOUT1), DM, DM, DM}; pg8::StaticOrder S; S.init(MROWS, DM, F.G, F.bid, DM, DM);
            constexpr int j = 1 + 3 * l;
            for (int i = F.bid * (NWAVES * 64) + F.tid; i < MROWS; i += F.G * NWAVES * 64) (SSQ + ((j + 1) & 1) * MROWS)[i] = 0.f;
            pg8::EpiRes E{XB, nullptr, SSQ + (j & 1) * MROWS};
            GEMM_CALL<pg8::EpiRes, pg8::StaticOrder, true, true>(F.lds, g, S, E);
        } SEAM(pb + 1);
        if (IN(pb + 2)) { PH_ENTER();
            pg8::Gemm g{XB, l == 0 ? QO : BIG, DM, DM, DM}; pg8::StaticOrder S; S.init(MROWS, DM, F.G, F.bid, DM, DM, DM);
            pg8::EpiSoftmax E{MIX, SSQ + ((1 + 3 * l) & 1) * MROWS, (LAS float*)(F.lds + RING_BYTES)};
#ifndef DIS_SM
            GEMM_CALL<pg8::EpiSoftmax, pg8::StaticOrder, true, true>(F.lds, g, S, E);
#endif
        } SEAM(pb + 2);
        if (IN(pb + 3)) { PH_ENTER();
            pg8::Gemm g{MIX, (l == 0 ? QO : BIG) + (size_t)16 * DM * DM, DM, DM, DM}; pg8::StaticOrder S; S.init(MROWS, DM, F.G, F.bid, DM, DM, DM);
            constexpr int j = 2 + 3 * l;
            for (int i = F.bid * (NWAVES * 64) + F.tid; i < MROWS; i += F.G * NWAVES * 64) (SSQ + ((j + 1) & 1) * MROWS)[i] = 0.f;
            pg8::EpiRes E{XB, nullptr, SSQ + (j & 1) * MROWS};
            GEMM_CALL<pg8::EpiRes, pg8::StaticOrder, true, true>(F.lds, g, S, E);
        } SEAM(pb + 3);
        if (IN(pb + 4)) { PH_ENTER();
            pg8::Gemm g{XB, WSP(bf16, WS_WFI) + (size_t)l * DM * 2 * FFH, DM, DM, DM}; pg8::StaticOrder S; S.init(MROWS, 2 * FFH, F.G, F.bid, DM, DM);
            pg8::EpiFfn E{BIG, SSQ + ((2 + 3 * l) & 1) * MROWS};
            for (int rep = 0; rep < REP_FFN; ++rep)
            GEMM_CALL<pg8::EpiFfn, pg8::StaticOrder, true, true>(F.lds, g, S, E);
        } SEAM(pb + 4);
        if (IN(pb + 5)) { PH_ENTER();
            pg8::Gemm g{BIG, WSP(bf16, WS_WFO) + (size_t)l * FFH * DM, FFH, FFH, FFH}; pg8::StaticOrder S; S.init(MROWS, DM, F.G, F.bid, FFH, FFH);
            constexpr int j = 3 + 3 * l;
            for (int i = F.bid * (NWAVES * 64) + F.tid; i < MROWS; i += F.G * NWAVES * 64) (SSQ + ((j + 1) & 1) * MROWS)[i] = 0.f;
            pg8::EpiRes E{XB, nullptr, SSQ + (j & 1) * MROWS};
            GEMM_CALL<pg8::EpiRes, pg8::StaticOrder, true, true>(F.lds, g, S, E);
        } SEAM(pb + 5);

#undef IN
#undef SEAM
#undef PH_ENTER
#undef XB
#undef BIG
#undef MIX
#undef QO
#undef SSQ
}

__global__ void __launch_bounds__(NWAVES * 64, 2) fwd_kernel(Args args) {
    extern __shared__ __attribute__((aligned(16))) unsigned char lds[];
    Frame F;
    F.lds = (LAS unsigned char*)lds;
    F.tid = threadIdx.x; F.lane = F.tid & 63; F.wave = __builtin_amdgcn_readfirstlane(F.tid >> 6);
    F.G = gridDim.x; F.bid = blockIdx.x;
    F.ka = (const CAS Args*)__builtin_amdgcn_kernarg_segment_ptr();
    F.out = args.out; F.ws = args.ws;
    const int vcu = (F.G % 8 == 0) ? (F.bid % 8) * (F.G / 8) + F.bid / 8 : F.bid;
    volatile LAS unsigned* MISC = (volatile LAS unsigned*)(F.lds + MISC_OFF);
    for (int u = F.tid; u < (LDS_BYTES - LDSCTL_OFF) / 4; u += NWAVES * 64) ((LAS unsigned*)(F.lds + LDSCTL_OFF))[u] = 0u;
    __syncthreads();
    const int lo = args.ph_lo, hi = args.ph_hi;
    unsigned* barw = (unsigned*)(F.ws + WS_CTL) + CW_BAR;
    XcdBarrier bar; bar.bar = barw; bar.x = 0; bar.st = nullptr;
    if (hi - lo > 1) bar = xcd_barrier_post(barw, MISC + 8);
#define IN(k) (lo <= (k) && (k) < hi)
#define PH_ENTER() asm volatile("" : "+s"(F.ws), "+s"(F.out))
#define SEAM(k) do { if (IN(k) && IN((k) + 1)) xcd_barrier(bar); } while (0)
#define XB WSP(bf16, WS_XB)
#define BIG WSP(bf16, WS_BIG)
#define MIX WSP(bf16, WS_MIX)
#define QO WSP(bf16, WS_QO)
#define SSQ WSP(float, WS_SSQ)

    #ifndef DIS_P0
    for (int rep = 0; rep < REP_P0; ++rep)
    if (IN(0)) { PH_ENTER(); p0_prologue(F); }
#endif
    SEAM(0);

    if (IN(1)) { PH_ENTER();
        pg8::Gemm g{XB, WSP(bf16, WS_WIN0), DM, DM, DM}; pg8::StaticOrder S; S.init(MROWS, 3072, F.G, F.bid, DM, DM);
        pg8::EpiIn0 E{BIG, SSQ, WSP(float, WS_LB)};
        GEMM_CALL<pg8::EpiIn0, pg8::StaticOrder, true, true>(F.lds, g, S, E);
    } SEAM(1);

    layer_phases<0>(F, lo, hi, bar, vcu);
    layer_phases<1>(F, lo, hi, bar, vcu);
    #ifndef DIS_FIN
    if (IN(15)) final_norm(F);
#endif
#undef IN
#undef SEAM
#undef XB
#undef BIG
#undef MIX
#undef QO
#undef SSQ
}

extern "C" void kernel_launch(void* const* d_in, const int* in_sizes, int n_in, void* d_out, int out_size, void* d_ws, size_t ws_size, hipStream_t stream) {
    static int grid = 0;
    if (grid == 0) {
        if (n_in != 26 || in_sizes[0] != MROWS * DM || out_size != MROWS * DM || ws_size < WS_END) {
            fprintf(stderr, "kernel_launch: unexpected shapes (n_in %d, in0 %d, out %d, ws %zu); nothing launched\n", n_in, n_in > 0 ? in_sizes[0] : -1, out_size, ws_size); grid = -1; return; }
        int dev = 0, cus = 0;
        if (hipGetDevice(&dev) != hipSuccess || hipDeviceGetAttribute(&cus, hipDeviceAttributeMultiprocessorCount, dev) != hipSuccess) { fprintf(stderr, "kernel_launch: device query failed\n"); grid = -1; return; }
        if (hipFuncSetAttribute((const void*)fwd_kernel, hipFuncAttributeMaxDynamicSharedMemorySize, LDS_BYTES) != hipSuccess) { fprintf(stderr, "kernel_launch: hipFuncSetAttribute failed\n"); grid = -1; return; }
        (void)hipGetLastError();
        grid = cus > 256 ? 256 : cus;
    }
    if (grid < 0) return;
    (void)hipMemsetAsync((char*)d_ws + WS_CTL, 0, CTL_ZERO_BYTES, stream);
    Args a{};
    for (int i = 0; i < 26; ++i) a.in[i] = (const float*)d_in[i];
    a.out = (float*)d_out; a.ws = (unsigned char*)d_ws;
#if MK_ONE_LAUNCH
    a.ph_lo = 0; a.ph_hi = NPH;
    hipLaunchKernelGGL(fwd_kernel, dim3(grid), dim3(NWAVES * 64), LDS_BYTES, stream, a);
#else
    for (int p = 0; p < NPH; ++p) { a.ph_lo = p; a.ph_hi = p + 1; hipLaunchKernelGGL(fwd_kernel, dim3(grid), dim3(NWAVES * 64), LDS_BYTES, stream, a); }
#endif
}
```

```cpp
#include <hip/hip_runtime.h>
#include <cstdio>
#include <cstdint>
#include <cmath>
namespace pg8 {
#define PG8_LAS __attribute__((address_space(3)))
typedef unsigned short bf16_t;
typedef short bf16x8 __attribute__((ext_vector_type(8)));
typedef float f32x4 __attribute__((ext_vector_type(4)));
typedef unsigned u32x4 __attribute__((ext_vector_type(4)));
constexpr int BM = 256, BK = 64, HALF = 128, HTB = HALF * BK * 2  , STAGE_BYTES = 8 * HTB, NXCD = 8, WGM = 8;

__host__ __device__ __forceinline__ int lds_byte(int r, int c) { const int st = (r >> 4) * 2 + (c >> 5), rr = r & 15, cc = c & 31, ob = rr * 64 + cc * 2; return st * 1024 + (ob ^ (((ob >> 9) & 1) << 5)); }
__host__ __device__ __forceinline__ void stage_rc(int b, int& R, int& C) { const int st = b / 1024, sb = b % 1024, swz = sb ^ (((sb >> 9) & 1) << 5); R = (st >> 1) * 16 + swz / 64; C = (st & 1) * 32 + (swz % 64) / 2; }
__host__ __device__ __forceinline__ int perm32(int rho) { const int n = rho >> 4, i = rho & 15; return 8 * (i >> 2) + 4 * n + (i & 3); }

struct Unit { int pm, pn; unsigned aoff, boff; };
struct Gemm { const bf16_t* A; const bf16_t* Bt; int K, lda, ldb; };

struct StaticOrder {
    int nM, nN, nwg, G, c, lda, ldb, bbatch;
    __host__ __device__ void init(int M, int N, int G_, int c_, int lda_, int ldb_, int bbatch_ = 0) { nM = M / BM; nN = N / BM; nwg = nM * nN; G = G_; c = c_; lda = lda_; ldb = ldb_; bbatch = bbatch_; }
    __host__ __device__ bool next(int i, Unit& u) const {
        const long L = (long)i * G + c; if (L >= nwg) return false;
        int wgid = (int)L; { const int q = nwg / NXCD, r = nwg % NXCD, xcd = wgid % NXCD, off = wgid / NXCD; wgid = (xcd < r ? xcd * (q + 1) : r * (q + 1) + (xcd - r) * q) + off; }
        const int nig = WGM * nN, gid = wgid / nig, fm = gid * WGM, gsz = (nM - fm) < WGM ? (nM - fm) : WGM;
        u.pm = fm + ((wgid % nig) % gsz); u.pn = (wgid % nig) / gsz;
        u.aoff = (unsigned)u.pm * (unsigned)(BM * lda); u.boff = ((unsigned)u.pn * BM + (unsigned)(u.pm >> 3) * (unsigned)bbatch) * (unsigned)ldb; return true;
    }
    __device__ __forceinline__ void a_ready(const Unit&) const {}
    __device__ __forceinline__ void done(const Unit&) const {}
};

typedef _Float16 h16x8 __attribute__((ext_vector_type(8))); typedef _Float16 h16x2 __attribute__((ext_vector_type(2))); typedef float f32x2c __attribute__((ext_vector_type(2)));
__device__ __forceinline__ unsigned cvt_pk_bf16(float lo, float hi) { const f32x2c v = {lo, hi}; const h16x2 h = __builtin_convertvector(v, h16x2); return __builtin_bit_cast(unsigned, h); }
typedef float f32x2 __attribute__((ext_vector_type(2)));
__device__ __forceinline__ f32x2 gelu_pk(f32x2 v) {
    const f32x2 av = __builtin_elementwise_abs(v), d = av * 0.2316418882f + 1.0f;
    f32x2 t; t.x = __builtin_amdgcn_rcpf(d.x); t.y = __builtin_amdgcn_rcpf(d.y);
    f32x2 q = t * 0.5307027145f + (-0.7265760135f); q = q * t + 0.7107068705f; q = q * t + (-0.142248368f); q = q * t + 0.127414796f; q = q * t;
    const f32x2 s = (v * v) * (-0.72134752044f);
    f32x2 e; e.x = __builtin_amdgcn_exp2f(s.x); e.y = __builtin_amdgcn_exp2f(s.y);
    const f32x2 m = v * (q * e), r = v - m;
    f32x2 o; o.x = v.x < 0.f ? m.x : r.x; o.y = v.y < 0.f ? m.y : r.y; return o;
}


constexpr int RM = 32768;
constexpr float EPS_ = 1e-6f, LOG2E_ = 1.4426950408889634f;
__device__ __forceinline__ float sigm(float x) { return __builtin_amdgcn_rcpf(1.0f + __builtin_amdgcn_exp2f(-x * LOG2E_)); }
__device__ __forceinline__ float silu_(float x) { return x * sigm(x); }
__device__ __forceinline__ u32x4 pack8(const f32x4 a, const f32x4 b) { u32x4 w; w.x = cvt_pk_bf16(a[0], a[1]); w.y = cvt_pk_bf16(a[2], a[3]); w.z = cvt_pk_bf16(b[0], b[1]); w.w = cvt_pk_bf16(b[2], b[3]); return w; }
__device__ __forceinline__ void row_scales(const float* ssq, int pm, int wr, int lane, float (&v)[2]) {
#pragma unroll
    for (int ai = 0; ai < 2; ++ai) v[ai] = 1.0f / sqrtf(ssq[pm * BM + ai * HALF + wr * 64 + lane] * (1.0f / 1024.0f) + EPS_);
}
#define ROWSCALE(ai, m) __shfl(rv[ai], 16 * (m) + fr)
#define ROWFENCE() asm volatile("" ::: "memory")
__device__ __forceinline__ f32x2 swiglu_pk(f32x2 a, f32x2 g) {
    const f32x2 t = a * (-LOG2E_); f32x2 e; e.x = __builtin_amdgcn_exp2f(t.x); e.y = __builtin_amdgcn_exp2f(t.y);
    const f32x2 d = e + 1.0f; f32x2 s; s.x = __builtin_amdgcn_rcpf(d.x); s.y = __builtin_amdgcn_rcpf(d.y);
    return (a * g) * s;
}
__device__ __forceinline__ f32x2 xsig_pk(f32x2 x, f32x2 y) {
    const f32x2 t = y * (-LOG2E_); f32x2 e; e.x = __builtin_amdgcn_exp2f(t.x); e.y = __builtin_amdgcn_exp2f(t.y);
    const f32x2 d = e + 1.0f; f32x2 s; s.x = __builtin_amdgcn_rcpf(d.x); s.y = __builtin_amdgcn_rcpf(d.y);
    return x * s;
}
__device__ __forceinline__ f32x4 xsig4(const f32x4 x, const f32x4 y) { const f32x2 lo = xsig_pk((f32x2){x[0], x[1]}, (f32x2){y[0], y[1]}), hi = xsig_pk((f32x2){x[2], x[3]}, (f32x2){y[2], y[3]}); return (f32x4){lo.x, lo.y, hi.x, hi.y}; }
struct EpiIn0 {
    static constexpr bool PERM = true, AFTER_DRAIN = false;
    bf16_t* P; const float* ssq; const float* lb;
    __device__ __forceinline__ void operator()(const f32x4 (&acc)[2][2][4][2], const Unit& u, int wr, int wc, int fr, int fq) const {
        float rv[2]; row_scales(ssq, u.pm, wr, fq * 16 + fr, rv);
        const int row0 = u.pm * BM + wr * 64 + fr, pn = u.pn;
        if (pn < 8) {
            const int typ = pn >> 1;
#pragma unroll
            for (int bj = 0; bj < 2; ++bj) { const int col0 = pn * BM + bj * HALF + wc * 32 + 8 * fq;
                f32x4 l0 = (f32x4){0.f, 0.f, 0.f, 0.f}, l1 = l0;
                if (typ == 1) { l0 = 1.0f - *(const f32x4*)(lb + col0 - 512); l1 = 1.0f - *(const f32x4*)(lb + col0 - 508); }
#pragma unroll
                for (int ai = 0; ai < 2; ++ai)
#pragma unroll
                    for (int m = 0; m < 4; ++m) { const float r = ROWSCALE(ai, m); f32x4 v0 = acc[ai][bj][m][0] * r, v1 = acc[ai][bj][m][1] * r;
                        if (typ == 0 || typ == 3) { v0 = xsig4(v0, v0); v1 = xsig4(v1, v1); }
                        else if (typ == 1) { v0 = xsig4(l0, -v0); v1 = xsig4(l1, -v1); }
                        *(u32x4*)(P + (size_t)(row0 + ai * HALF + m * 16) * 2560 + col0) = pack8(v0, v1); ROWFENCE(); } }
        } else {
            const int col0 = 2048 + (pn - 8) * HALF + wc * 32 + 8 * fq;
#pragma unroll
            for (int ai = 0; ai < 2; ++ai)
#pragma unroll
                for (int m = 0; m < 4; ++m) { const float r = ROWSCALE(ai, m);
                    const f32x4 v0 = xsig4(acc[ai][0][m][0] * r, acc[ai][1][m][0] * r), v1 = xsig4(acc[ai][0][m][1] * r, acc[ai][1][m][1] * r);
                    *(u32x4*)(P + (size_t)(row0 + ai * HALF + m * 16) * 2560 + col0) = pack8(v0, v1); ROWFENCE(); }
        }
    }
};
struct EpiIn1 {
    static constexpr bool PERM = true, AFTER_DRAIN = false;
    bf16_t* P; const float* ssq; float* kpart; float qscale;
    __device__ __forceinline__ void operator()(const f32x4 (&acc)[2][2][4][2], const Unit& u, int wr, int wc, int fr, int fq) const {
        float rv[2]; row_scales(ssq, u.pm, wr, fq * 16 + fr, rv);
        const int row0 = u.pm * BM + wr * 64 + fr, pn = u.pn;
        const int typ = pn < 2 ? 0 : (pn < 4 ? 1 : (pn < 6 ? 2 : 3));
#pragma unroll
        for (int bj = 0; bj < 2; ++bj) { const int col0 = pn * BM + bj * HALF + wc * 32 + 8 * fq;
            f32x4 cs0 = (f32x4){0.f, 0.f, 0.f, 0.f}, cs1 = cs0;
#pragma unroll
            for (int ai = 0; ai < 2; ++ai)
#pragma unroll
                for (int m = 0; m < 4; ++m) { const float r = ROWSCALE(ai, m); f32x4 v0 = acc[ai][bj][m][0] * r, v1 = acc[ai][bj][m][1] * r;
                    if (typ == 0) { v0 = v0 * qscale; v1 = v1 * qscale; }
                    else if (typ == 1) { cs0 += v0; cs1 += v1; }
                    else if (typ == 3) { f32x2 a = gelu_pk((f32x2){v0[0], v0[1]}), b = gelu_pk((f32x2){v0[2], v0[3]}), c = gelu_pk((f32x2){v1[0], v1[1]}), d = gelu_pk((f32x2){v1[2], v1[3]});
                        v0 = (f32x4){a.x, a.y, b.x, b.y}; v1 = (f32x4){c.x, c.y, d.x, d.y}; }
                    *(u32x4*)(P + (size_t)(row0 + ai * HALF + m * 16) * 2560 + col0) = pack8(v0, v1); ROWFENCE(); }
            if (typ == 1) {
#pragma unroll
                for (int i = 0; i < 4; ++i) {
#pragma unroll
                    for (int o = 1; o < 16; o <<= 1) { cs0[i] += __shfl_xor(cs0[i], o); cs1[i] += __shfl_xor(cs1[i], o); } }
                if (fr == 0) { float* kp = kpart + (size_t)(u.pm * 2 + wr) * 512 + (col0 - 512); *(f32x4*)kp = cs0; *(f32x4*)(kp + 4) = cs1; }
            } }
    }
};
struct EpiRes {
    static constexpr bool PERM = true, AFTER_DRAIN = false;
    bf16_t* xb; float* outf; float* ssqw;
    __device__ __forceinline__ void operator()(const f32x4 (&acc)[2][2][4][2], const Unit& u, int wr, int wc, int fr, int fq) const {
        const int row0 = u.pm * BM + wr * 64 + fr;
#pragma unroll
        for (int ai = 0; ai < 2; ++ai)
#pragma unroll
            for (int m = 0; m < 4; ++m) { const int row = row0 + ai * HALF + m * 16; float ss = 0.f;
#pragma unroll
                for (int bj = 0; bj < 2; ++bj) { const size_t off = (size_t)row * 1024 + u.pn * BM + bj * HALF + wc * 32 + 8 * fq;
                    const u32x4 b = *(const u32x4*)(xb + off);
                    const h16x8 bh = __builtin_bit_cast(h16x8, b);
                    const f32x4 b0 = (f32x4){(float)bh[0], (float)bh[1], (float)bh[2], (float)bh[3]};
                    const f32x4 b1 = (f32x4){(float)bh[4], (float)bh[5], (float)bh[6], (float)bh[7]};
                    const f32x4 v0 = b0 + acc[ai][bj][m][0], v1 = b1 + acc[ai][bj][m][1];
                    ss += (v0[0] * v0[0] + v0[1] * v0[1]) + (v0[2] * v0[2] + v0[3] * v0[3]) + (v1[0] * v1[0] + v1[1] * v1[1]) + (v1[2] * v1[2] + v1[3] * v1[3]);
                    if (outf) { *(f32x4*)(outf + off) = v0; *(f32x4*)(outf + off + 4) = v1; }
                    else *(u32x4*)(xb + off) = pack8(v0, v1); }
                ss += __shfl_xor(ss, 16); ss += __shfl_xor(ss, 32);
                if (fq == 0) atomicAdd(ssqw + row, ss);
                ROWFENCE(); }
    }
};
struct EpiFfn {
    static constexpr bool PERM = true, AFTER_DRAIN = false;
    bf16_t* H; const float* ssq;
    __device__ __forceinline__ void operator()(const f32x4 (&acc)[2][2][4][2], const Unit& u, int wr, int wc, int fr, int fq) const {
        float rv[2]; row_scales(ssq, u.pm, wr, fq * 16 + fr, rv);
        const int row0 = u.pm * BM + wr * 64 + fr, col0 = u.pn * HALF + wc * 32 + 8 * fq;
#pragma unroll
        for (int ai = 0; ai < 2; ++ai)
#pragma unroll
            for (int m = 0; m < 4; ++m) { const float r = ROWSCALE(ai, m);
                const f32x4 a0 = acc[ai][0][m][0] * r, a1 = acc[ai][0][m][1] * r, g0 = acc[ai][1][m][0] * r, g1 = acc[ai][1][m][1] * r;
                const f32x2 p0 = swiglu_pk((f32x2){a0[0], a0[1]}, (f32x2){g0[0], g0[1]}), p1 = swiglu_pk((f32x2){a0[2], a0[3]}, (f32x2){g0[2], g0[3]}),
                            p2 = swiglu_pk((f32x2){a1[0], a1[1]}, (f32x2){g1[0], g1[1]}), p3 = swiglu_pk((f32x2){a1[2], a1[3]}, (f32x2){g1[2], g1[3]});
                *(u32x4*)(H + (size_t)(row0 + ai * HALF + m * 16) * 2816 + col0) = pack8((f32x4){p0.x, p0.y, p1.x, p1.y}, (f32x4){p2.x, p2.y, p3.x, p3.y}); ROWFENCE(); }
    }
};
struct SubOrder {
    int G, c, mode;
    __device__ __forceinline__ bool next(int i, Unit& u) const {
        const int L = i * G + c; if (L >= 256) return false;
        const unsigned b = L >> 4, h = (L >> 2) & 3, t = L & 3; u.pm = L; u.pn = 0;
        const unsigned x = (b * 256u) * 1024u + h * 256u, y = (t * 256u) * 1024u + h * 256u;
        u.aoff = mode == 0 ? x : y; u.boff = mode == 0 ? y : x; return true;
    }
    __device__ __forceinline__ void a_ready(const Unit&) const {}
    __device__ __forceinline__ void done(const Unit&) const {}
};
struct EpiSub {
    static constexpr bool PERM = true, AFTER_DRAIN = false;
    bf16_t* O; int mode;
    __device__ __forceinline__ void operator()(const f32x4 (&acc)[2][2][4][2], const Unit& u, int wr, int wc, int fr, int fq) const {
        const int L = u.pm, b = L >> 4, h = (L >> 2) & 3, t = L & 3;
        const int rb = b * 1024 + (mode == 0 ? h : t) * 256 + wr * 64 + fr, cb = (mode == 0 ? t : h) * 256 + wc * 32 + 8 * fq;
#pragma unroll
        for (int ai = 0; ai < 2; ++ai)
#pragma unroll
            for (int m = 0; m < 4; ++m)
#pragma unroll
                for (int bj = 0; bj < 2; ++bj) *(u32x4*)(O + (size_t)(rb + ai * HALF + m * 16) * 1024 + cb + bj * HALF) = pack8(acc[ai][bj][m][0], acc[ai][bj][m][1]);
    }
};
struct EpiSoftmax {
    static constexpr bool PERM = true, AFTER_DRAIN = false;
    bf16_t* P; const float* ssq; PG8_LAS float* scr;
    __device__ __forceinline__ void operator()(f32x4 (&acc)[2][2][4][2], const Unit& u, int wr, int wc, int fr, int fq) const {
        float rv[2]; row_scales(ssq, u.pm, wr, fq * 16 + fr, rv);
        PG8_LAS float* MX = scr; PG8_LAS float* SM = scr + 1024;
        float mx[2][4];
#pragma unroll
        for (int ai = 0; ai < 2; ++ai)
#pragma unroll
            for (int m = 0; m < 4; ++m) { const float r = ROWSCALE(ai, m); float v = -3.0e38f;
#pragma unroll
                for (int bj = 0; bj < 2; ++bj)
#pragma unroll
                    for (int n = 0; n < 2; ++n) { acc[ai][bj][m][n] = acc[ai][bj][m][n] * r; const f32x4 x = acc[ai][bj][m][n]; v = fmaxf(v, fmaxf(fmaxf(x[0], x[1]), fmaxf(x[2], x[3]))); }
                v = fmaxf(v, __shfl_xor(v, 16)); v = fmaxf(v, __shfl_xor(v, 32));
                if (fq == 0) MX[(ai * HALF + wr * 64 + m * 16 + fr) * 4 + wc] = v; }
        asm volatile("s_waitcnt lgkmcnt(0)" ::: "memory"); __builtin_amdgcn_s_barrier(); asm volatile("" ::: "memory");
#pragma unroll
        for (int ai = 0; ai < 2; ++ai)
#pragma unroll
            for (int m = 0; m < 4; ++m) { const f32x4 q = *(const PG8_LAS f32x4*)(MX + (ai * HALF + wr * 64 + m * 16 + fr) * 4); const float mm = fmaxf(fmaxf(q[0], q[1]), fmaxf(q[2], q[3])); float sm = 0.f;
#pragma unroll
                for (int bj = 0; bj < 2; ++bj)
#pragma unroll
                    for (int n = 0; n < 2; ++n) { f32x4 x = acc[ai][bj][m][n];
#pragma unroll
                        for (int i = 0; i < 4; ++i) { x[i] = __builtin_amdgcn_exp2f(x[i] - mm); sm += x[i]; }
                        acc[ai][bj][m][n] = x; }
                sm += __shfl_xor(sm, 16); sm += __shfl_xor(sm, 32);
                if (fq == 0) SM[(ai * HALF + wr * 64 + m * 16 + fr) * 4 + wc] = sm; }
        asm volatile("s_waitcnt lgkmcnt(0)" ::: "memory"); __builtin_amdgcn_s_barrier(); asm volatile("" ::: "memory");
        const int row0 = u.pm * BM + wr * 64 + fr;
#pragma unroll
        for (int ai = 0; ai < 2; ++ai)
#pragma unroll
            for (int m = 0; m < 4; ++m) { const f32x4 q = *(const PG8_LAS f32x4*)(SM + (ai * HALF + wr * 64 + m * 16 + fr) * 4); const float inv = __builtin_amdgcn_rcpf((q[0] + q[1]) + (q[2] + q[3]));
#pragma unroll
                for (int bj = 0; bj < 2; ++bj) *(u32x4*)(P + (size_t)(row0 + ai * HALF + m * 16) * 1024 + u.pn * BM + bj * HALF + wc * 32 + 8 * fq) = pack8(acc[ai][bj][m][0] * inv, acc[ai][bj][m][1] * inv);
                ROWFENCE(); }
    }
};
struct EpiK {
    static constexpr bool PERM = true, AFTER_DRAIN = false;
    bf16_t* O; const float* rmem;
    __device__ __forceinline__ void operator()(const f32x4 (&acc)[2][2][4][2], const Unit& u, int wr, int wc, int fr, int fq) const {
        const int row0 = u.pm * BM + wr * 64 + fr;
#pragma unroll
        for (int ai = 0; ai < 2; ++ai)
#pragma unroll
            for (int m = 0; m < 4; ++m) { const int row = row0 + ai * HALF + m * 16; const float r = rmem[row];
#pragma unroll
                for (int bj = 0; bj < 2; ++bj) *(u32x4*)(O + (size_t)row * 1024 + u.pn * BM + bj * HALF + wc * 32 + 8 * fq) = pack8(acc[ai][bj][m][0] * r, acc[ai][bj][m][1] * r); }
    }
};
template <class Epi, class Sched, bool ALIGN_EPI = false, bool SP2 = false>
__device__ __forceinline__ void gemm_phase(PG8_LAS unsigned char* lds, const Gemm g, const Sched& S, const Epi& E) {
    int tid_ = threadIdx.x; asm volatile("" : "+v"(tid_));
    const int tid = tid_, wid = __builtin_amdgcn_readfirstlane(tid >> 6), lane = tid & 63, wr = wid >> 2, wc = wid & 3, fr = lane & 15, fq = lane >> 4;
    const int K = g.K, nt = K / BK;
    unsigned voffA[2], voffB[2];
#pragma unroll
    for (int i = 0; i < 2; ++i) { int R, C; stage_rc(tid * 16 + i * 8192, R, C); const int Rb = Epi::PERM ? ((R & ~31) + perm32(R & 31)) : R;
        voffA[i] = (unsigned)(R * g.lda + C) * 2u; voffB[i] = (unsigned)(Rb * g.ldb + C) * 2u; }
    const size_t kstep = (size_t)(BK * 2);
    const size_t hstepA = (size_t)HALF * g.lda * 2, hstepB = (size_t)HALF * g.ldb * 2;
    const unsigned ldsw = (unsigned)wid * 1024u;
    const int aoff = lds_byte(wr * 64 + fr, fq * 8), boff = lds_byte(wc * 32 + fr, fq * 8);
#define PG8_SA(b, h) (((b) * 2 + (h)) * HTB)
#define PG8_SB(b, h) ((4 + (b) * 2 + (h)) * HTB)
#define PG8_STAGE(bufoff, gbase, voff) do { _Pragma("unroll") for (int _i = 0; _i < 2; ++_i) \
        __builtin_amdgcn_global_load_lds((const unsigned*)((const char*)(gbase) + (voff)[_i]), (PG8_LAS unsigned*)(lds + (bufoff) + ldsw + _i * 8192), 16, 0, 0); } while (0)
#define PG8_LDA(dst, b, h) do { _Pragma("unroll") for (int m = 0; m < 4; ++m) _Pragma("unroll") for (int k = 0; k < 2; ++k) dst[m][k] = *(const PG8_LAS bf16x8*)(lds + PG8_SA(b, h) + aoff + m * 2048 + k * 1024); } while (0)
#define PG8_LDB(dst, b, h) do { _Pragma("unroll") for (int n = 0; n < 2; ++n) _Pragma("unroll") for (int k = 0; k < 2; ++k) dst[n][k] = *(const PG8_LAS bf16x8*)(lds + PG8_SB(b, h) + boff + n * 2048 + k * 1024); } while (0)
#define PG8_MMA(ai, bj, At, Bt) do { __builtin_amdgcn_s_setprio(1); _Pragma("unroll") for (int m = 0; m < 4; ++m) _Pragma("unroll") for (int n = 0; n < 2; ++n) _Pragma("unroll") for (int k = 0; k < 2; ++k) \
        acc[ai][bj][m][n] = __builtin_amdgcn_mfma_f32_16x16x32_f16(__builtin_bit_cast(h16x8, Bt[n][k]), __builtin_bit_cast(h16x8, At[m][k]), acc[ai][bj][m][n], 0, 0, 0); __builtin_amdgcn_s_setprio(0); } while (0)
#define PG8_WAIT_V(n) asm volatile("s_waitcnt vmcnt(" #n ")" ::: "memory")
#define PG8_WAIT_L(n) asm volatile("s_waitcnt lgkmcnt(" #n ")" ::: "memory")
#define PG8_BAR __builtin_amdgcn_s_barrier()
#define PG8_SCHED __builtin_amdgcn_sched_barrier(0)
    Unit cur, nxt; int ui = 0;
    if (!S.next(0, cur)) return;
    f32x4 acc[2][2][4][2];
#pragma unroll
    for (int a = 0; a < 2; ++a)
#pragma unroll
        for (int b = 0; b < 2; ++b)
#pragma unroll
            for (int m = 0; m < 4; ++m)
#pragma unroll
                for (int n = 0; n < 2; ++n) acc[a][b][m][n] = (f32x4){0.f, 0.f, 0.f, 0.f};
    bf16x8 At[4][2], B0[2][2], B1[2][2];
    const char* cA = (const char*)g.A + (size_t)cur.aoff * 2; const char* cB = (const char*)g.Bt + (size_t)cur.boff * 2;
    S.a_ready(cur);
    if constexpr (SP2) {
        PG8_STAGE(PG8_SB(0, 0), cB, voffB); PG8_STAGE(PG8_SB(0, 1), cB + hstepB, voffB); PG8_STAGE(PG8_SA(0, 0), cA, voffA); PG8_STAGE(PG8_SA(0, 1), cA + hstepA, voffA);
        if (wr == 1) PG8_BAR;
        PG8_WAIT_V(2); PG8_BAR;
        PG8_STAGE(PG8_SB(1, 0), cB + kstep, voffB); PG8_STAGE(PG8_SA(1, 0), cA + kstep, voffA); PG8_STAGE(PG8_SB(1, 1), cB + hstepB + kstep, voffB);
        PG8_WAIT_V(6); PG8_BAR;
    } else {
        PG8_STAGE(PG8_SB(0, 0), cB, voffB); PG8_STAGE(PG8_SA(0, 0), cA, voffA); PG8_STAGE(PG8_SB(0, 1), cB + hstepB, voffB); PG8_STAGE(PG8_SA(0, 1), cA + hstepA, voffA);
        if (wr == 1) PG8_BAR;
        PG8_WAIT_V(4); PG8_BAR;
        PG8_STAGE(PG8_SB(1, 0), cB + kstep, voffB); PG8_STAGE(PG8_SA(1, 0), cA + kstep, voffA); PG8_STAGE(PG8_SB(1, 1), cB + hstepB + kstep, voffB);
        PG8_WAIT_V(6); PG8_BAR;
    }
    for (;;) {
        const bool has_next = S.next(ui + 1, nxt);
        const char* nA = has_next ? (const char*)g.A + (size_t)nxt.aoff * 2 : cA; const char* nB = has_next ? (const char*)g.Bt + (size_t)nxt.boff * 2 : cB;
        for (int t = 0; t < nt; t += 2) {
            const bool last = (t == nt - 2);
            const char* a1 = cA + (size_t)(t + 1) * kstep;
            const char* a2 = last ? nA : cA + (size_t)(t + 2) * kstep; const char* b2 = last ? nB : cB + (size_t)(t + 2) * kstep;
            const char* a3 = a2 + kstep; const char* b3 = b2 + kstep;
            if (last && has_next) S.a_ready(nxt);
            if constexpr (SP2) {
            PG8_LDB(B0, 0, 0); PG8_LDB(B1, 0, 1); PG8_SCHED; PG8_LDA(At, 0, 0); PG8_STAGE(PG8_SA(1, 1), a1 + hstepA, voffA);
            PG8_WAIT_V(8); PG8_WAIT_L(0); PG8_BAR; PG8_MMA(0, 0, At, B0); PG8_MMA(0, 1, At, B1); PG8_BAR; PG8_SCHED;
            PG8_LDA(At, 0, 1); PG8_STAGE(PG8_SB(0, 0), b2, voffB); PG8_STAGE(PG8_SB(0, 1), b2 + hstepB, voffB); PG8_STAGE(PG8_SA(0, 0), a2, voffA);
            PG8_WAIT_V(8); PG8_WAIT_L(0); PG8_BAR; PG8_MMA(1, 0, At, B0); PG8_MMA(1, 1, At, B1); PG8_BAR; PG8_SCHED;
            PG8_LDB(B0, 1, 0); PG8_LDB(B1, 1, 1); PG8_SCHED; PG8_LDA(At, 1, 0); PG8_STAGE(PG8_SA(0, 1), a2 + hstepA, voffA);
            PG8_WAIT_V(8); PG8_WAIT_L(0); PG8_BAR; PG8_MMA(0, 0, At, B0); PG8_MMA(0, 1, At, B1); PG8_BAR; PG8_SCHED;
            PG8_LDA(At, 1, 1); PG8_STAGE(PG8_SB(1, 0), b3, voffB); PG8_STAGE(PG8_SB(1, 1), b3 + hstepB, voffB); PG8_STAGE(PG8_SA(1, 0), a3, voffA);
            PG8_WAIT_V(8); PG8_WAIT_L(0); PG8_BAR; PG8_MMA(1, 0, At, B0); PG8_MMA(1, 1, At, B1); PG8_BAR; PG8_SCHED;
            } else {
            PG8_LDB(B0, 0, 0); PG8_SCHED; PG8_LDA(At, 0, 0); PG8_STAGE(PG8_SA(1, 1), a1 + hstepA, voffA);
            PG8_WAIT_L(8); PG8_BAR; PG8_WAIT_L(0); PG8_MMA(0, 0, At, B0); PG8_BAR; PG8_SCHED;
            PG8_LDB(B1, 0, 1); PG8_STAGE(PG8_SB(0, 0), b2, voffB);
            PG8_BAR; PG8_WAIT_L(0); PG8_MMA(0, 1, At, B1); PG8_BAR;
            PG8_LDA(At, 0, 1); PG8_STAGE(PG8_SA(0, 0), a2, voffA);
            PG8_BAR; PG8_WAIT_L(0); PG8_MMA(1, 0, At, B0); PG8_BAR; PG8_SCHED;
            PG8_STAGE(PG8_SB(0, 1), b2 + hstepB, voffB);
            PG8_WAIT_V(6); PG8_BAR; PG8_MMA(1, 1, At, B1); PG8_BAR;
            PG8_LDB(B0, 1, 0); PG8_SCHED; PG8_LDA(At, 1, 0); PG8_STAGE(PG8_SA(0, 1), a2 + hstepA, voffA);
            PG8_WAIT_L(8); PG8_BAR; PG8_WAIT_L(0); PG8_MMA(0, 0, At, B0); PG8_BAR; PG8_SCHED;
            PG8_LDB(B1, 1, 1); PG8_STAGE(PG8_SB(1, 0), b3, voffB);
            PG8_BAR; PG8_WAIT_L(0); PG8_MMA(0, 1, At, B1); PG8_BAR;
            PG8_LDA(At, 1, 1); PG8_STAGE(PG8_SA(1, 0), a3, voffA);
            PG8_BAR; PG8_WAIT_L(0); PG8_MMA(1, 0, At, B0); PG8_BAR; PG8_SCHED;
            PG8_STAGE(PG8_SB(1, 1), b3 + hstepB, voffB);
            PG8_WAIT_V(6); PG8_BAR; PG8_MMA(1, 1, At, B1); PG8_BAR;
            }
        }
        if constexpr (ALIGN_EPI) { if (wr == 0) PG8_BAR; }
        if constexpr (!Epi::AFTER_DRAIN) { E(acc, cur, wr, wc, fr, fq); S.done(cur); }
        if (!has_next) break;
#pragma unroll
        for (int a = 0; a < 2; ++a)
#pragma unroll
            for (int b = 0; b < 2; ++b)
#pragma unroll
                for (int m = 0; m < 4; ++m)
#pragma unroll
                    for (int n = 0; n < 2; ++n) acc[a][b][m][n] = (f32x4){0.f, 0.f, 0.f, 0.f};
        cur = nxt; cA = nA; cB = nB; ++ui;
        if constexpr (ALIGN_EPI) { if (wr == 1) PG8_BAR; }
    }
    PG8_WAIT_V(0);
    if constexpr (!ALIGN_EPI) { if (wr == 0) PG8_BAR; }
    PG8_BAR;
    if constexpr (Epi::AFTER_DRAIN) { E.fused(acc, cur, wr, wc, fr, fq, lds, wid, lane); S.done(cur); }
#undef PG8_SA
#undef PG8_SB
#undef PG8_STAGE
#undef PG8_LDA
#undef PG8_LDB
#undef PG8_MMA
#undef PG8_WAIT_V
#undef PG8_WAIT_L
#undef PG8_BAR
#undef PG8_SCHED
}
}

constexpr int NWAVES = 8;
constexpr int BATCH = 16, SEQ = 2048, DM = 1024, MROWS = BATCH * SEQ, MEMLEN = 256, MMEM = BATCH * MEMLEN, FFH = 2816, PW = 2560;
constexpr float EPS = 1e-6f, LOG2E = 1.4426950408889634f;
constexpr float C2M = 0.125f * LOG2E;
constexpr float C2X = 0.0625f * LOG2E;
constexpr float NEGBIG = -1.0e30f;
constexpr int NPH = 16;
#ifndef MK_ONE_LAUNCH
#define MK_ONE_LAUNCH 1
#endif

constexpr size_t MiB = 1u << 20;
constexpr size_t WS_CTL = 0, CTL_ZERO_BYTES = 64 * 1024;
constexpr size_t WS_LB = 1 * MiB, WS_RMEM = 1 * MiB + 4096, WS_SGUW = 1 * MiB + 65536, WS_KPART = 1 * MiB + 512 * 1024;
constexpr size_t WS_SSQ = 2 * MiB;
constexpr size_t WS_WIN0 = 4 * MiB, WS_WOUT0 = 10 * MiB, WS_WIN1 = 12 * MiB, WS_WOUT1 = 17 * MiB, WS_WQ = 19 * MiB, WS_WO = 23 * MiB, WS_WK = 27 * MiB, WS_WV = 31 * MiB,
                 WS_WFI = 35 * MiB, WS_WFO = 57 * MiB;
constexpr size_t WS_MEMB = 68 * MiB, WS_KB = 76 * MiB, WS_VT = 92 * MiB;
constexpr size_t WS_XB = 112 * MiB, WS_BIG = 176 * MiB, WS_MIX = 352 * MiB, WS_QO = 416 * MiB, WS_END = 480 * MiB;
constexpr int CW_BAR = 1024;

constexpr int RING_BYTES = 131072, LDS_BYTES = 147456, LDSCTL_OFF = LDS_BYTES - 512, MISC_OFF = LDSCTL_OFF;

#define GAS __attribute__((address_space(1)))
#define LAS __attribute__((address_space(3)))
typedef unsigned short bf16;
typedef unsigned v4u __attribute__((ext_vector_type(4)));
typedef unsigned v2u __attribute__((ext_vector_type(2)));
typedef float f32x4 __attribute__((ext_vector_type(4)));
typedef float f32x16 __attribute__((ext_vector_type(16)));
typedef short bf16x8 __attribute__((ext_vector_type(8)));
typedef short s16x4 __attribute__((ext_vector_type(4)));
typedef GAS unsigned gu32;
#define LDS_WAIT() asm volatile("s_waitcnt lgkmcnt(0)" ::: "memory")
#define VM_WAIT() asm volatile("s_waitcnt vmcnt(0)" ::: "memory")
__device__ __forceinline__ float bf2f(unsigned short b) { return __uint_as_float(((unsigned)b) << 16); }
__device__ __forceinline__ float bflo(unsigned w) { return __uint_as_float(w << 16); }
__device__ __forceinline__ float bfhi(unsigned w) { return __uint_as_float(w & 0xffff0000u); }
typedef float f32x2_t __attribute__((ext_vector_type(2))); typedef __bf16 bf16x2_t __attribute__((ext_vector_type(2)));
__device__ __forceinline__ unsigned pk2(float lo, float hi) { f32x2_t v = {lo, hi}; bf16x2_t b = __builtin_convertvector(v, bf16x2_t); return __builtin_bit_cast(unsigned, b); }
typedef _Float16 h16x8 __attribute__((ext_vector_type(8))); typedef _Float16 h16x2 __attribute__((ext_vector_type(2)));
__device__ __forceinline__ unsigned pk2h(float lo, float hi) { f32x2_t v = {lo, hi}; h16x2 h = __builtin_convertvector(v, h16x2); return __builtin_bit_cast(unsigned, h); }
__device__ __forceinline__ float h2f(unsigned short b) { return (float)__builtin_bit_cast(_Float16, b); }
__device__ __forceinline__ float hlo(unsigned w) { return (float)__builtin_bit_cast(h16x2, w)[0]; }
__device__ __forceinline__ float hhi(unsigned w) { return (float)__builtin_bit_cast(h16x2, w)[1]; }
__device__ __forceinline__ float fexp2(float x) { return __builtin_amdgcn_exp2f(x); }
__device__ __forceinline__ float fexp(float x) { return __builtin_amdgcn_exp2f(x * LOG2E); }
__device__ __forceinline__ float sigm(float x) { return __builtin_amdgcn_rcpf(1.0f + __builtin_amdgcn_exp2f(-x * LOG2E)); }
__device__ __forceinline__ float wave_sum(float v) {
#pragma unroll
    for (int o = 1; o < 64; o <<= 1) v += __shfl_xor(v, o);
    return v;
}
#define MFMA32(a, b, c) __builtin_amdgcn_mfma_f32_32x32x16_bf16((a), (b), (c), 0, 0, 0)
#define MFMA32H(a, b, c) __builtin_amdgcn_mfma_f32_32x32x16_f16(__builtin_bit_cast(h16x8, (a)), __builtin_bit_cast(h16x8, (b)), (c), 0, 0, 0)
__device__ __forceinline__ bf16x8 ldsfrag(const LAS unsigned char* p) { return *(const LAS bf16x8*)p; }
__device__ __forceinline__ bf16x8 ldsfrag2(const LAS unsigned char* p0, const LAS unsigned char* p1) {
    const s16x4 lo = *(const LAS s16x4*)p0, hi = *(const LAS s16x4*)p1;
    return (bf16x8){lo[0], lo[1], lo[2], lo[3], hi[0], hi[1], hi[2], hi[3]};
}
__device__ __forceinline__ bf16x8 packfrag(const f32x16& p, int s2) {
    v4u w; w.x = pk2h(p[8 * s2 + 0], p[8 * s2 + 1]); w.y = pk2h(p[8 * s2 + 2], p[8 * s2 + 3]); w.z = pk2h(p[8 * s2 + 4], p[8 * s2 + 5]); w.w = pk2h(p[8 * s2 + 6], p[8 * s2 + 7]);
    return __builtin_bit_cast(bf16x8, w);
}
template <int NKS, bool H = false> __device__ __forceinline__ void mma_lds(f32x16& acc, const LAS unsigned char* pa, const LAS unsigned char* pb) {
    bf16x8 fa[NKS], fb[NKS];
#pragma unroll
    for (int ks = 0; ks < NKS; ++ks) { fa[ks] = ldsfrag(pa + ks * 32); fb[ks] = ldsfrag(pb + ks * 32); }
#pragma unroll
    for (int ks = 0; ks < NKS; ++ks) { if constexpr (H) acc = MFMA32H(fa[ks], fb[ks], acc); else acc = MFMA32(fa[ks], fb[ks], acc); }
}
#define XB_TMO      128
#define XB_XCNT(j)  (256  + 64 * (j))
#define XB_XSUB(j)  (1280 + 64 * (j))
#define XB_XGEN(j)  (2304 + 64 * (j))
#define XB_TOP      3328
#define XB_TOPGEN   3392
#define XCD_BAR_WORDS 3456
#define XB_SPIN_CAP (1u << 18)

__device__ __forceinline__ unsigned xb_ld(unsigned* p)              { return __hip_atomic_load(p, __ATOMIC_RELAXED, __HIP_MEMORY_SCOPE_AGENT); }
__device__ __forceinline__ unsigned xb_add(unsigned* p, unsigned v) { return __hip_atomic_fetch_add(p, v, __ATOMIC_RELAXED, __HIP_MEMORY_SCOPE_AGENT); }
__device__ __forceinline__ unsigned xb_xcc_id() { return (unsigned)__builtin_amdgcn_s_getreg((3 << 11) | 20) & 0xFu; }
#define XB_SPIN(cond, bar) do { unsigned _sp = 0; while (cond) { __builtin_amdgcn_s_sleep(1); \
    if ((++_sp & 255u) == 0u) { if (xb_ld(&(bar)[XB_TMO])) break; if (_sp > XB_SPIN_CAP) { atomicAdd(&(bar)[XB_TMO], 1u); break; } } } } while (0)

struct XcdBarrier {
    unsigned* bar; unsigned x;
    volatile LAS unsigned* st;
};

__device__ __forceinline__ XcdBarrier xcd_barrier_post(unsigned* bar, volatile LAS unsigned* st) {
    XcdBarrier b; b.bar = bar; b.x = xb_xcc_id(); b.st = st;
    if (threadIdx.x == 0) (void)xb_add(&bar[XB_XCNT(b.x)], 1u);
    return b;
}
__device__ __forceinline__ void xcd_barrier_complete(unsigned* bar, unsigned x, unsigned& nloc, unsigned& nx) {
    const unsigned G = gridDim.x * gridDim.y * gridDim.z;
    unsigned sum, cnt, mine, sp = 0u;
    for (;;) {
        sum = 0u; cnt = 0u; mine = 0u;
#pragma unroll
        for (unsigned j = 0; j < 16; ++j) { const unsigned c = xb_ld(&bar[XB_XCNT(j)]); sum += c; cnt += (c > 0u) ? 1u : 0u; mine = (j == x) ? c : mine; }
        if (sum == G) break;
        __builtin_amdgcn_s_sleep(1);
        if ((++sp & 255u) == 0u) { if (xb_ld(&bar[XB_TMO])) break; if (sp > XB_SPIN_CAP) { atomicAdd(&bar[XB_TMO], 1u); break; } }
    }
    nloc = mine > 0u ? mine : 1u; nx = cnt > 0u ? cnt : 1u;
}

__device__ __forceinline__ void xcd_barrier(const XcdBarrier& b) {
    asm volatile("s_waitcnt vmcnt(0)" ::: "memory");
    __syncthreads();
    if (threadIdx.x == 0) {
        unsigned* bar = b.bar;
        __builtin_amdgcn_s_waitcnt(0);
        unsigned nloc = b.st[0], nx = b.st[1];
        if (nloc == 0u) { xcd_barrier_complete(bar, b.x, nloc, nx); b.st[0] = nloc; b.st[1] = nx; }
        const unsigned old = xb_add(&bar[XB_XSUB(b.x)], 1u);
        const unsigned gen = old / nloc;
        if (old + 1u == (gen + 1u) * nloc) {
            __builtin_amdgcn_fence(__ATOMIC_RELEASE, "agent");
            asm volatile("s_waitcnt vmcnt(0)" ::: "memory");
            const unsigned og = xb_add(&bar[XB_TOP], 1u);
            const unsigned tg = og / nx;
            if (og + 1u == (tg + 1u) * nx) xb_add(&bar[XB_TOPGEN], 1u);
            else XB_SPIN(xb_ld(&bar[XB_TOPGEN]) == tg, bar);
            __builtin_amdgcn_fence(__ATOMIC_ACQUIRE, "agent");
            xb_add(&bar[XB_XGEN(b.x)], 1u);
            asm volatile("s_waitcnt vmcnt(0)" ::: "memory");
        } else {
            XB_SPIN(xb_ld(&bar[XB_XGEN(b.x)]) == gen, bar);
            __builtin_amdgcn_fence(__ATOMIC_ACQUIRE, "agent");
            asm volatile("s_waitcnt vmcnt(0)" ::: "memory");
        }
    }
    __syncthreads();
}

#define CAS __attribute__((address_space(4)))
struct Args { const float* in[26]; float* out; unsigned char* ws; int ph_lo, ph_hi; };
struct Frame {
    LAS unsigned char* lds;
    int tid, lane, wave, G, bid;
    const CAS struct Args* ka;
    float* out; unsigned char* ws;
};
#define WSP(T, off) ((T*)(F.ws + (off)))
#define WSPG(T, off) ((GAS T*)((GAS unsigned char*)F.ws + (off)))
#define INP(k) ((const GAS float*)F.ka->in[k])

__device__ __forceinline__ void tr_item(const GAS float* W, int ldw, int K, int scol0, int k0, GAS bf16* WT, int drow0, const GAS float* gain, LAS float* scr, int lane) {
    f32x4 v[8]; float gn[8];
#pragma unroll
    for (int i = 0; i < 8; ++i) { const int kk = 8 * i + (lane >> 3); v[i] = __builtin_nontemporal_load((const GAS f32x4*)(W + (size_t)(k0 + kk) * ldw + scol0 + 4 * (lane & 7))); gn[i] = gain ? gain[k0 + kk] : 1.0f; }
#pragma unroll
    for (int i = 0; i < 8; ++i) { const int kk = 8 * i + (lane >> 3); LAS float* d = scr + kk * 33 + 4 * (lane & 7);
        d[0] = v[i][0] * gn[i]; d[1] = v[i][1] * gn[i]; d[2] = v[i][2] * gn[i]; d[3] = v[i][3] * gn[i]; }
    LDS_WAIT(); asm volatile("" ::: "memory");
    const int c = lane & 7;
#pragma unroll
    for (int j = 0; j < 4; ++j) { const int n = (lane >> 3) + 8 * j; const LAS float* s = scr + (8 * c) * 33 + n;
        v4u o; o.x = pk2h(s[0 * 33], s[1 * 33]); o.y = pk2h(s[2 * 33], s[3 * 33]); o.z = pk2h(s[4 * 33], s[5 * 33]); o.w = pk2h(s[6 * 33], s[7 * 33]);
        *(GAS v4u*)(WT + (size_t)(drow0 + n) * K + k0 + 8 * c) = o; }
    LDS_WAIT(); asm volatile("" ::: "memory");
}
__device__ __forceinline__ bool tr_matrix(int& r, const GAS float* W, int ldw, int K, int N, int soff, int map, GAS bf16* WT, const GAS float* gain, LAS float* scr, int lane) {
    const int nblk = N / 32, cnt = (K / 64) * nblk;
    if (r >= cnt) { r -= cnt; return false; }
    const int kb = r / nblk, nb = r % nblk, d0 = 32 * nb; int sc = d0;
    if (map == 1 && d0 >= 2048) { const int q = d0 - 2048; sc = 2048 + ((q >> 7) & 1) * 512 + (q >> 8) * 128 + (q & 127); }
    if (map == 2) sc = ((d0 >> 7) & 1) * FFH + (d0 >> 8) * 128 + (d0 & 127);
    tr_item(W, ldw, K, soff + sc, 64 * kb, WT, d0, gain, scr, lane);
    return true;
}
__device__ __forceinline__ void convert_rest(Frame& F, int wi, int nw) {
    LAS float* scr = (LAS float*)(F.lds + F.wave * 16384);
    const int lane = F.lane;
    constexpr int NITEMS = 512 + 1280 + 512 + 2 * (512 + 2816 + 1408);
    for (int it = wi; it < NITEMS; it += nw) {
        int r = it;
        if (tr_matrix(r, INP(8), DM, DM, DM, 0, 0, WSPG(bf16, WS_WOUT0), nullptr, scr, lane)) continue;
        if (tr_matrix(r, INP(15), PW, DM, PW, 0, 0, WSPG(bf16, WS_WIN1), INP(2) + DM, scr, lane)) continue;
        if (tr_matrix(r, INP(16), DM, DM, DM, 0, 0, WSPG(bf16, WS_WOUT1), nullptr, scr, lane)) continue;
        bool done = false;
#pragma unroll
        for (int l = 0; l < 2; ++l) {
            if (done) break;
            if (tr_matrix(r, INP(23) + (size_t)l * DM * DM, DM, DM, DM, 0, 0, WSPG(bf16, WS_WO) + (size_t)l * DM * DM, nullptr, scr, lane)) { done = true; break; }
            if (tr_matrix(r, INP(24) + (size_t)l * DM * 2 * FFH, 2 * FFH, DM, 2 * FFH, 0, 2, WSPG(bf16, WS_WFI) + (size_t)l * DM * 2 * FFH, INP(4) + l * DM, scr, lane)) { done = true; break; }
            if (tr_matrix(r, INP(25) + (size_t)l * FFH * DM, DM, FFH, DM, 0, 0, WSPG(bf16, WS_WFO) + (size_t)l * FFH * DM, nullptr, scr, lane)) { done = true; break; }
        }
    }
    for (int it = wi; it < 2 * DM; it += nw) {
        const int l = it >> 10, i = it & (DM - 1);
        const float gsc = INP(3)[l * DM + i] * C2X;
        const GAS f32x4* xr = (const GAS f32x4*)(INP(21) + ((size_t)l * DM + i) * DM) + lane;
        GAS v2u* o8 = (GAS v2u*)(WSPG(bf16, WS_WQ) + ((size_t)l * DM + i) * DM) + lane;
#pragma unroll
        for (int j = 0; j < 4; ++j) { const f32x4 v = __builtin_nontemporal_load(xr + 64 * j) * gsc; v2u w; w.x = pk2h(v[0], v[1]); w.y = pk2h(v[2], v[3]); o8[64 * j] = w; }
    }
    __syncthreads();
}
__device__ __forceinline__ void p0_prologue(Frame& F) {
    LAS float* scr = (LAS float*)(F.lds + F.wave * 16384);
    const int gw = F.bid * NWAVES + F.wave, NGW = F.G * NWAVES, lane = F.lane;
    for (int it = gw; it < 1536 + 2048; it += NGW) { int r = it;
        if (tr_matrix(r, INP(7), 3072, DM, 3072, 0, 1, WSPG(bf16, WS_WIN0), INP(2), scr, lane)) continue;
        bool done = false;
#pragma unroll
        for (int l = 0; l < 2; ++l) {
            if (done) break;
            if (tr_matrix(r, INP(22) + (size_t)l * DM * 2048, 2048, DM, DM, 0, 0, WSPG(bf16, WS_WK) + (size_t)l * DM * DM, INP(5), scr, lane)) { done = true; break; }
            if (tr_matrix(r, INP(22) + (size_t)l * DM * 2048, 2048, DM, DM, 1024, 0, WSPG(bf16, WS_WV) + (size_t)l * DM * DM, INP(5), scr, lane)) { done = true; break; }
        } }
    {   const GAS float* x = INP(0); GAS bf16* xb = WSPG(bf16, WS_XB); GAS float* ssq = WSPG(float, WS_SSQ);
        for (int m = gw; m < MROWS; m += NGW) {
            const GAS f32x4* xr = (const GAS f32x4*)(x + (size_t)m * DM) + lane; f32x4 v[4]; float s = 0.f;
#pragma unroll
            for (int j = 0; j < 4; ++j) { v[j] = __builtin_nontemporal_load(xr + 64 * j); s += (v[j][0] * v[j][0] + v[j][1] * v[j][1]) + (v[j][2] * v[j][2] + v[j][3] * v[j][3]); }
            s = wave_sum(s);
            GAS v2u* o8 = (GAS v2u*)(xb + (size_t)m * DM) + lane;
#pragma unroll
            for (int j = 0; j < 4; ++j) { v2u w; w.x = pk2h(v[j][0], v[j][1]); w.y = pk2h(v[j][2], v[j][3]); o8[64 * j] = w; }
            if (lane == 0) { ssq[m] = s; ssq[MROWS + m] = 0.f; }
        } }
    {   const GAS float* x = INP(1); GAS bf16* xb = WSPG(bf16, WS_MEMB); GAS float* rm = WSPG(float, WS_RMEM);
        for (int m = gw; m < MMEM; m += NGW) {
            const GAS f32x4* xr = (const GAS f32x4*)(x + (size_t)m * DM) + lane; f32x4 v[4]; float s = 0.f;
#pragma unroll
            for (int j = 0; j < 4; ++j) { v[j] = __builtin_nontemporal_load(xr + 64 * j); s += (v[j][0] * v[j][0] + v[j][1] * v[j][1]) + (v[j][2] * v[j][2] + v[j][3] * v[j][3]); }
            s = wave_sum(s);
            GAS v2u* o8 = (GAS v2u*)(xb + (size_t)m * DM) + lane;
#pragma unroll
            for (int j = 0; j < 4; ++j) { v2u w; w.x = pk2h(v[j][0], v[j][1]); w.y = pk2h(v[j][2], v[j][3]); o8[64 * j] = w; }
            if (lane == 0) rm[m] = 1.0f / sqrtf(s * (1.0f / DM) + EPS);
        } }
    {   const int idx = F.bid * (NWAVES * 64) + F.tid, NT = F.G * NWAVES * 64;
        for (int i = idx; i < 512; i += NT) { const float a0 = INP(9)[i], a1 = INP(9)[512 + i], a2 = INP(9)[1024 + i]; const float mx = fmaxf(a0, fmaxf(a1, a2));
            const float e0 = __expf(a0 - mx), e1 = __expf(a1 - mx), e2 = __expf(a2 - mx); WSPG(float, WS_LB)[i] = e0 / (e0 + e1 + e2); }
        for (int i = idx; i < 4 * 128 * 128; i += NT) { const int t = (i >> 7) & 127, s = i & 127; WSPG(bf16, WS_SGUW)[i] = (bf16)(s <= t ? (pk2h(INP(19)[i], 0.f) & 0xffffu) : 0u); }
    }
}

constexpr int HG_QIN = 0, HG_KIN = 17408, HG_KOT = 34816, HG_VTT = 53248, HG_ATT = 71680, HG_STT = 80896, HG_OST = 115712, HG_DEC = 133120, HG_SSQ = 133632;
constexpr int P128 = 272, P64 = 144;
__device__ __forceinline__ float wave_scan(float v) {
#define HG_DPP(ctrl, rmask) v += __builtin_bit_cast(float, __builtin_amdgcn_update_dpp(0, __builtin_bit_cast(int, v), (ctrl), (rmask), 0xf, false))
    HG_DPP(0x111, 0xf); HG_DPP(0x112, 0xf); HG_DPP(0x114, 0xf); HG_DPP(0x118, 0xf); HG_DPP(0x142, 0xa); HG_DPP(0x143, 0xc);
#undef HG_DPP
    return v;
}
__device__ __forceinline__ void hgrn_unit(Frame& F, int b, int h) {
    LAS unsigned char* L = F.lds;
    int tid_ = F.tid; asm volatile("" : "+v"(tid_));
    const int tid = tid_, lane = tid & 63, w = __builtin_amdgcn_readfirstlane(tid >> 6), l31 = lane & 31, hh = lane >> 5;
    const GAS bf16* P = WSPG(bf16, WS_BIG); GAS bf16* MIX = WSPG(bf16, WS_MIX);
    const int vs = tid >> 3, vec = (tid & 7) * 16;
    const int eb = w & 3, cb = w >> 2;
    f32x16 S0, S1;
#pragma unroll
    for (int r = 0; r < 16; ++r) { S0[r] = 0.f; S1[r] = 0.f; }
    for (int i = tid; i < 34816 / 16; i += 512) *(LAS v4u*)(L + HG_STT + i * 16) = (v4u){0u, 0u, 0u, 0u};
    float onorm[16];
#pragma unroll
    for (int j = 0; j < 16; ++j) onorm[j] = INP(10)[h * 128 + vec + j];
    LAS float* DEC = (LAS float*)(L + HG_DEC); LAS float* SSQ = (LAS float*)(L + HG_SSQ);
    const GAS bf16* pbase = P + ((size_t)b * SEQ + lane) * PW + h * 128 + 16 * w;
    const GAS bf16* gbase = P + ((size_t)b * SEQ + vs) * PW + 1536 + h * 128 + vec;
    v4u ra0, ra1, ra2, ra3, ra4, ra5, rb0, rb1, rb2, rb3, rb4, rb5, ga0, ga1, gb0, gb1;
    ra0 = *(const GAS v4u*)(pbase); ra1 = *(const GAS v4u*)(pbase + 8); ra2 = *(const GAS v4u*)(pbase + 512); ra3 = *(const GAS v4u*)(pbase + 520); ra4 = *(const GAS v4u*)(pbase + 1024); ra5 = *(const GAS v4u*)(pbase + 1032);
    {   const GAS bf16* p1 = pbase + (size_t)64 * PW;
        rb0 = *(const GAS v4u*)(p1); rb1 = *(const GAS v4u*)(p1 + 8); rb2 = *(const GAS v4u*)(p1 + 512); rb3 = *(const GAS v4u*)(p1 + 520); rb4 = *(const GAS v4u*)(p1 + 1024); rb5 = *(const GAS v4u*)(p1 + 1032); }
    ga0 = *(const GAS v4u*)(gbase); ga1 = *(const GAS v4u*)(gbase + 8); gb0 = *(const GAS v4u*)(gbase + (size_t)64 * PW); gb1 = *(const GAS v4u*)(gbase + (size_t)64 * PW + 8);
    auto chunk = [&](const int n, v4u& rq0, v4u& rq1, v4u& rk0, v4u& rk1, v4u& rv0, v4u& rv1, v4u& g0, v4u& g1) {
        const size_t m0 = (size_t)b * SEQ + n * 64;
        {   const unsigned qw[8] = {rq0.x, rq0.y, rq0.z, rq0.w, rq1.x, rq1.y, rq1.z, rq1.w}, kw[8] = {rk0.x, rk0.y, rk0.z, rk0.w, rk1.x, rk1.y, rk1.z, rk1.w}, vw[8] = {rv0.x, rv0.y, rv0.z, rv0.w, rv1.x, rv1.y, rv1.z, rv1.w};
            float kk[16], cm[16];
#pragma unroll
            for (int j2 = 0; j2 < 8; ++j2) { kk[2 * j2] = hlo(kw[j2]); kk[2 * j2 + 1] = hhi(kw[j2]); }
#pragma unroll
            for (int j = 0; j < 16; ++j) cm[j] = __builtin_amdgcn_logf(1.0f - kk[j]);
#define HG_STEP(ctrl, rmask) _Pragma("unroll") for (int j = 0; j < 16; ++j) cm[j] += __builtin_bit_cast(float, __builtin_amdgcn_update_dpp(0, __builtin_bit_cast(int, cm[j]), (ctrl), (rmask), 0xf, false))
            HG_STEP(0x111, 0xf); HG_STEP(0x112, 0xf); HG_STEP(0x114, 0xf); HG_STEP(0x118, 0xf); HG_STEP(0x142, 0xa); HG_STEP(0x143, 0xc);
#undef HG_STEP
            unsigned qo[8], ko[8]; float decv = 0.f;
#pragma unroll
            for (int j2 = 0; j2 < 8; ++j2) {
                float qi[2], ki[2];
#pragma unroll
                for (int t = 0; t < 2; ++t) { const int j = 2 * j2 + t;
                    const float e1 = fexp2(cm[j]), e2 = __builtin_amdgcn_rcpf(e1), dec = __builtin_bit_cast(float, __builtin_amdgcn_readlane(__builtin_bit_cast(int, e1), 63));
                    qi[t] = (t == 0 ? hlo(qw[j2]) : hhi(qw[j2])) * e1; ki[t] = kk[j] * e2;
                    *(LAS bf16*)(L + HG_KOT + (16 * w + j) * P64 + lane * 2) = (bf16)(pk2h(ki[t] * dec, 0.f) & 0xffffu);
                    decv = lane == j ? dec : decv; }
                qo[j2] = pk2(qi[0], qi[1]); ko[j2] = pk2(ki[0], ki[1]);
                *(LAS bf16*)(L + HG_VTT + (16 * w + 2 * j2) * P64 + lane * 2) = (bf16)(vw[j2] & 0xffffu);
                *(LAS bf16*)(L + HG_VTT + (16 * w + 2 * j2 + 1) * P64 + lane * 2) = (bf16)(vw[j2] >> 16);
            }
            if (lane < 16) DEC[16 * w + lane] = decv;
            *(LAS v4u*)(L + HG_QIN + lane * P128 + 32 * w) = (v4u){qo[0], qo[1], qo[2], qo[3]}; *(LAS v4u*)(L + HG_QIN + lane * P128 + 32 * w + 16) = (v4u){qo[4], qo[5], qo[6], qo[7]};
            *(LAS v4u*)(L + HG_KIN + lane * P128 + 32 * w) = (v4u){ko[0], ko[1], ko[2], ko[3]}; *(LAS v4u*)(L + HG_KIN + lane * P128 + 32 * w + 16) = (v4u){ko[4], ko[5], ko[6], ko[7]};
        }
        __syncthreads();
        {   const int n2c = n + 2 < 32 ? n + 2 : 31;
            const GAS bf16* pn = pbase + (size_t)n2c * 64 * PW;
            rq0 = *(const GAS v4u*)(pn); rq1 = *(const GAS v4u*)(pn + 8); rk0 = *(const GAS v4u*)(pn + 512); rk1 = *(const GAS v4u*)(pn + 520); rv0 = *(const GAS v4u*)(pn + 1024); rv1 = *(const GAS v4u*)(pn + 1032); }
        f32x16 o;
#pragma unroll
        for (int r = 0; r < 16; ++r) o[r] = 0.f;
        mma_lds<8>(o, L + HG_STT + (32 * eb + l31) * P128 + hh * 16, L + HG_QIN + (32 * cb + l31) * P128 + hh * 16);
        if (w < 3) {
            const int sb = w >> 1, cb2 = (w + 1) >> 1;
            f32x16 at;
#pragma unroll
            for (int r = 0; r < 16; ++r) at[r] = 0.f;
            mma_lds<8>(at, L + HG_KIN + (32 * sb + l31) * P128 + hh * 16, L + HG_QIN + (32 * cb2 + l31) * P128 + hh * 16);
            if (sb == cb2) {
#pragma unroll
                for (int r = 0; r < 16; ++r) { const int sl = (r & 3) + 8 * (r >> 2) + 4 * hh; if (sl > l31) at[r] = 0.f; } }
#pragma unroll
            for (int g4 = 0; g4 < 4; ++g4) *(LAS v2u*)(L + HG_ATT + (32 * cb2 + l31) * P64 + (32 * sb + 8 * g4 + 4 * hh) * 2) = (v2u){pk2h(at[4 * g4], at[4 * g4 + 1]), pk2h(at[4 * g4 + 2], at[4 * g4 + 3])};
        }
        __syncthreads();
        if (cb == 0) mma_lds<2, true>(o, L + HG_VTT + (32 * eb + l31) * P64 + hh * 16, L + HG_ATT + l31 * P64 + hh * 16);
        else         mma_lds<4, true>(o, L + HG_VTT + (32 * eb + l31) * P64 + hh * 16, L + HG_ATT + (32 + l31) * P64 + hh * 16);
#pragma unroll
        for (int i2 = 0; i2 < 2; ++i2) {
            const int dkb = 2 * cb + i2;
            f32x16& S = i2 == 0 ? S0 : S1;
#pragma unroll
            for (int g4 = 0; g4 < 4; ++g4) { const f32x4 d4 = *(const LAS f32x4*)(DEC + 32 * dkb + 8 * g4 + 4 * hh);
#pragma unroll
                for (int j = 0; j < 4; ++j) S[4 * g4 + j] *= d4[j]; }
            mma_lds<4, true>(S, L + HG_KOT + (32 * dkb + l31) * P64 + hh * 16, L + HG_VTT + (32 * eb + l31) * P64 + hh * 16);
#pragma unroll
            for (int g4 = 0; g4 < 4; ++g4) *(LAS v2u*)(L + HG_STT + (32 * eb + l31) * P128 + (32 * dkb + 8 * g4 + 4 * hh) * 2) = (v2u){pk2(S[4 * g4], S[4 * g4 + 1]), pk2(S[4 * g4 + 2], S[4 * g4 + 3])};
        }
        {   float ss = 0.f;
#pragma unroll
            for (int r = 0; r < 16; ++r) ss += o[r] * o[r];
            ss += __shfl_xor(ss, 32);
            if (hh == 0) SSQ[eb * 64 + 32 * cb + l31] = ss;
#pragma unroll
            for (int g4 = 0; g4 < 4; ++g4) *(LAS v2u*)(L + HG_OST + (32 * cb + l31) * P128 + (32 * eb + 8 * g4 + 4 * hh) * 2) = (v2u){pk2h(o[4 * g4], o[4 * g4 + 1]), pk2h(o[4 * g4 + 2], o[4 * g4 + 3])}; }
        __syncthreads();
        {   const int c = vs;
            const float rn = 1.0f / sqrtf(((SSQ[c] + SSQ[64 + c]) + (SSQ[128 + c] + SSQ[192 + c])) * (1.0f / 128.0f) + EPS);
            const v4u o0 = *(const LAS v4u*)(L + HG_OST + c * P128 + vec * 2), o1 = *(const LAS v4u*)(L + HG_OST + c * P128 + vec * 2 + 16);
            const unsigned ow[8] = {o0.x, o0.y, o0.z, o0.w, o1.x, o1.y, o1.z, o1.w}, gw[8] = {g0.x, g0.y, g0.z, g0.w, g1.x, g1.y, g1.z, g1.w};
            {   const int n2c = n + 2 < 32 ? n + 2 : 31; g0 = *(const GAS v4u*)(gbase + (size_t)n2c * 64 * PW); g1 = *(const GAS v4u*)(gbase + (size_t)n2c * 64 * PW + 8); }
            unsigned res[8];
#pragma unroll
            for (int j = 0; j < 8; ++j) res[j] = pk2h(hlo(ow[j]) * rn * onorm[2 * j] * hlo(gw[j]), hhi(ow[j]) * rn * onorm[2 * j + 1] * hhi(gw[j]));
            *(GAS v4u*)(MIX + (m0 + c) * DM + h * 128 + vec) = (v4u){res[0], res[1], res[2], res[3]};
            *(GAS v4u*)(MIX + (m0 + c) * DM + h * 128 + vec + 8) = (v4u){res[4], res[5], res[6], res[7]};
        }
    };
#pragma unroll 1
    for (int n2 = 0; n2 < 32; n2 += 2) { chunk(n2, ra0, ra1, ra2, ra3, ra4, ra5, ga0, ga1); chunk(n2 + 1, rb0, rb1, rb2, rb3, rb4, rb5, gb0, gb1); }
    __syncthreads();
}

__device__ __forceinline__ void reduce16x2(float (&a)[16], int lane) {
#pragma unroll
    for (int i = 0; i < 8; ++i) { const bool up = (lane & 32) != 0; const float send = up ? a[i] : a[i + 8]; const float keep = up ? a[i + 8] : a[i]; a[i] = keep + __shfl_xor(send, 32); }
#pragma unroll
    for (int i = 0; i < 4; ++i) { const bool up = (lane & 16) != 0; const float send = up ? a[i] : a[i + 4]; const float keep = up ? a[i + 4] : a[i]; a[i] = keep + __shfl_xor(send, 16); }
#pragma unroll
    for (int i = 0; i < 2; ++i) { const bool up = (lane & 8) != 0; const float send = up ? a[i] : a[i + 2]; const float keep = up ? a[i + 2] : a[i]; a[i] = keep + __shfl_xor(send, 8); }
    { const bool up = (lane & 4) != 0; const float send = up ? a[0] : a[1]; const float keep = up ? a[1] : a[0]; a[0] = keep + __shfl_xor(send, 4); }
    a[0] += __shfl_xor(a[0], 2); a[0] += __shfl_xor(a[0], 1);
}
constexpr int CV_CT = 0, CV_PART = 98304;
__device__ __forceinline__ void conv_tiles(Frame& F, int first, int stride) {
    if (first >= 512) return;
    LAS unsigned char* L = F.lds;
    int tid_ = F.tid; asm volatile("" : "+v"(tid_));
    const int tid = tid_, lane = tid & 63, w = __builtin_amdgcn_readfirstlane(tid >> 6);
    const GAS bf16* P = WSPG(bf16, WS_BIG); GAS unsigned* MIX32 = WSPG(unsigned, WS_MIX);
    const int cp = tid & 255, th = tid >> 8;
    float w0[31], w1[31];
#pragma unroll
    for (int k = 0; k < 31; ++k) { const f32x2_t ww = *(const GAS f32x2_t*)(INP(11) + k * 512 + 2 * cp); w0[k] = ww.x; w1[k] = ww.y; }
    const f32x2_t bias = *(const GAS f32x2_t*)(INP(12) + 2 * cp), lng = *(const GAS f32x2_t*)(INP(13) + 2 * cp), lnb = *(const GAS f32x2_t*)(INP(14) + 2 * cp);
    LAS float* PART = (LAS float*)(L + CV_PART);
    const LAS unsigned* CT32 = (const LAS unsigned*)(L + CV_CT);
    v4u rows[12];
    auto load_rows = [&](int tile) { const int b = tile >> 5, t0 = (tile & 31) * 64;
#pragma unroll
        for (int i = 0; i < 12; ++i) { const int idx = tid + 512 * i, j = idx >> 6, c16 = idx & 63, t = t0 - 30 + j;
            rows[i] = (v4u){0u, 0u, 0u, 0u}; if (idx < 94 * 64 && t >= 0) rows[i] = *(const GAS v4u*)(P + ((size_t)b * SEQ + t) * PW + 2048 + c16 * 8); } };
    auto store_rows = [&]() {
#pragma unroll
        for (int i = 0; i < 12; ++i) { const int idx = tid + 512 * i; if (idx < 94 * 64) *(LAS v4u*)(L + CV_CT + (idx >> 6) * 1024 + (idx & 63) * 16) = rows[i]; } };
    load_rows(first);
#pragma unroll 1
    for (int tile = first; tile < 512; tile += stride) {
        const int b = tile >> 5, t0 = (tile & 31) * 64; const size_t m0 = (size_t)b * SEQ + t0;
        store_rows();
        __syncthreads();
        if (tile + stride < 512) load_rows(tile + stride);
#pragma unroll 1
        for (int grp = 0; grp < 4; ++grp) {
            const int tok0 = 32 * th + 8 * grp;
            float a0[8], a1[8];
#pragma unroll
            for (int i = 0; i < 8; ++i) { a0[i] = bias.x; a1[i] = bias.y; }
#pragma unroll
            for (int jj = 0; jj < 38; ++jj) { const unsigned v = CT32[(tok0 + jj) * 256 + cp]; const float x0 = hlo(v), x1 = hhi(v);
#pragma unroll
                for (int i = 0; i < 8; ++i) { const int k = jj - i; if (k >= 0 && k <= 30) { a0[i] += w0[k] * x0; a1[i] += w1[k] * x1; } } }
            float st[16];
#pragma unroll
            for (int i = 0; i < 8; ++i) { st[i] = a0[i] + a1[i]; st[8 + i] = a0[i] * a0[i] + a1[i] * a1[i]; }
            reduce16x2(st, lane);
            if ((lane & 3) == 0) PART[((grp & 1) * 8 + w) * 16 + (8 * ((lane >> 5) & 1) + 4 * ((lane >> 4) & 1) + 2 * ((lane >> 3) & 1) + ((lane >> 2) & 1))] = st[0];
            __syncthreads();
#pragma unroll
            for (int i = 0; i < 8; ++i) {
                float s = 0.f, q = 0.f;
#pragma unroll
                for (int ww = 0; ww < 4; ++ww) { s += PART[((grp & 1) * 8 + 4 * th + ww) * 16 + i]; q += PART[((grp & 1) * 8 + 4 * th + ww) * 16 + 8 + i]; }
                const float mu = s * (1.0f / 512.0f), var = q * (1.0f / 512.0f) - mu * mu, rstd = 1.0f / sqrtf(fmaxf(var, 0.f) + EPS);
                float y0 = (a0[i] - mu) * rstd * lng.x + lnb.x, y1 = (a1[i] - mu) * rstd * lng.y + lnb.y;
                y0 *= sigm(y0); y1 *= sigm(y1);
                MIX32[(m0 + tok0 + i) * 512 + 256 + cp] = pk2h(y0, y1);
            }
        }
        __syncthreads();
    }
}

constexpr int MB_KP = 144, MB_VP = 520, MB_VOFF = 256 * MB_KP, MB_BUF = MB_VOFF + 64 * MB_VP, MB_KM = 2 * MB_BUF;
__device__ __forceinline__ void moba_unit(Frame& F, int b, int hd, int jq) {
    LAS unsigned char* L = F.lds;
    int tid_ = F.tid; asm volatile("" : "+v"(tid_));
    const int tid = tid_, lane = tid & 63, w = __builtin_amdgcn_readfirstlane(tid >> 6), l31 = lane & 31, hh = lane >> 5;
    const GAS bf16* P = WSPG(bf16, WS_BIG); GAS bf16* MIX = WSPG(bf16, WS_MIX); const GAS float* kpart = WSPG(float, WS_KPART);
    const size_t m0 = (size_t)b * SEQ + jq * 256;
    const size_t qrow = m0 + 32 * w + l31;
    bf16x8 qf[4];
#pragma unroll
    for (int ks = 0; ks < 4; ++ks) qf[ks] = *(const GAS bf16x8*)(P + qrow * PW + hd * 64 + 16 * ks + 8 * hh);
    LAS float* KM = (LAS float*)(L + MB_KM);
    if (tid < jq * 64) { const int n = tid >> 6, d = tid & 63, pm = b * 8 + n, col = hd * 64 + d;
        KM[n * 64 + d] = (kpart[(size_t)(pm * 2) * 512 + col] + kpart[(size_t)(pm * 2 + 1) * 512 + col]) * (1.0f / 256.0f); }
    const int skey = tid >> 3, sch = tid & 7, vkey = tid & 255, vch = tid >> 8;
    v4u kreg[4], vreg[4];
    auto stage_load = [&](int blk) { const size_t mk = (size_t)b * SEQ + blk * 256;
#pragma unroll
        for (int j = 0; j < 4; ++j) { kreg[j] = *(const GAS v4u*)(P + (mk + skey + 64 * j) * PW + 512 + hd * 64 + 8 * sch); vreg[j] = *(const GAS v4u*)(P + (mk + vkey) * PW + 1024 + hd * 64 + 8 * (vch + 2 * j)); } };
    auto stage_write = [&](int buf) {
#pragma unroll
        for (int j = 0; j < 4; ++j) { *(LAS v4u*)(L + buf * MB_BUF + (skey + 64 * j) * MB_KP + sch * 16) = kreg[j];
            const unsigned vw[4] = {vreg[j].x, vreg[j].y, vreg[j].z, vreg[j].w}; LAS unsigned char* vp = L + buf * MB_BUF + MB_VOFF + 8 * (vch + 2 * j) * MB_VP + vkey * 2;
#pragma unroll
            for (int e = 0; e < 4; ++e) { *(LAS bf16*)(vp + (2 * e) * MB_VP) = (bf16)(vw[e] & 0xffffu); *(LAS bf16*)(vp + (2 * e + 1) * MB_VP) = (bf16)(vw[e] >> 16); } } };
    stage_load(jq); stage_write(0);
    __syncthreads();
    unsigned sel = 0u;
    if (jq <= 3) sel = (1u << jq) - 1u;
    else {
        float sc[7];
#pragma unroll
        for (int n = 0; n < 7; ++n) { float p = 0.f;
            if (n < jq) {
#pragma unroll
                for (int ks = 0; ks < 4; ++ks)
#pragma unroll
                    for (int j = 0; j < 8; ++j) p += h2f((unsigned short)qf[ks][j]) * KM[n * 64 + 16 * ks + 8 * hh + j];
                p += __shfl_xor(p, 32); } else p = -INFINITY;
            sc[n] = p; }
#pragma unroll
        for (int n = 0; n < 7; ++n) { int rank = 0;
#pragma unroll
            for (int n2 = 0; n2 < 7; ++n2) if (n2 != n) rank += (sc[n2] > sc[n] || (sc[n2] == sc[n] && n2 < n)) ? 1 : 0;
            if (n < jq && rank < 3) sel |= 1u << n; }
    }
    float negm = 0.f, lrun = 0.f; bool first = true; f32x16 O0, O1;
#pragma unroll
    for (int r = 0; r < 16; ++r) { O0[r] = 0.f; O1[r] = 0.f; }
#pragma unroll 1
    for (int bi = 0; bi <= jq; ++bi) {
        const int buf = bi & 1;
        if (bi < jq) stage_load(bi);
        const bool own = bi == 0; const int blk = own ? jq : bi - 1;
        const bool mysel = own ? true : (((sel >> blk) & 1u) != 0u);
        const bool anysel = own ? true : (__ballot(mysel) != 0ull);
        const int nkt = own ? ((w >> 1) + 1) : (anysel ? 4 : 0);
#pragma unroll 1
        for (int kt = 0; kt < nkt; ++kt) {
            f32x16 p0, p1;
#pragma unroll
            for (int r = 0; r < 16; ++r) { p0[r] = negm; p1[r] = negm; }
            {   const LAS unsigned char* kb = L + buf * MB_BUF + (64 * kt + l31) * MB_KP + hh * 16;
                bf16x8 kfa[4], kfb[4];
#pragma unroll
                for (int ks = 0; ks < 4; ++ks) { kfa[ks] = ldsfrag(kb + ks * 32); kfb[ks] = ldsfrag(kb + 32 * MB_KP + ks * 32); }
#pragma unroll
                for (int ks = 0; ks < 4; ++ks) { p0 = MFMA32H(kfa[ks], qf[ks], p0); p1 = MFMA32H(kfb[ks], qf[ks], p1); } }
            bf16x8 vf[8];
            {   const LAS unsigned char* vb = L + buf * MB_BUF + MB_VOFF + l31 * MB_VP + hh * 8 + 128 * kt;
#pragma unroll
                for (int sub = 0; sub < 2; ++sub)
#pragma unroll
                    for (int s2 = 0; s2 < 2; ++s2) { const int ko = (32 * sub + 16 * s2) * 2;
                        vf[(sub * 2 + s2) * 2] = ldsfrag2(vb + ko, vb + ko + 16); vf[(sub * 2 + s2) * 2 + 1] = ldsfrag2(vb + 32 * MB_VP + ko, vb + 32 * MB_VP + ko + 16); } }
            if (own) { const int qrel = 32 * w + l31, kb0 = 64 * kt + 4 * hh;
                if (64 * kt + 63 > 32 * w) {
#pragma unroll
                    for (int r = 0; r < 16; ++r) { const int kv = kb0 + (r & 3) + 8 * (r >> 2); if (kv > qrel) p0[r] = NEGBIG; if (kv + 32 > qrel) p1[r] = NEGBIG; } }
            } else if (!mysel) {
#pragma unroll
                for (int r = 0; r < 16; ++r) { p0[r] = NEGBIG; p1[r] = NEGBIG; } }
            float mxa = fmaxf(p0[0], p1[0]), mxb = fmaxf(p0[1], p1[1]), mxc = fmaxf(p0[2], p1[2]), mxd = fmaxf(p0[3], p1[3]);
#pragma unroll
            for (int r = 4; r < 16; r += 4) { mxa = fmaxf(mxa, fmaxf(p0[r], p1[r])); mxb = fmaxf(mxb, fmaxf(p0[r + 1], p1[r + 1])); mxc = fmaxf(mxc, fmaxf(p0[r + 2], p1[r + 2])); mxd = fmaxf(mxd, fmaxf(p0[r + 3], p1[r + 3])); }
            float mx = fmaxf(fmaxf(mxa, mxb), fmaxf(mxc, mxd));
            mx = fmaxf(mx, __shfl_xor(mx, 32));
            if (first || !__all(mx <= 8.0f)) {
                const float delta = first ? mx : fmaxf(mx, 0.f);
                negm -= delta;
#pragma unroll
                for (int r = 0; r < 16; ++r) { p0[r] -= delta; p1[r] -= delta; }
                if (!first) { const float alpha = fexp2(-delta); lrun *= alpha;
#pragma unroll
                    for (int r = 0; r < 16; ++r) { O0[r] *= alpha; O1[r] *= alpha; } }
                first = false;
            }
            float rsa = 0.f, rsb = 0.f, rsc = 0.f, rsd = 0.f;
#pragma unroll
            for (int r = 0; r < 16; r += 4) { p0[r] = fexp2(p0[r]); p1[r] = fexp2(p1[r]); p0[r + 1] = fexp2(p0[r + 1]); p1[r + 1] = fexp2(p1[r + 1]); p0[r + 2] = fexp2(p0[r + 2]); p1[r + 2] = fexp2(p1[r + 2]); p0[r + 3] = fexp2(p0[r + 3]); p1[r + 3] = fexp2(p1[r + 3]);
                rsa += p0[r] + p1[r]; rsb += p0[r + 1] + p1[r + 1]; rsc += p0[r + 2] + p1[r + 2]; rsd += p0[r + 3] + p1[r + 3]; }
            float rs = (rsa + rsb) + (rsc + rsd);
            rs += __shfl_xor(rs, 32);
            lrun += rs;
#pragma unroll
            for (int sub = 0; sub < 2; ++sub)
#pragma unroll
                for (int s2 = 0; s2 < 2; ++s2) { const bf16x8 pb = packfrag(sub == 0 ? p0 : p1, s2);
                    O0 = MFMA32H(vf[(sub * 2 + s2) * 2], pb, O0);
                    O1 = MFMA32H(vf[(sub * 2 + s2) * 2 + 1], pb, O1); }
        }
        if (bi < jq) stage_write(buf ^ 1);
        __syncthreads();
    }
    {   const float inv = 1.0f / lrun;
        GAS bf16* op = MIX + qrow * DM + hd * 64 + 4 * hh;
#pragma unroll
        for (int g4 = 0; g4 < 4; ++g4) {
            *(GAS v2u*)(op + 8 * g4) = (v2u){pk2h(O0[4 * g4] * inv, O0[4 * g4 + 1] * inv), pk2h(O0[4 * g4 + 2] * inv, O0[4 * g4 + 3] * inv)};
            *(GAS v2u*)(op + 32 + 8 * g4) = (v2u){pk2h(O1[4 * g4] * inv, O1[4 * g4 + 1] * inv), pk2h(O1[4 * g4 + 2] * inv, O1[4 * g4 + 3] * inv)}; }
    }
}

constexpr int SG_ZT = 0, SG_STAT = 34816, SG_OT = 40960;
__device__ __forceinline__ void sgu_unit(Frame& F, int ucur, int unext, const v4u (&zr)[4], const v4u (&ur)[4], v4u (&nz)[4], v4u (&nu)[4]) {
    const int b = ucur >> 6, nc = (ucur >> 2) & 15, g = ucur & 3;
    LAS unsigned char* L = F.lds;
    int tid_ = F.tid; asm volatile("" : "+v"(tid_));
    const int tid = tid_, lane = tid & 63, w = __builtin_amdgcn_readfirstlane(tid >> 6), l31 = lane & 31, hh = lane >> 5;
    const GAS bf16* P = WSPG(bf16, WS_BIG); GAS bf16* MIX = WSPG(bf16, WS_MIX); const GAS bf16* Wb = WSPG(bf16, WS_SGUW) + g * 128 * 128;
    const size_t m0 = (size_t)b * SEQ + nc * 128;
    const int s = tid & 127, qt = tid >> 7, c0 = 32 * qt;
    const int tb0 = w >> 2;
    bf16x8 wf0[4], wf1[8];
#pragma unroll
    for (int ks = 0; ks < 4; ++ks) if (ks < 2 * (tb0 + 1)) wf0[ks] = *(const GAS bf16x8*)(Wb + (32 * tb0 + l31) * 128 + 8 * hh + 16 * ks);
#pragma unroll
    for (int ks = 0; ks < 8; ++ks) if (ks < 2 * (4 - tb0)) wf1[ks] = *(const GAS bf16x8*)(Wb + (32 * (3 - tb0) + l31) * 128 + 8 * hh + 16 * ks);
    if (unext >= 0) {
        const int b2 = unext >> 6, nc2 = (unext >> 2) & 15, g2 = unext & 3; const size_t m2 = (size_t)b2 * SEQ + nc2 * 128;
        const GAS bf16* zp = P + (m2 + s) * PW + 2048 + g2 * 128 + c0; const GAS bf16* up = P + (m2 + (tid >> 2)) * PW + 1536 + g2 * 128 + (tid & 3) * 32;
#pragma unroll
        for (int j4 = 0; j4 < 4; ++j4) { nz[j4] = *(const GAS v4u*)(zp + 8 * j4); nu[j4] = *(const GAS v4u*)(up + 8 * j4); } }
    float z[32];
#pragma unroll
    for (int j4 = 0; j4 < 4; ++j4) { const unsigned vw[4] = {zr[j4].x, zr[j4].y, zr[j4].z, zr[j4].w};
#pragma unroll
        for (int j = 0; j < 4; ++j) { z[8 * j4 + 2 * j] = hlo(vw[j]); z[8 * j4 + 2 * j + 1] = hhi(vw[j]); } }
    float sm = 0.f, sq = 0.f;
#pragma unroll
    for (int j = 0; j < 32; ++j) { sm += z[j]; sq += z[j] * z[j]; }
    LAS float* ST = (LAS float*)(L + SG_STAT);
    ST[(qt * 128 + s) * 2] = sm; ST[(qt * 128 + s) * 2 + 1] = sq;
    __syncthreads();
    {   float a = 0.f, q = 0.f;
#pragma unroll
        for (int k = 0; k < 4; ++k) { a += ST[(k * 128 + s) * 2]; q += ST[(k * 128 + s) * 2 + 1]; }
        const float mu = a * (1.0f / 128.0f), var = q * (1.0f / 128.0f) - mu * mu, rstd = 1.0f / sqrtf(fmaxf(var, 0.f) + EPS);
        const GAS float* lg = INP(17) + g * 128 + c0; const GAS float* lbp = INP(18) + g * 128 + c0;
#pragma unroll
        for (int j = 0; j < 32; ++j) *(LAS bf16*)(L + SG_ZT + (c0 + j) * P128 + s * 2) = (bf16)(pk2h((z[j] - mu) * rstd * lg[j] + lbp[j], 0.f) & 0xffffu);
    }
    __syncthreads();
    const int cb = w & 3;
#pragma unroll
    for (int it = 0; it < 2; ++it) {
        const int tb = it == 0 ? tb0 : 3 - tb0;
        f32x16 acc;
#pragma unroll
        for (int r = 0; r < 16; ++r) acc[r] = 0.f;
        const LAS unsigned char* zb = L + SG_ZT + (32 * cb + l31) * P128 + hh * 16;
        const int nks = 2 * (tb + 1);
#pragma unroll
        for (int ks = 0; ks < (it == 0 ? 4 : 8); ++ks) if (ks < nks) acc = MFMA32H(ldsfrag(zb + ks * 32), it == 0 ? wf0[ks] : wf1[ks], acc);
        const float bias = INP(20)[g * 128 + 32 * tb + l31];
#pragma unroll
        for (int g4 = 0; g4 < 4; ++g4) *(LAS v2u*)(L + SG_OT + (32 * tb + l31) * P128 + (32 * cb + 8 * g4 + 4 * hh) * 2) = (v2u){pk2h(acc[4 * g4] + bias, acc[4 * g4 + 1] + bias), pk2h(acc[4 * g4 + 2] + bias, acc[4 * g4 + 3] + bias)};
    }
    __syncthreads();
    {   const int t = tid >> 2, cc = (tid & 3) * 32;
        GAS bf16* op = MIX + (m0 + t) * DM + 512 + g * 128 + cc;
#pragma unroll
        for (int j4 = 0; j4 < 4; ++j4) { const v4u u = ur[j4], mx = *(const LAS v4u*)(L + SG_OT + t * P128 + (cc + 8 * j4) * 2);
            *(GAS v4u*)(op + 8 * j4) = (v4u){pk2h(hlo(u.x) * hlo(mx.x), hhi(u.x) * hhi(mx.x)), pk2h(hlo(u.y) * hlo(mx.y), hhi(u.y) * hhi(mx.y)), pk2h(hlo(u.z) * hlo(mx.z), hhi(u.z) * hhi(mx.z)), pk2h(hlo(u.w) * hlo(mx.w), hhi(u.w) * hhi(mx.w))}; }
    }
    __syncthreads();
}

__device__ __forceinline__ void sgu_units(Frame& F, int first, int stride) {
    if (first >= 1024) return;
    const int tid = F.tid, s = tid & 127, c0 = 32 * (tid >> 7);
    const GAS bf16* P = WSPG(bf16, WS_BIG);
    v4u za[4], ua[4], zb[4], ub[4];
    {   const int b = first >> 6, nc = (first >> 2) & 15, g = first & 3; const size_t m0 = (size_t)b * SEQ + nc * 128;
        const GAS bf16* zp = P + (m0 + s) * PW + 2048 + g * 128 + c0; const GAS bf16* up = P + (m0 + (tid >> 2)) * PW + 1536 + g * 128 + (tid & 3) * 32;
#pragma unroll
        for (int j4 = 0; j4 < 4; ++j4) { za[j4] = *(const GAS v4u*)(zp + 8 * j4); ua[j4] = *(const GAS v4u*)(up + 8 * j4); } }
#pragma unroll 1
    for (int u = first; u < 1024; u += 2 * stride) {
        const int u1 = u + stride, u2 = u + 2 * stride;
        sgu_unit(F, u, u1 < 1024 ? u1 : -1, za, ua, zb, ub);
        if (u1 < 1024) sgu_unit(F, u1, u2 < 1024 ? u2 : -1, zb, ub, za, ua);
    }
}

__device__ __forceinline__ void final_norm(Frame& F) {
    const int gw = F.bid * NWAVES + F.wave, NGW = F.G * NWAVES, lane = F.lane;
    const GAS float* ssq = WSPG(float, WS_SSQ); const GAS float* gn = INP(6);
    f32x4 gv[4];
#pragma unroll
    for (int j = 0; j < 4; ++j) gv[j] = *(const GAS f32x4*)(gn + 4 * lane + 256 * j);
    for (int m = gw; m < MROWS; m += NGW) {
        const float s = ssq[m];
        const float r = 1.0f / sqrtf(s * (1.0f / DM) + EPS);
        const GAS v2u* xr = (const GAS v2u*)(WSPG(bf16, WS_XB) + (size_t)m * DM) + lane; GAS f32x4* orow = (GAS f32x4*)(F.out + (size_t)m * DM) + lane;
#pragma unroll
        for (int j = 0; j < 4; ++j) { const v2u w = __builtin_nontemporal_load(xr + 64 * j); f32x4 v = (f32x4){hlo(w.x), hhi(w.x), hlo(w.y), hhi(w.y)}; v = v * r * gv[j]; __builtin_nontemporal_store(v, orow + 64 * j); }
    }
}


#ifdef DIS_HGRN
#define HGRN_CALL(...)
#else
#define HGRN_CALL hgrn_unit
#endif
#ifdef DIS_CONV
#define CONV_CALL(...)
#else
#define CONV_CALL conv_tiles
#endif
#ifdef DIS_MOBA
#define MOBA_CALL(...)
#else
#define MOBA_CALL moba_unit
#endif
#ifdef DIS_SGU
#define SGU_CALL(...)
#else
#define SGU_CALL sgu_units
#endif
#ifndef REP_HGRN
#define REP_HGRN 1
#endif
#ifndef REP_CONV
#define REP_CONV 1
#endif
#ifndef REP_MOBA
#define REP_MOBA 1
#endif
#ifndef REP_SGU
#define REP_SGU 1
#endif
#ifndef REP_FFN
#define REP_FFN 1
#endif
#ifndef REP_P0
#define REP_P0 1
#endif
#ifndef GSEL
#define GSEL 0
#endif
#ifdef DIS_GEMM
template <class Epi, class Sched, bool A, bool B> __device__ __forceinline__ void gemm_dummy(LAS unsigned char*, const pg8::Gemm, const Sched&, const Epi&) {}
#define GEMM_CALL gemm_dummy
#else
#define GEMM_CALL pg8::gemm_phase
#endif
__device__ __forceinline__ void sub_barrier(Frame& F, unsigned* cnt, unsigned n) {
    asm volatile("s_waitcnt vmcnt(0)" ::: "memory"); __syncthreads();
    if (F.tid == 0) {
        __threadfence();
        asm volatile("s_waitcnt vmcnt(0)" ::: "memory");
        (void)__hip_atomic_fetch_add(cnt, 1u, __ATOMIC_RELAXED, __HIP_MEMORY_SCOPE_AGENT);
        unsigned sp = 0;
        while (__hip_atomic_load(cnt, __ATOMIC_RELAXED, __HIP_MEMORY_SCOPE_AGENT) < n) { __builtin_amdgcn_s_sleep(2); if (++sp > (1u << 22)) break; }
        __threadfence();
        asm volatile("s_waitcnt vmcnt(0)" ::: "memory");
    }
    __syncthreads();
}
template <int l> __device__ __forceinline__ void layer_phases(Frame& F, const int lo, const int hi, const XcdBarrier& bar, const int vcu) {
#define IN(k) (lo <= (k) && (k) < hi)
#define SEAM(k) do { if (IN(k) && IN((k) + 1)) xcd_barrier(bar); } while (0)
#define PH_ENTER() asm volatile("" : "+s"(F.ws), "+s"(F.out))
#define XB WSP(bf16, WS_XB)
#define BIG WSP(bf16, WS_BIG)
#define MIX WSP(bf16, WS_MIX)
#define QO WSP(bf16, WS_QO)
#define SSQ WSP(float, WS_SSQ)

        constexpr int pb = l == 0 ? 2 : 9;
        if (l == 1) {
            if (IN(8)) { PH_ENTER();
                pg8::Gemm g{XB, WSP(bf16, WS_WIN1), DM, DM, DM}; pg8::StaticOrder S; S.init(MROWS, PW, F.G, F.bid, DM, DM);
                pg8::EpiIn1 E{BIG, SSQ + MROWS, WSP(float, WS_KPART), C2M};
                GEMM_CALL<pg8::EpiIn1, pg8::StaticOrder, true, true>(F.lds, g, S, E);
            } SEAM(8);
        }
        if (IN(pb)) { PH_ENTER();
            if (l == 0) {
                const int nh = F.G > 64 ? 64 : F.G;
                for (int rep = 0; rep < REP_HGRN; ++rep)
                if (F.bid < nh) { for (int u = F.bid; u < 64; u += nh) HGRN_CALL(F, u >> 2, u & 3); }
                for (int rep = 0; rep < REP_CONV; ++rep)
                {   const bool split = F.G > 64; const int g2 = split ? F.G - 64 : F.G, c2 = split ? F.bid - 64 : F.bid;
                    if (c2 >= 0) {
                        CONV_CALL(F, c2, g2);
#pragma unroll 1
                        for (int q = 0; q < 4; ++q) {
                            pg8::Gemm g{WSP(bf16, WS_MEMB), WSP(bf16, (q & 1) ? WS_WV : WS_WK) + (size_t)(q >> 1) * DM * DM, DM, DM, DM}; pg8::StaticOrder S; S.init(MMEM, DM, g2, (c2 + 4 * g2 - 64 * q) % g2, DM, DM);
                            pg8::EpiK E{WSP(bf16, (q & 1) ? WS_VT : WS_KB) + (size_t)(q >> 1) * MMEM * DM, WSP(float, WS_RMEM)};
                            GEMM_CALL<pg8::EpiK, pg8::StaticOrder, true, true>(F.lds, g, S, E); }
                        convert_rest(F, c2 * NWAVES + F.wave, g2 * NWAVES);
                        sub_barrier(F, (unsigned*)(F.ws + WS_CTL) + 900, (unsigned)g2);
                        {   int k256 = 256; asm volatile("" : "+s"(k256));
                            {   pg8::Gemm g{WSP(bf16, WS_KB), WSP(bf16, WS_WQ), k256, DM, DM}; pg8::SubOrder S{g2, (c2 + 64) % g2, 0};
                                pg8::EpiSub E{QO, 0};
                                GEMM_CALL<pg8::EpiSub, pg8::SubOrder, true, true>(F.lds, g, S, E); }
                            {   pg8::Gemm g{WSP(bf16, WS_WO), WSP(bf16, WS_VT), k256, DM, DM}; pg8::SubOrder S{g2, (c2 + 128) % g2, 1};
                                pg8::EpiSub E{QO + (size_t)16 * DM * DM, 1};
                                GEMM_CALL<pg8::EpiSub, pg8::SubOrder, true, true>(F.lds, g, S, E); } }
                    } }
            } else {
                for (int rep = 0; rep < REP_MOBA; ++rep)
                for (int p = vcu; p < 512; p += F.G) { const int b = p >> 5, hd = (p >> 2) & 7, pj = p & 3; MOBA_CALL(F, b, hd, 7 - pj); MOBA_CALL(F, b, hd, pj); }
                for (int rep = 0; rep < REP_SGU; ++rep)
                SGU_CALL(F, vcu, F.G);
            }
        } SEAM(pb);
        if (IN(pb + 1)) { PH_ENTER();
            if (l == 1) {
            int k256 = 256; asm volatile("" : "+s"(k256));
            {   pg8::Gemm g{WSP(bf16, WS_KB) + (size_t)l * MMEM * DM, WSP(bf16, WS_WQ) + (size_t)l * DM * DM, k256, DM, DM}; pg8::SubOrder S{F.G, F.bid, 0};
                pg8::EpiSub E{BIG, 0};
#ifndef DIS_SUB
                GEMM_CALL<pg8::EpiSub, pg8::SubOrder, true, true>(F.lds, g, S, E);
#endif
 }
            {   pg8::Gemm g{WSP(bf16, WS_WO) + (size_t)l * DM * DM, WSP(bf16, WS_VT) + (size_t)l * MMEM * DM, k256, DM, DM}; pg8::SubOrder S{F.G, F.bid, 1};
                pg8::EpiSub E{BIG + (size_t)16 * DM * DM, 1};
#ifndef DIS_SUB
                GEMM_CALL<pg8::EpiSub, pg8::SubOrder, true, true>(F.lds, g, S, E);
#endif
 }
            }
            pg8::Gemm g{MIX, WSP(bf16, l == 0 ? WS_WOUT0 : WS_WOUT1), DM, DM, DM}; pg8::StaticOrder S; S.init(MROWS, DM, F.G, F.bid, DM, DM);
            constexpr int j = 1 + 3 * l;
            for (int i = F.bid * (NWAVES * 64) + F.tid; i < MROWS; i += F.G * NWAVES * 64) (SSQ + ((j + 1) & 1) * MROWS)[i] = 0.f;
            pg8::EpiRes E{XB, nullptr, SSQ + (j & 1) * MROWS};
            GEMM_CALL<pg8::EpiRes, pg8::StaticOrder, true, true>(F.lds, g, S, E);
        } SEAM(pb + 1);
        if (IN(pb + 2)) { PH_ENTER();
            pg8::Gemm g{XB, l == 0 ? QO : BIG, DM, DM, DM}; pg8::StaticOrder S; S.init(MROWS, DM, F.G, F.bid, DM, DM, DM);
            pg8::EpiSoftmax E{MIX, SSQ + ((1 + 3 * l) & 1) * MROWS, (LAS float*)(F.lds + RING_BYTES)};
#ifndef DIS_SM
            GEMM_CALL<pg8::EpiSoftmax, pg8::StaticOrder, true, true>(F.lds, g, S, E);
#endif
        } SEAM(pb + 2);
        if (IN(pb + 3)) { PH_ENTER();
            pg8::Gemm g{MIX, (l == 0 ? QO : BIG) + (size_t)16 * DM * DM, DM, DM, DM}; pg8::StaticOrder S; S.init(MROWS, DM, F.G, F.bid, DM, DM, DM);
            constexpr int j = 2 + 3 * l;
            for (int i = F.bid * (NWAVES * 64) + F.tid; i < MROWS; i += F.G * NWAVES * 64) (SSQ + ((j + 1) & 1) * MROWS)[i] = 0.f;
            pg8::EpiRes E{XB, nullptr, SSQ + (j & 1) * MROWS};
            GEMM_CALL<pg8::EpiRes, pg8::StaticOrder, true, true>(F.lds, g, S, E);
        } SEAM(pb + 3);
        if (IN(pb + 4)) { PH_ENTER();
            pg8::Gemm g{XB, WSP(bf16, WS_WFI) + (size_t)l * DM * 2 * FFH, DM, DM, DM}; pg8::StaticOrder S; S.init(MROWS, 2 * FFH, F.G, F.bid, DM, DM);
            pg8::EpiFfn E{BIG, SSQ + ((2 + 3 * l) & 1) * MROWS};
            for (int rep = 0; rep < REP_FFN; ++rep)
            GEMM_CALL<pg8::EpiFfn, pg8::StaticOrder, true, true>(F.lds, g, S, E);
        } SEAM(pb + 4);
        if (IN(pb + 5)) { PH_ENTER();
            pg8::Gemm g{BIG, WSP(bf16, WS_WFO) + (size_t)l * FFH * DM, FFH, FFH, FFH}; pg8::StaticOrder S; S.init(MROWS, DM, F.G, F.bid, FFH, FFH);
            constexpr int j = 3 + 3 * l;
            for (int i = F.bid * (NWAVES * 64) + F.tid; i < MROWS; i += F.G * NWAVES * 64) (SSQ + ((j + 1) & 1) * MROWS)[i] = 0.f;
            pg8::EpiRes E{XB, nullptr, SSQ + (j & 1) * MROWS};
            GEMM_CALL<pg8::EpiRes, pg8::StaticOrder, true, true>(F.lds, g, S, E);
        } SEAM(pb + 5);

#undef IN
#undef SEAM
#undef PH_ENTER
#undef XB
#undef BIG
#undef MIX
#undef QO
#undef SSQ
}

__global__ void __launch_bounds__(NWAVES * 64, 2) fwd_kernel(Args args) {
    extern __shared__ __attribute__((aligned(16))) unsigned char lds[];
    Frame F;
    F.lds = (LAS unsigned char*)lds;
    F.tid = threadIdx.x; F.lane = F.tid & 63; F.wave = __builtin_amdgcn_readfirstlane(F.tid >> 6);
    F.G = gridDim.x; F.bid = blockIdx.x;
    F.ka = (const CAS Args*)__builtin_amdgcn_kernarg_segment_ptr();
    F.out = args.out; F.ws = args.ws;
    const int vcu = (F.G % 8 == 0) ? (F.bid % 8) * (F.G / 8) + F.bid / 8 : F.bid;
    volatile LAS unsigned* MISC = (volatile LAS unsigned*)(F.lds + MISC_OFF);
    for (int u = F.tid; u < (LDS_BYTES - LDSCTL_OFF) / 4; u += NWAVES * 64) ((LAS unsigned*)(F.lds + LDSCTL_OFF))[u] = 0u;
    __syncthreads();
    const int lo = args.ph_lo, hi = args.ph_hi;
    unsigned* barw = (unsigned*)(F.ws + WS_CTL) + CW_BAR;
    XcdBarrier bar; bar.bar = barw; bar.x = 0; bar.st = nullptr;
    if (hi - lo > 1) bar = xcd_barrier_post(barw, MISC + 8);
#define IN(k) (lo <= (k) && (k) < hi)
#define PH_ENTER() asm volatile("" : "+s"(F.ws), "+s"(F.out))
#define SEAM(k) do { if (IN(k) && IN((k) + 1)) xcd_barrier(bar); } while (0)
#define XB WSP(bf16, WS_XB)
#define BIG WSP(bf16, WS_BIG)
#define MIX WSP(bf16, WS_MIX)
#define QO WSP(bf16, WS_QO)
#define SSQ WSP(float, WS_SSQ)

    #ifndef DIS_P0
    for (int rep = 0; rep < REP_P0; ++rep)
    if (IN(0)) { PH_ENTER(); p0_prologue(F); }
#endif
    SEAM(0);

    if (IN(1)) { PH_ENTER();
        pg8::Gemm g{XB, WSP(bf16, WS_WIN0), DM, DM, DM}; pg8::StaticOrder S; S.init(MROWS, 3072, F.G, F.bid, DM, DM);
        pg8::EpiIn0 E{BIG, SSQ, WSP(float, WS_LB)};
        GEMM_CALL<pg8::EpiIn0, pg8::StaticOrder, true, true>(F.lds, g, S, E);
    } SEAM(1);

    layer_phases<0>(F, lo, hi, bar, vcu);
    layer_phases<1>(F, lo, hi, bar, vcu);
    #ifndef DIS_FIN
    if (IN(15)) final_norm(F);
#endif
#undef IN
#undef SEAM
#undef XB
#undef BIG
#undef MIX
#undef QO
#undef SSQ
}

extern "C" void kernel_launch(void* const* d_in, const int* in_sizes, int n_in, void* d_out, int out_size, void* d_ws, size_t ws_size, hipStream_t stream) {
    static int grid = 0;
    if (grid == 0) {
        if (n_in != 26 || in_sizes[0] != MROWS * DM || out_size != MROWS * DM || ws_size < WS_END) {
            fprintf(stderr, "kernel_launch: unexpected shapes (n_in %d, in0 %d, out %d, ws %zu); nothing launched\n", n_in, n_in > 0 ? in_sizes[0] : -1, out_size, ws_size); grid = -1; return; }
        int dev = 0, cus = 0;
        if (hipGetDevice(&dev) != hipSuccess || hipDeviceGetAttribute(&cus, hipDeviceAttributeMultiprocessorCount, dev) != hipSuccess) { fprintf(stderr, "kernel_launch: device query failed\n"); grid = -1; return; }
        if (hipFuncSetAttribute((const void*)fwd_kernel, hipFuncAttributeMaxDynamicSharedMemorySize, LDS_BYTES) != hipSuccess) { fprintf(stderr, "kernel_launch: hipFuncSetAttribute failed\n"); grid = -1; return; }
        (void)hipGetLastError();
        grid = cus > 256 ? 256 : cus;
    }
    if (grid < 0) return;
    (void)hipMemsetAsync((char*)d_ws + WS_CTL, 0, CTL_ZERO_BYTES, stream);
    Args a{};
    for (int i = 0; i < 26; ++i) a.in[i] = (const float*)d_in[i];
    a.out = (float*)d_out; a.ws = (unsigned char*)d_ws;
#if MK_ONE_LAUNCH
    a.ph_lo = 0; a.ph_hi = NPH;
    hipLaunchKernelGGL(fwd_kernel, dim3(grid), dim3(NWAVES * 64), LDS_BYTES, stream, a);
#else
    for (int p = 0; p < NPH; ++p) { a.ph_lo = p; a.ph_hi = p + 1; hipLaunchKernelGGL(fwd_kernel, dim3(grid), dim3(NWAVES * 64), LDS_BYTES, stream, a); }
#endif
}
```

```cpp
#include <hip/hip_runtime.h>
#include <cstdio>
#include <cstdint>
#include <cmath>
namespace pg8 {
#define PG8_LAS __attribute__((address_space(3)))
typedef unsigned short bf16_t;
typedef short bf16x8 __attribute__((ext_vector_type(8)));
typedef float f32x4 __attribute__((ext_vector_type(4)));
typedef unsigned u32x4 __attribute__((ext_vector_type(4)));
typedef __attribute__((address_space(1))) u32x4 gu32x4_t; typedef __attribute__((address_space(1))) f32x4 gf32x4_t;
constexpr int BM = 256, BK = 64, HALF = 128, HTB = HALF * BK * 2  , STAGE_BYTES = 8 * HTB, NXCD = 8, WGM = 8;

__host__ __device__ __forceinline__ int lds_byte(int r, int c) { const int st = (r >> 4) * 2 + (c >> 5), rr = r & 15, cc = c & 31, ob = rr * 64 + cc * 2; return st * 1024 + (ob ^ (((ob >> 9) & 1) << 5)); }
__host__ __device__ __forceinline__ void stage_rc(int b, int& R, int& C) { const int st = b / 1024, sb = b % 1024, swz = sb ^ (((sb >> 9) & 1) << 5); R = (st >> 1) * 16 + swz / 64; C = (st & 1) * 32 + (swz % 64) / 2; }
__host__ __device__ __forceinline__ int perm32(int rho) { const int n = rho >> 4, i = rho & 15; return 8 * (i >> 2) + 4 * n + (i & 3); }

struct Unit { int pm, pn; unsigned aoff, boff; };
struct Gemm { const bf16_t* A; const bf16_t* Bt; int K, lda, ldb; };

struct StaticOrder {
    int nM, nN, nwg, G, c, lda, ldb, bbatch;
    __host__ __device__ void init(int M, int N, int G_, int c_, int lda_, int ldb_, int bbatch_ = 0) { nM = M / BM; nN = N / BM; nwg = nM * nN; G = G_; c = c_; lda = lda_; ldb = ldb_; bbatch = bbatch_; }
    __host__ __device__ bool next(int i, Unit& u) const {
        const long L = (long)i * G + c; if (L >= nwg) return false;
        int wgid = (int)L; { const int q = nwg / NXCD, r = nwg % NXCD, xcd = wgid % NXCD, off = wgid / NXCD; wgid = (xcd < r ? xcd * (q + 1) : r * (q + 1) + (xcd - r) * q) + off; }
        const int nig = WGM * nN, gid = wgid / nig, fm = gid * WGM, gsz = (nM - fm) < WGM ? (nM - fm) : WGM;
        u.pm = fm + ((wgid % nig) % gsz); u.pn = (wgid % nig) / gsz;
        u.aoff = (unsigned)u.pm * (unsigned)(BM * lda); u.boff = ((unsigned)u.pn * BM + (unsigned)(u.pm >> 3) * (unsigned)bbatch) * (unsigned)ldb; return true;
    }
    __device__ __forceinline__ void a_ready(const Unit&) const {}
    __device__ __forceinline__ void done(const Unit&) const {}
};

typedef _Float16 h16x8 __attribute__((ext_vector_type(8))); typedef _Float16 h16x2 __attribute__((ext_vector_type(2))); typedef float f32x2c __attribute__((ext_vector_type(2)));
__device__ __forceinline__ unsigned cvt_pk_bf16(float lo, float hi) { const f32x2c v = {lo, hi}; const h16x2 h = __builtin_convertvector(v, h16x2); return __builtin_bit_cast(unsigned, h); }
typedef float f32x2 __attribute__((ext_vector_type(2)));
__device__ __forceinline__ float fq_sum(float x) { float a = x, b = x; asm("s_nop 1\n\tv_permlane16_swap_b32 %0, %1" : "+v"(a), "+v"(b)); float c = a + b, d = c; asm("s_nop 1\n\tv_permlane32_swap_b32 %0, %1" : "+v"(c), "+v"(d)); return c + d; }
__device__ __forceinline__ float fq_max(float x) { float a = x, b = x; asm("s_nop 1\n\tv_permlane16_swap_b32 %0, %1" : "+v"(a), "+v"(b)); float c = fmaxf(a, b), d = c; asm("s_nop 1\n\tv_permlane32_swap_b32 %0, %1" : "+v"(c), "+v"(d)); return fmaxf(c, d); }
__device__ __forceinline__ f32x2 gelu_pk(f32x2 v) {
    const f32x2 av = __builtin_elementwise_abs(v), d = av * 0.2316418882f + 1.0f;
    f32x2 t; t.x = __builtin_amdgcn_rcpf(d.x); t.y = __builtin_amdgcn_rcpf(d.y);
    f32x2 q = t * 0.5307027145f + (-0.7265760135f); q = q * t + 0.7107068705f; q = q * t + (-0.142248368f); q = q * t + 0.127414796f; q = q * t;
    const f32x2 s = (v * v) * (-0.72134752044f);
    f32x2 e; e.x = __builtin_amdgcn_exp2f(s.x); e.y = __builtin_amdgcn_exp2f(s.y);
    const f32x2 m = v * (q * e), r = v - m;
    f32x2 o; o.x = v.x < 0.f ? m.x : r.x; o.y = v.y < 0.f ? m.y : r.y; return o;
}


constexpr int RM = 32768;
constexpr float EPS_ = 1e-6f, LOG2E_ = 1.4426950408889634f;
__device__ __forceinline__ float sigm(float x) { return __builtin_amdgcn_rcpf(1.0f + __builtin_amdgcn_exp2f(-x * LOG2E_)); }
__device__ __forceinline__ float silu_(float x) { return x * sigm(x); }
__device__ __forceinline__ u32x4 pack8(const f32x4 a, const f32x4 b) { u32x4 w; w.x = cvt_pk_bf16(a[0], a[1]); w.y = cvt_pk_bf16(a[2], a[3]); w.z = cvt_pk_bf16(b[0], b[1]); w.w = cvt_pk_bf16(b[2], b[3]); return w; }
__device__ __forceinline__ void row_sums(const float* ssq, int pm, int wr, int lane, float (&raw)[2]) {
#pragma unroll
    for (int ai = 0; ai < 2; ++ai) raw[ai] = ((const __attribute__((address_space(1))) float*)ssq)[pm * BM + ai * HALF + wr * 64 + lane];
}
__device__ __forceinline__ void row_scales(const float (&raw)[2], float (&v)[2]) {
#pragma unroll
    for (int ai = 0; ai < 2; ++ai) v[ai] = 1.0f / sqrtf(raw[ai] * (1.0f / 1024.0f) + EPS_);
}
#define ROWSCALE(ai, m) __shfl(rv[ai], 16 * (m) + fr)
#define ROWFENCE() asm volatile("" ::: "memory")
__device__ __forceinline__ f32x2 swiglu_pk(f32x2 a, f32x2 g) {
    const f32x2 t = a * (-LOG2E_); f32x2 e; e.x = __builtin_amdgcn_exp2f(t.x); e.y = __builtin_amdgcn_exp2f(t.y);
    const f32x2 d = e + 1.0f; f32x2 s; s.x = __builtin_amdgcn_rcpf(d.x); s.y = __builtin_amdgcn_rcpf(d.y);
    return (a * g) * s;
}
__device__ __forceinline__ f32x2 swiglu_rs(f32x2 a, f32x2 g, float rc, float r2) {
    const f32x2 t = a * rc; f32x2 e; e.x = __builtin_amdgcn_exp2f(t.x); e.y = __builtin_amdgcn_exp2f(t.y);
    const f32x2 d = e + 1.0f; f32x2 s; s.x = __builtin_amdgcn_rcpf(d.x); s.y = __builtin_amdgcn_rcpf(d.y);
    return ((a * g) * r2) * s;
}
__device__ __forceinline__ f32x2 xsig_pk(f32x2 x, f32x2 y) {
    const f32x2 t = y * (-LOG2E_); f32x2 e; e.x = __builtin_amdgcn_exp2f(t.x); e.y = __builtin_amdgcn_exp2f(t.y);
    const f32x2 d = e + 1.0f; f32x2 s; s.x = __builtin_amdgcn_rcpf(d.x); s.y = __builtin_amdgcn_rcpf(d.y);
    return x * s;
}
__device__ __forceinline__ f32x4 xsig4(const f32x4 x, const f32x4 y) { const f32x2 lo = xsig_pk((f32x2){x[0], x[1]}, (f32x2){y[0], y[1]}), hi = xsig_pk((f32x2){x[2], x[3]}, (f32x2){y[2], y[3]}); return (f32x4){lo.x, lo.y, hi.x, hi.y}; }
struct EpiIn0 {
    static constexpr bool PERM = true, AFTER_DRAIN = false, PRE = true;
    bf16_t* P; const float* ssq; const float* lb;
    __device__ __forceinline__ void pre(const Unit& u, int wr, int lane, float (&raw)[2]) const { row_sums(ssq, u.pm, wr, lane, raw); }
    __device__ __forceinline__ void operator()(const f32x4 (&acc)[2][2][4][2], const Unit& u, int wr, int wc, int fr, int fq, const float (&raw)[2]) const {
        float rv[2]; row_scales(raw, rv);
        const int row0 = u.pm * BM + wr * 64 + fr, pn = u.pn;
        if (pn < 8) {
            const int typ = pn >> 1;
#pragma unroll
            for (int bj = 0; bj < 2; ++bj) { const int col0 = pn * BM + bj * HALF + wc * 32 + 8 * fq;
                f32x4 l0 = (f32x4){0.f, 0.f, 0.f, 0.f}, l1 = l0;
                if (typ == 1) { l0 = 1.0f - *(const gf32x4_t*)(lb + col0 - 512); l1 = 1.0f - *(const gf32x4_t*)(lb + col0 - 508); }
#pragma unroll
                for (int ai = 0; ai < 2; ++ai)
#pragma unroll
                    for (int m = 0; m < 4; ++m) { const float r = ROWSCALE(ai, m); f32x4 v0 = acc[ai][bj][m][0] * r, v1 = acc[ai][bj][m][1] * r;
                        if (typ == 0 || typ == 3) { v0 = xsig4(v0, v0); v1 = xsig4(v1, v1); }
                        else if (typ == 1) { v0 = xsig4(l0, -v0); v1 = xsig4(l1, -v1); }
                        *(gu32x4_t*)(P + (size_t)(row0 + ai * HALF + m * 16) * 2560 + col0) = pack8(v0, v1); ROWFENCE(); } }
        } else {
            const int col0 = 2048 + (pn - 8) * HALF + wc * 32 + 8 * fq;
#pragma unroll
            for (int ai = 0; ai < 2; ++ai)
#pragma unroll
                for (int m = 0; m < 4; ++m) { const float r = ROWSCALE(ai, m);
                    const f32x4 v0 = xsig4(acc[ai][0][m][0] * r, acc[ai][1][m][0] * r), v1 = xsig4(acc[ai][0][m][1] * r, acc[ai][1][m][1] * r);
                    *(gu32x4_t*)(P + (size_t)(row0 + ai * HALF + m * 16) * 2560 + col0) = pack8(v0, v1); ROWFENCE(); }
        }
    }
};
struct EpiIn1 {
    static constexpr bool PERM = true, AFTER_DRAIN = false, PRE = true;
    bf16_t* P; const float* ssq; float* kpart; float qscale;
    __device__ __forceinline__ void pre(const Unit& u, int wr, int lane, float (&raw)[2]) const { row_sums(ssq, u.pm, wr, lane, raw); }
    __device__ __forceinline__ void operator()(const f32x4 (&acc)[2][2][4][2], const Unit& u, int wr, int wc, int fr, int fq, const float (&raw)[2]) const {
        float rv[2]; row_scales(raw, rv);
        const int row0 = u.pm * BM + wr * 64 + fr, pn = u.pn;
        const int typ = pn < 2 ? 0 : (pn < 4 ? 1 : (pn < 6 ? 2 : 3));
#pragma unroll
        for (int bj = 0; bj < 2; ++bj) { const int col0 = pn * BM + bj * HALF + wc * 32 + 8 * fq;
            f32x4 cs0 = (f32x4){0.f, 0.f, 0.f, 0.f}, cs1 = cs0;
#pragma unroll
            for (int ai = 0; ai < 2; ++ai)
#pragma unroll
                for (int m = 0; m < 4; ++m) { const float r = ROWSCALE(ai, m); f32x4 v0 = acc[ai][bj][m][0] * r, v1 = acc[ai][bj][m][1] * r;
                    if (typ == 0) { v0 = v0 * qscale; v1 = v1 * qscale; }
                    else if (typ == 1) { cs0 += v0; cs1 += v1; }
                    else if (typ == 3) { f32x2 a = gelu_pk((f32x2){v0[0], v0[1]}), b = gelu_pk((f32x2){v0[2], v0[3]}), c = gelu_pk((f32x2){v1[0], v1[1]}), d = gelu_pk((f32x2){v1[2], v1[3]});
                        v0 = (f32x4){a.x, a.y, b.x, b.y}; v1 = (f32x4){c.x, c.y, d.x, d.y}; }
                    *(gu32x4_t*)(P + (size_t)(row0 + ai * HALF + m * 16) * 2560 + col0) = pack8(v0, v1); ROWFENCE(); }
            if (typ == 1) {
#pragma unroll
                for (int i = 0; i < 4; ++i) {
#pragma unroll
                    for (int o = 1; o < 16; o <<= 1) { cs0[i] += __shfl_xor(cs0[i], o); cs1[i] += __shfl_xor(cs1[i], o); } }
                if (fr == 0) { float* kp = kpart + (size_t)(u.pm * 2 + wr) * 512 + (col0 - 512); *(gf32x4_t*)kp = cs0; *(gf32x4_t*)(kp + 4) = cs1; }
            } }
    }
};
struct EpiRes {
    static constexpr bool PERM = true, AFTER_DRAIN = false, PRE = false;
    bf16_t* xb; float* outf; float* ssqw;
    static __device__ __forceinline__ float hadd_lo(unsigned w, float c) { float d; asm("v_fma_mix_f32 %0, %1, 1.0, %2 op_sel_hi:[1,0,0]" : "=v"(d) : "v"(w), "v"(c)); return d; }
    static __device__ __forceinline__ float hadd_hi(unsigned w, float c) { float d; asm("v_fma_mix_f32 %0, %1, 1.0, %2 op_sel:[1,0,0] op_sel_hi:[1,0,0]" : "=v"(d) : "v"(w), "v"(c)); return d; }
    __device__ __forceinline__ void operator()(const f32x4 (&acc)[2][2][4][2], const Unit& u, int wr, int wc, int fr, int fq) const {
        typedef __attribute__((address_space(1))) u32x4 gu32x4;
        const int row0 = u.pm * BM + wr * 64 + fr;
#pragma unroll
        for (int ai = 0; ai < 2; ++ai)
#pragma unroll
            for (int m = 0; m < 4; ++m) { const int row = row0 + ai * HALF + m * 16; float ss = 0.f, s2 = 0.f;
#pragma unroll
                for (int bj = 0; bj < 2; ++bj) { const size_t off = (size_t)row * 1024 + u.pn * BM + bj * HALF + wc * 32 + 8 * fq;
                    const u32x4 b = *(const gu32x4*)(xb + off);
                    const f32x4 a0 = acc[ai][bj][m][0], a1 = acc[ai][bj][m][1];
                    const f32x4 v0 = (f32x4){hadd_lo(b.x, a0[0]), hadd_hi(b.x, a0[1]), hadd_lo(b.y, a0[2]), hadd_hi(b.y, a0[3])};
                    const f32x4 v1 = (f32x4){hadd_lo(b.z, a1[0]), hadd_hi(b.z, a1[1]), hadd_lo(b.w, a1[2]), hadd_hi(b.w, a1[3])};
#pragma unroll
                    for (int e = 0; e < 4; ++e) { ss = __builtin_fmaf(v0[e], v0[e], ss); s2 = __builtin_fmaf(v1[e], v1[e], s2); }
                    *(gu32x4*)(xb + off) = pack8(v0, v1); }
                ss += s2;
                ss = fq_sum(ss);
                if (fq == 0) atomicAdd(ssqw + row, ss);
                ROWFENCE(); }
    }
};
struct EpiFfn {
    static constexpr bool PERM = true, AFTER_DRAIN = false, PRE = true;
    bf16_t* H; const float* ssq;
    __device__ __forceinline__ void pre(const Unit& u, int wr, int lane, float (&raw)[2]) const { row_sums(ssq, u.pm, wr, lane, raw); }
    __device__ __forceinline__ void operator()(const f32x4 (&acc)[2][2][4][2], const Unit& u, int wr, int wc, int fr, int fq, const float (&raw)[2]) const {
        float rv[2]; row_scales(raw, rv);
        const int row0 = u.pm * BM + wr * 64 + fr, col0 = u.pn * HALF + wc * 32 + 8 * fq;
#pragma unroll
        for (int ai = 0; ai < 2; ++ai)
#pragma unroll
            for (int m = 0; m < 4; ++m) { const float r = ROWSCALE(ai, m), rc = -r * LOG2E_, r2 = r * r;
                const f32x4 a0 = acc[ai][0][m][0], a1 = acc[ai][0][m][1], g0 = acc[ai][1][m][0], g1 = acc[ai][1][m][1];
                const f32x2 p0 = swiglu_rs((f32x2){a0[0], a0[1]}, (f32x2){g0[0], g0[1]}, rc, r2), p1 = swiglu_rs((f32x2){a0[2], a0[3]}, (f32x2){g0[2], g0[3]}, rc, r2),
                            p2 = swiglu_rs((f32x2){a1[0], a1[1]}, (f32x2){g1[0], g1[1]}, rc, r2), p3 = swiglu_rs((f32x2){a1[2], a1[3]}, (f32x2){g1[2], g1[3]}, rc, r2);
                *(gu32x4_t*)(H + (size_t)(row0 + ai * HALF + m * 16) * 2816 + col0) = pack8((f32x4){p0.x, p0.y, p1.x, p1.y}, (f32x4){p2.x, p2.y, p3.x, p3.y}); ROWFENCE(); }
    }
};
struct SubOrder {
    int G, c, mode;
    __device__ __forceinline__ bool next(int i, Unit& u) const {
        const int L = i * G + c; if (L >= 256) return false;
        const unsigned b = L >> 4, h = (L >> 2) & 3, t = L & 3; u.pm = L; u.pn = 0;
        const unsigned x = (b * 256u) * 1024u + h * 256u, y = (t * 256u) * 1024u + h * 256u;
        u.aoff = mode == 0 ? x : y; u.boff = mode == 0 ? y : x; return true;
    }
    __device__ __forceinline__ void a_ready(const Unit&) const {}
    __device__ __forceinline__ void done(const Unit&) const {}
};
struct EpiSub {
    static constexpr bool PERM = true, AFTER_DRAIN = false, PRE = false;
    bf16_t* O; int mode;
    __device__ __forceinline__ void operator()(const f32x4 (&acc)[2][2][4][2], const Unit& u, int wr, int wc, int fr, int fq) const {
        const int L = u.pm, b = L >> 4, h = (L >> 2) & 3, t = L & 3;
        const int rb = b * 1024 + (mode == 0 ? h : t) * 256 + wr * 64 + fr, cb = (mode == 0 ? t : h) * 256 + wc * 32 + 8 * fq;
#pragma unroll
        for (int ai = 0; ai < 2; ++ai)
#pragma unroll
            for (int m = 0; m < 4; ++m)
#pragma unroll
                for (int bj = 0; bj < 2; ++bj) *(gu32x4_t*)(O + (size_t)(rb + ai * HALF + m * 16) * 1024 + cb + bj * HALF) = pack8(acc[ai][bj][m][0], acc[ai][bj][m][1]);
    }
};
struct EpiSoftmax {
    static constexpr bool PERM = true, AFTER_DRAIN = false, PRE = true;
    bf16_t* P; const float* ssq; PG8_LAS float* scr;
    __device__ __forceinline__ void pre(const Unit& u, int wr, int lane, float (&raw)[2]) const { row_sums(ssq, u.pm, wr, lane, raw); }
    __device__ __forceinline__ void operator()(f32x4 (&acc)[2][2][4][2], const Unit& u, int wr, int wc, int fr, int fq, const float (&raw)[2]) const {
        float rv[2]; row_scales(raw, rv);
        PG8_LAS float* MX = scr; PG8_LAS float* SM = scr + 1024;
        float mx[2][4];
#pragma unroll
        for (int ai = 0; ai < 2; ++ai)
#pragma unroll
            for (int m = 0; m < 4; ++m) { const float r = ROWSCALE(ai, m); float v = -3.0e38f;
#pragma unroll
                for (int bj = 0; bj < 2; ++bj)
#pragma unroll
                    for (int n = 0; n < 2; ++n) { acc[ai][bj][m][n] = acc[ai][bj][m][n] * r; const f32x4 x = acc[ai][bj][m][n]; v = fmaxf(v, fmaxf(fmaxf(x[0], x[1]), fmaxf(x[2], x[3]))); }
                v = fq_max(v);
                if (fq == 0) MX[(ai * HALF + wr * 64 + m * 16 + fr) * 4 + wc] = v; }
        asm volatile("s_waitcnt lgkmcnt(0)" ::: "memory"); __builtin_amdgcn_s_barrier(); asm volatile("" ::: "memory");
#pragma unroll
        for (int ai = 0; ai < 2; ++ai)
#pragma unroll
            for (int m = 0; m < 4; ++m) { const f32x4 q = *(const PG8_LAS f32x4*)(MX + (ai * HALF + wr * 64 + m * 16 + fr) * 4); const float mm = fmaxf(fmaxf(q[0], q[1]), fmaxf(q[2], q[3])); float sm = 0.f;
#pragma unroll
                for (int bj = 0; bj < 2; ++bj)
#pragma unroll
                    for (int n = 0; n < 2; ++n) { f32x4 x = acc[ai][bj][m][n];
#pragma unroll
                        for (int i = 0; i < 4; ++i) { x[i] = __builtin_amdgcn_exp2f(x[i] - mm); sm += x[i]; }
                        acc[ai][bj][m][n] = x; }
                sm = fq_sum(sm);
                if (fq == 0) SM[(ai * HALF + wr * 64 + m * 16 + fr) * 4 + wc] = sm; }
        asm volatile("s_waitcnt lgkmcnt(0)" ::: "memory"); __builtin_amdgcn_s_barrier(); asm volatile("" ::: "memory");
        const int row0 = u.pm * BM + wr * 64 + fr;
#pragma unroll
        for (int ai = 0; ai < 2; ++ai)
#pragma unroll
            for (int m = 0; m < 4; ++m) { const f32x4 q = *(const PG8_LAS f32x4*)(SM + (ai * HALF + wr * 64 + m * 16 + fr) * 4); const float inv = __builtin_amdgcn_rcpf((q[0] + q[1]) + (q[2] + q[3]));
#pragma unroll
                for (int bj = 0; bj < 2; ++bj) *(gu32x4_t*)(P + (size_t)(row0 + ai * HALF + m * 16) * 1024 + u.pn * BM + bj * HALF + wc * 32 + 8 * fq) = pack8(acc[ai][bj][m][0] * inv, acc[ai][bj][m][1] * inv);
                ROWFENCE(); }
    }
};
struct EpiK {
    static constexpr bool PERM = true, AFTER_DRAIN = false, PRE = false;
    bf16_t* O; const float* rmem;
    __device__ __forceinline__ void operator()(const f32x4 (&acc)[2][2][4][2], const Unit& u, int wr, int wc, int fr, int fq) const {
        const int row0 = u.pm * BM + wr * 64 + fr;
#pragma unroll
        for (int ai = 0; ai < 2; ++ai)
#pragma unroll
            for (int m = 0; m < 4; ++m) { const int row = row0 + ai * HALF + m * 16; const float r = rmem[row];
#pragma unroll
                for (int bj = 0; bj < 2; ++bj) *(gu32x4_t*)(O + (size_t)row * 1024 + u.pn * BM + bj * HALF + wc * 32 + 8 * fq) = pack8(acc[ai][bj][m][0] * r, acc[ai][bj][m][1] * r); }
    }
};
template <class Epi, class Sched, bool ALIGN_EPI = false, bool SP2 = false>
__device__ __forceinline__ void gemm_phase(PG8_LAS unsigned char* lds, const Gemm g, const Sched& S, const Epi& E) {
    int tid_ = threadIdx.x; asm volatile("" : "+v"(tid_));
    const int tid = tid_, wid = __builtin_amdgcn_readfirstlane(tid >> 6), lane = tid & 63, wr = wid >> 2, wc = wid & 3, fr = lane & 15, fq = lane >> 4;
    const int K = g.K, nt = K / BK;
    unsigned voffA[2], voffB[2];
#pragma unroll
    for (int i = 0; i < 2; ++i) { int R, C; stage_rc(tid * 16 + i * 8192, R, C); const int Rb = Epi::PERM ? ((R & ~31) + perm32(R & 31)) : R;
        voffA[i] = (unsigned)(R * g.lda + C) * 2u; voffB[i] = (unsigned)(Rb * g.ldb + C) * 2u; }
    const size_t kstep = (size_t)(BK * 2);
    const size_t hstepA = (size_t)HALF * g.lda * 2, hstepB = (size_t)HALF * g.ldb * 2;
    const unsigned ldsw = (unsigned)wid * 1024u;
    const int aoff = lds_byte(wr * 64 + fr, fq * 8), boff = lds_byte(wc * 32 + fr, fq * 8);
#define PG8_SA(b, h) (((b) * 2 + (h)) * HTB)
#define PG8_SB(b, h) ((4 + (b) * 2 + (h)) * HTB)
#define PG8_STAGE(bufoff, gbase, voff) do { _Pragma("unroll") for (int _i = 0; _i < 2; ++_i) \
        __builtin_amdgcn_global_load_lds((const unsigned*)((const char*)(gbase) + (voff)[_i]), (PG8_LAS unsigned*)(lds + (bufoff) + ldsw + _i * 8192), 16, 0, 0); } while (0)
#define PG8_LDA(dst, b, h) do { _Pragma("unroll") for (int m = 0; m < 4; ++m) _Pragma("unroll") for (int k = 0; k < 2; ++k) dst[m][k] = *(const PG8_LAS bf16x8*)(lds + PG8_SA(b, h) + aoff + m * 2048 + k * 1024); } while (0)
#define PG8_LDB(dst, b, h) do { _Pragma("unroll") for (int n = 0; n < 2; ++n) _Pragma("unroll") for (int k = 0; k < 2; ++k) dst[n][k] = *(const PG8_LAS bf16x8*)(lds + PG8_SB(b, h) + boff + n * 2048 + k * 1024); } while (0)
#define PG8_MMA(ai, bj, At, Bt) do { __builtin_amdgcn_s_setprio(1); _Pragma("unroll") for (int m = 0; m < 4; ++m) _Pragma("unroll") for (int n = 0; n < 2; ++n) _Pragma("unroll") for (int k = 0; k < 2; ++k) \
        acc[ai][bj][m][n] = __builtin_amdgcn_mfma_f32_16x16x32_f16(__builtin_bit_cast(h16x8, Bt[n][k]), __builtin_bit_cast(h16x8, At[m][k]), acc[ai][bj][m][n], 0, 0, 0); __builtin_amdgcn_s_setprio(0); } while (0)
#define PG8_WAIT_V(n) asm volatile("s_waitcnt vmcnt(" #n ")" ::: "memory")
#define PG8_WAIT_L(n) asm volatile("s_waitcnt lgkmcnt(" #n ")" ::: "memory")
#define PG8_BAR __builtin_amdgcn_s_barrier()
#define PG8_SCHED __builtin_amdgcn_sched_barrier(0)
    Unit cur, nxt; int ui = 0;
    if (!S.next(0, cur)) return;
    f32x4 acc[2][2][4][2];
#pragma unroll
    for (int a = 0; a < 2; ++a)
#pragma unroll
        for (int b = 0; b < 2; ++b)
#pragma unroll
            for (int m = 0; m < 4; ++m)
#pragma unroll
                for (int n = 0; n < 2; ++n) acc[a][b][m][n] = (f32x4){0.f, 0.f, 0.f, 0.f};
    bf16x8 At[4][2], B0[2][2], B1[2][2];
    const char* cA = (const char*)g.A + (size_t)cur.aoff * 2; const char* cB = (const char*)g.Bt + (size_t)cur.boff * 2;
    float raw[2] = {0.f, 0.f};
    if constexpr (Epi::PRE) E.pre(cur, wr, lane, raw);
    S.a_ready(cur);
    if constexpr (SP2) {
        PG8_STAGE(PG8_SB(0, 0), cB, voffB); PG8_STAGE(PG8_SB(0, 1), cB + hstepB, voffB); PG8_STAGE(PG8_SA(0, 0), cA, voffA); PG8_STAGE(PG8_SA(0, 1), cA + hstepA, voffA);
        if (wr == 1) PG8_BAR;
        PG8_WAIT_V(2); PG8_BAR;
        PG8_STAGE(PG8_SB(1, 0), cB + kstep, voffB); PG8_STAGE(PG8_SA(1, 0), cA + kstep, voffA); PG8_STAGE(PG8_SB(1, 1), cB + hstepB + kstep, voffB);
        PG8_WAIT_V(6); PG8_BAR;
    } else {
        PG8_STAGE(PG8_SB(0, 0), cB, voffB); PG8_STAGE(PG8_SA(0, 0), cA, voffA); PG8_STAGE(PG8_SB(0, 1), cB + hstepB, voffB); PG8_STAGE(PG8_SA(0, 1), cA + hstepA, voffA);
        if (wr == 1) PG8_BAR;
        PG8_WAIT_V(4); PG8_BAR;
        PG8_STAGE(PG8_SB(1, 0), cB + kstep, voffB); PG8_STAGE(PG8_SA(1, 0), cA + kstep, voffA); PG8_STAGE(PG8_SB(1, 1), cB + hstepB + kstep, voffB);
        PG8_WAIT_V(6); PG8_BAR;
    }
    for (;;) {
        const bool has_next = S.next(ui + 1, nxt);
        const char* nA = has_next ? (const char*)g.A + (size_t)nxt.aoff * 2 : cA; const char* nB = has_next ? (const char*)g.Bt + (size_t)nxt.boff * 2 : cB;
        for (int t = 0; t < nt; t += 2) {
            const bool last = (t == nt - 2);
            const char* a1 = cA + (size_t)(t + 1) * kstep;
            const char* a2 = last ? nA : cA + (size_t)(t + 2) * kstep; const char* b2 = last ? nB : cB + (size_t)(t + 2) * kstep;
            const char* a3 = a2 + kstep; const char* b3 = b2 + kstep;
            if (last && has_next) S.a_ready(nxt);
            if constexpr (SP2) {
            PG8_LDB(B0, 0, 0); PG8_LDB(B1, 0, 1); PG8_SCHED; PG8_LDA(At, 0, 0); PG8_STAGE(PG8_SA(1, 1), a1 + hstepA, voffA);
            PG8_WAIT_V(8); PG8_WAIT_L(0); PG8_BAR; PG8_MMA(0, 0, At, B0); PG8_MMA(0, 1, At, B1); PG8_BAR; PG8_SCHED;
            PG8_LDA(At, 0, 1); PG8_STAGE(PG8_SB(0, 0), b2, voffB); PG8_STAGE(PG8_SB(0, 1), b2 + hstepB, voffB); PG8_STAGE(PG8_SA(0, 0), a2, voffA);
            PG8_WAIT_V(8); PG8_WAIT_L(0); PG8_BAR; PG8_MMA(1, 0, At, B0); PG8_MMA(1, 1, At, B1); PG8_BAR; PG8_SCHED;
            PG8_LDB(B0, 1, 0); PG8_LDB(B1, 1, 1); PG8_SCHED; PG8_LDA(At, 1, 0); PG8_STAGE(PG8_SA(0, 1), a2 + hstepA, voffA);
            PG8_WAIT_V(8); PG8_WAIT_L(0); PG8_BAR; PG8_MMA(0, 0, At, B0); PG8_MMA(0, 1, At, B1); PG8_BAR; PG8_SCHED;
            PG8_LDA(At, 1, 1); PG8_STAGE(PG8_SB(1, 0), b3, voffB); PG8_STAGE(PG8_SB(1, 1), b3 + hstepB, voffB); PG8_STAGE(PG8_SA(1, 0), a3, voffA);
            PG8_WAIT_V(8); PG8_WAIT_L(0); PG8_BAR; PG8_MMA(1, 0, At, B0); PG8_MMA(1, 1, At, B1); PG8_BAR; PG8_SCHED;
            } else {
            PG8_LDB(B0, 0, 0); PG8_SCHED; PG8_LDA(At, 0, 0); PG8_STAGE(PG8_SA(1, 1), a1 + hstepA, voffA);
            PG8_WAIT_L(8); PG8_BAR; PG8_WAIT_L(0); PG8_MMA(0, 0, At, B0); PG8_BAR; PG8_SCHED;
            PG8_LDB(B1, 0, 1); PG8_STAGE(PG8_SB(0, 0), b2, voffB);
            PG8_BAR; PG8_WAIT_L(0); PG8_MMA(0, 1, At, B1); PG8_BAR;
            PG8_LDA(At, 0, 1); PG8_STAGE(PG8_SA(0, 0), a2, voffA);
            PG8_BAR; PG8_WAIT_L(0); PG8_MMA(1, 0, At, B0); PG8_BAR; PG8_SCHED;
            PG8_STAGE(PG8_SB(0, 1), b2 + hstepB, voffB);
            PG8_WAIT_V(6); PG8_BAR; PG8_MMA(1, 1, At, B1); PG8_BAR;
            PG8_LDB(B0, 1, 0); PG8_SCHED; PG8_LDA(At, 1, 0); PG8_STAGE(PG8_SA(0, 1), a2 + hstepA, voffA);
            PG8_WAIT_L(8); PG8_BAR; PG8_WAIT_L(0); PG8_MMA(0, 0, At, B0); PG8_BAR; PG8_SCHED;
            PG8_LDB(B1, 1, 1); PG8_STAGE(PG8_SB(1, 0), b3, voffB);
            PG8_BAR; PG8_WAIT_L(0); PG8_MMA(0, 1, At, B1); PG8_BAR;
            PG8_LDA(At, 1, 1); PG8_STAGE(PG8_SA(1, 0), a3, voffA);
            PG8_BAR; PG8_WAIT_L(0); PG8_MMA(1, 0, At, B0); PG8_BAR; PG8_SCHED;
            PG8_STAGE(PG8_SB(1, 1), b3 + hstepB, voffB);
            PG8_WAIT_V(6); PG8_BAR; PG8_MMA(1, 1, At, B1); PG8_BAR;
            }
        }
        if constexpr (ALIGN_EPI) { if (wr == 0) PG8_BAR; }
        if constexpr (!Epi::AFTER_DRAIN) { if constexpr (Epi::PRE) E(acc, cur, wr, wc, fr, fq, raw); else E(acc, cur, wr, wc, fr, fq); S.done(cur); }
        if (!has_next) break;
#pragma unroll
        for (int a = 0; a < 2; ++a)
#pragma unroll
            for (int b = 0; b < 2; ++b)
#pragma unroll
                for (int m = 0; m < 4; ++m)
#pragma unroll
                    for (int n = 0; n < 2; ++n) acc[a][b][m][n] = (f32x4){0.f, 0.f, 0.f, 0.f};
        cur = nxt; cA = nA; cB = nB; ++ui;
        if constexpr (Epi::PRE) E.pre(cur, wr, lane, raw);
        if constexpr (ALIGN_EPI) { if (wr == 1) PG8_BAR; }
    }
    PG8_WAIT_V(0);
    if constexpr (!ALIGN_EPI) { if (wr == 0) PG8_BAR; }
    PG8_BAR;
    if constexpr (Epi::AFTER_DRAIN) { E.fused(acc, cur, wr, wc, fr, fq, lds, wid, lane); S.done(cur); }
#undef PG8_SA
#undef PG8_SB
#undef PG8_STAGE
#undef PG8_LDA
#undef PG8_LDB
#undef PG8_MMA
#undef PG8_WAIT_V
#undef PG8_WAIT_L
#undef PG8_BAR
#undef PG8_SCHED
}
}

constexpr int NWAVES = 8;
constexpr int BATCH = 16, SEQ = 2048, DM = 1024, MROWS = BATCH * SEQ, MEMLEN = 256, MMEM = BATCH * MEMLEN, FFH = 2816, PW = 2560;
constexpr float EPS = 1e-6f, LOG2E = 1.4426950408889634f;
constexpr float C2M = 0.125f * LOG2E;
constexpr float C2X = 0.0625f * LOG2E;
constexpr float NEGBIG = -1.0e30f;
constexpr int NPH = 16;
#ifndef MK_ONE_LAUNCH
#define MK_ONE_LAUNCH 1
#endif

constexpr size_t MiB = 1u << 20;
constexpr size_t WS_CTL = 0, CTL_ZERO_BYTES = 64 * 1024;
constexpr size_t WS_LB = 1 * MiB, WS_RMEM = 1 * MiB + 4096, WS_SGUW = 1 * MiB + 65536, WS_KPART = 1 * MiB + 512 * 1024;
constexpr size_t WS_SSQ = 2 * MiB;
constexpr size_t WS_WIN0 = 4 * MiB, WS_WOUT0 = 10 * MiB, WS_WIN1 = 12 * MiB, WS_WOUT1 = 17 * MiB, WS_WQ = 19 * MiB, WS_WO = 23 * MiB, WS_WK = 27 * MiB, WS_WV = 31 * MiB,
                 WS_WFI = 35 * MiB, WS_WFO = 57 * MiB;
constexpr size_t WS_MEMB = 68 * MiB, WS_KB = 76 * MiB, WS_VT = 92 * MiB;
constexpr size_t WS_XB = 112 * MiB, WS_BIG = 176 * MiB, WS_MIX = 352 * MiB, WS_QO = 416 * MiB, WS_END = 480 * MiB;
constexpr int CW_BAR = 1024;

constexpr int RING_BYTES = 131072, LDS_BYTES = 147456, LDSCTL_OFF = LDS_BYTES - 512, MISC_OFF = LDSCTL_OFF;

#define GAS __attribute__((address_space(1)))
#define LAS __attribute__((address_space(3)))
typedef unsigned short bf16;
typedef unsigned v4u __attribute__((ext_vector_type(4)));
typedef unsigned v2u __attribute__((ext_vector_type(2)));
typedef float f32x4 __attribute__((ext_vector_type(4)));
typedef float f32x16 __attribute__((ext_vector_type(16)));
typedef short bf16x8 __attribute__((ext_vector_type(8)));
typedef short s16x4 __attribute__((ext_vector_type(4)));
typedef GAS unsigned gu32;
#define LDS_WAIT() asm volatile("s_waitcnt lgkmcnt(0)" ::: "memory")
#define VM_WAIT() asm volatile("s_waitcnt vmcnt(0)" ::: "memory")
__device__ __forceinline__ float bf2f(unsigned short b) { return __uint_as_float(((unsigned)b) << 16); }
__device__ __forceinline__ float bflo(unsigned w) { return __uint_as_float(w << 16); }
__device__ __forceinline__ float bfhi(unsigned w) { return __uint_as_float(w & 0xffff0000u); }
typedef float f32x2_t __attribute__((ext_vector_type(2))); typedef __bf16 bf16x2_t __attribute__((ext_vector_type(2)));
__device__ __forceinline__ unsigned pk2(float lo, float hi) { f32x2_t v = {lo, hi}; bf16x2_t b = __builtin_convertvector(v, bf16x2_t); return __builtin_bit_cast(unsigned, b); }
typedef _Float16 h16x8 __attribute__((ext_vector_type(8))); typedef _Float16 h16x2 __attribute__((ext_vector_type(2)));
__device__ __forceinline__ unsigned pk2h(float lo, float hi) { f32x2_t v = {lo, hi}; h16x2 h = __builtin_convertvector(v, h16x2); return __builtin_bit_cast(unsigned, h); }
__device__ __forceinline__ float h2f(unsigned short b) { return (float)__builtin_bit_cast(_Float16, b); }
__device__ __forceinline__ float hlo(unsigned w) { return (float)__builtin_bit_cast(h16x2, w)[0]; }
__device__ __forceinline__ float hhi(unsigned w) { return (float)__builtin_bit_cast(h16x2, w)[1]; }
__device__ __forceinline__ float fmax_nn(float a, float b) { return __builtin_elementwise_maximum(a, b); }
__device__ __forceinline__ float x32_max(float x) { float a = x, b = x; asm("s_nop 1\n\tv_permlane32_swap_b32 %0, %1" : "+v"(a), "+v"(b)); return fmax_nn(a, b); }
__device__ __forceinline__ float x32_sum(float x) { float a = x, b = x; asm("s_nop 1\n\tv_permlane32_swap_b32 %0, %1" : "+v"(a), "+v"(b)); return a + b; }
__device__ __forceinline__ float fexp2(float x) { return __builtin_amdgcn_exp2f(x); }
__device__ __forceinline__ float fexp(float x) { return __builtin_amdgcn_exp2f(x * LOG2E); }
__device__ __forceinline__ float sigm(float x) { return __builtin_amdgcn_rcpf(1.0f + __builtin_amdgcn_exp2f(-x * LOG2E)); }
__device__ __forceinline__ float wave_sum(float v) {
#pragma unroll
    for (int o = 1; o < 64; o <<= 1) v += __shfl_xor(v, o);
    return v;
}
#define MFMA32(a, b, c) __builtin_amdgcn_mfma_f32_32x32x16_bf16((a), (b), (c), 0, 0, 0)
#define MFMA32H(a, b, c) __builtin_amdgcn_mfma_f32_32x32x16_f16(__builtin_bit_cast(h16x8, (a)), __builtin_bit_cast(h16x8, (b)), (c), 0, 0, 0)
__device__ __forceinline__ bf16x8 ldsfrag(const LAS unsigned char* p) { return *(const LAS bf16x8*)p; }
__device__ __forceinline__ bf16x8 ldsfrag2(const LAS unsigned char* p0, const LAS unsigned char* p1) {
    const s16x4 lo = *(const LAS s16x4*)p0, hi = *(const LAS s16x4*)p1;
    return (bf16x8){lo[0], lo[1], lo[2], lo[3], hi[0], hi[1], hi[2], hi[3]};
}
__device__ __forceinline__ bf16x8 packfrag(const f32x16& p, int s2) {
    v4u w; w.x = pk2h(p[8 * s2 + 0], p[8 * s2 + 1]); w.y = pk2h(p[8 * s2 + 2], p[8 * s2 + 3]); w.z = pk2h(p[8 * s2 + 4], p[8 * s2 + 5]); w.w = pk2h(p[8 * s2 + 6], p[8 * s2 + 7]);
    return __builtin_bit_cast(bf16x8, w);
}
template <int NKS, bool H = false> __device__ __forceinline__ void mma_lds(f32x16& acc, const LAS unsigned char* pa, const LAS unsigned char* pb) {
    bf16x8 fa[NKS], fb[NKS];
#pragma unroll
    for (int ks = 0; ks < NKS; ++ks) { fa[ks] = ldsfrag(pa + ks * 32); fb[ks] = ldsfrag(pb + ks * 32); }
#pragma unroll
    for (int ks = 0; ks < NKS; ++ks) { if constexpr (H) acc = MFMA32H(fa[ks], fb[ks], acc); else acc = MFMA32(fa[ks], fb[ks], acc); }
}
#define XB_TMO      128
#define XB_XCNT(j)  (256  + 64 * (j))
#define XB_XSUB(j)  (1280 + 64 * (j))
#define XB_XGEN(j)  (2304 + 64 * (j))
#define XB_TOP      3328
#define XB_TOPGEN   3392
#define XCD_BAR_WORDS 3456
#define XB_SPIN_CAP (1u << 18)

__device__ __forceinline__ unsigned xb_ld(unsigned* p)              { return __hip_atomic_load(p, __ATOMIC_RELAXED, __HIP_MEMORY_SCOPE_AGENT); }
__device__ __forceinline__ unsigned xb_add(unsigned* p, unsigned v) { return __hip_atomic_fetch_add(p, v, __ATOMIC_RELAXED, __HIP_MEMORY_SCOPE_AGENT); }
__device__ __forceinline__ unsigned xb_xcc_id() { return (unsigned)__builtin_amdgcn_s_getreg((3 << 11) | 20) & 0xFu; }
#define XB_SPIN(cond, bar) do { unsigned _sp = 0; while (cond) { __builtin_amdgcn_s_sleep(1); \
    if ((++_sp & 255u) == 0u) { if (xb_ld(&(bar)[XB_TMO])) break; if (_sp > XB_SPIN_CAP) { atomicAdd(&(bar)[XB_TMO], 1u); break; } } } } while (0)

struct XcdBarrier {
    unsigned* bar; unsigned x;
    volatile LAS unsigned* st;
};

__device__ __forceinline__ XcdBarrier xcd_barrier_post(unsigned* bar, volatile LAS unsigned* st) {
    XcdBarrier b; b.bar = bar; b.x = xb_xcc_id(); b.st = st;
    if (threadIdx.x == 0) (void)xb_add(&bar[XB_XCNT(b.x)], 1u);
    return b;
}
__device__ __forceinline__ void xcd_barrier_complete(unsigned* bar, unsigned x, unsigned& nloc, unsigned& nx) {
    const unsigned G = gridDim.x * gridDim.y * gridDim.z;
    unsigned sum, cnt, mine, sp = 0u;
    for (;;) {
        sum = 0u; cnt = 0u; mine = 0u;
#pragma unroll
        for (unsigned j = 0; j < 16; ++j) { const unsigned c = xb_ld(&bar[XB_XCNT(j)]); sum += c; cnt += (c > 0u) ? 1u : 0u; mine = (j == x) ? c : mine; }
        if (sum == G) break;
        __builtin_amdgcn_s_sleep(1);
        if ((++sp & 255u) == 0u) { if (xb_ld(&bar[XB_TMO])) break; if (sp > XB_SPIN_CAP) { atomicAdd(&bar[XB_TMO], 1u); break; } }
    }
    nloc = mine > 0u ? mine : 1u; nx = cnt > 0u ? cnt : 1u;
}

__device__ __forceinline__ void xcd_barrier(const XcdBarrier& b) {
    asm volatile("s_waitcnt vmcnt(0)" ::: "memory");
    __syncthreads();
    if (threadIdx.x == 0) {
        unsigned* bar = b.bar;
        __builtin_amdgcn_s_waitcnt(0);
        unsigned nloc = b.st[0], nx = b.st[1];
        if (nloc == 0u) { xcd_barrier_complete(bar, b.x, nloc, nx); b.st[0] = nloc; b.st[1] = nx; }
        const unsigned old = xb_add(&bar[XB_XSUB(b.x)], 1u);
        const unsigned gen = old / nloc;
        if (old + 1u == (gen + 1u) * nloc) {
            __builtin_amdgcn_fence(__ATOMIC_RELEASE, "agent");
            asm volatile("s_waitcnt vmcnt(0)" ::: "memory");
            const unsigned og = xb_add(&bar[XB_TOP], 1u);
            const unsigned tg = og / nx;
            if (og + 1u == (tg + 1u) * nx) xb_add(&bar[XB_TOPGEN], 1u);
            else XB_SPIN(xb_ld(&bar[XB_TOPGEN]) == tg, bar);
            __builtin_amdgcn_fence(__ATOMIC_ACQUIRE, "agent");
            xb_add(&bar[XB_XGEN(b.x)], 1u);
            asm volatile("s_waitcnt vmcnt(0)" ::: "memory");
        } else {
            XB_SPIN(xb_ld(&bar[XB_XGEN(b.x)]) == gen, bar);
            __builtin_amdgcn_fence(__ATOMIC_ACQUIRE, "agent");
            asm volatile("s_waitcnt vmcnt(0)" ::: "memory");
        }
    }
    __syncthreads();
}

#define CAS __attribute__((address_space(4)))
struct Args { const float* in[26]; float* out; unsigned char* ws; int ph_lo, ph_hi; };
struct Frame {
    LAS unsigned char* lds;
    int tid, lane, wave, G, bid;
    const CAS struct Args* ka;
    float* out; unsigned char* ws;
};
#define WSP(T, off) ((T*)(F.ws + (off)))
#define WSPG(T, off) ((GAS T*)((GAS unsigned char*)F.ws + (off)))
#define INP(k) ((const GAS float*)F.ka->in[k])

__device__ __forceinline__ void tr_item(const GAS float* W, int ldw, int K, int scol0, int k0, GAS bf16* WT, int drow0, const GAS float* gain, LAS float* scr, int lane) {
    f32x4 v[8]; float gn[8];
#pragma unroll
    for (int i = 0; i < 8; ++i) { const int kk = 8 * i + (lane >> 3); v[i] = __builtin_nontemporal_load((const GAS f32x4*)(W + (size_t)(k0 + kk) * ldw + scol0 + 4 * (lane & 7))); gn[i] = gain ? gain[k0 + kk] : 1.0f; }
#pragma unroll
    for (int i = 0; i < 8; ++i) { const int kk = 8 * i + (lane >> 3); LAS float* d = scr + kk * 33 + 4 * (lane & 7);
        d[0] = v[i][0] * gn[i]; d[1] = v[i][1] * gn[i]; d[2] = v[i][2] * gn[i]; d[3] = v[i][3] * gn[i]; }
    LDS_WAIT(); asm volatile("" ::: "memory");
    const int c = lane & 7;
#pragma unroll
    for (int j = 0; j < 4; ++j) { const int n = (lane >> 3) + 8 * j; const LAS float* s = scr + (8 * c) * 33 + n;
        v4u o; o.x = pk2h(s[0 * 33], s[1 * 33]); o.y = pk2h(s[2 * 33], s[3 * 33]); o.z = pk2h(s[4 * 33], s[5 * 33]); o.w = pk2h(s[6 * 33], s[7 * 33]);
        *(GAS v4u*)(WT + (size_t)(drow0 + n) * K + k0 + 8 * c) = o; }
    LDS_WAIT(); asm volatile("" ::: "memory");
}
__device__ __forceinline__ bool tr_matrix(int& r, const GAS float* W, int ldw, int K, int N, int soff, int map, GAS bf16* WT, const GAS float* gain, LAS float* scr, int lane) {
    const int nblk = N / 32, cnt = (K / 64) * nblk;
    if (r >= cnt) { r -= cnt; return false; }
    const int kb = r / nblk, nb = r % nblk, d0 = 32 * nb; int sc = d0;
    if (map == 1 && d0 >= 2048) { const int q = d0 - 2048; sc = 2048 + ((q >> 7) & 1) * 512 + (q >> 8) * 128 + (q & 127); }
    if (map == 2) sc = ((d0 >> 7) & 1) * FFH + (d0 >> 8) * 128 + (d0 & 127);
    tr_item(W, ldw, K, soff + sc, 64 * kb, WT, d0, gain, scr, lane);
    return true;
}
__device__ __forceinline__ void convert_rest(Frame& F, int wi, int nw) {
    LAS float* scr = (LAS float*)(F.lds + F.wave * 16384);
    const int lane = F.lane;
    constexpr int NITEMS = 512 + 1280 + 512 + 2 * (512 + 2816 + 1408);
    for (int it = wi; it < NITEMS; it += nw) {
        int r = it;
        if (tr_matrix(r, INP(8), DM, DM, DM, 0, 0, WSPG(bf16, WS_WOUT0), nullptr, scr, lane)) continue;
        if (tr_matrix(r, INP(15), PW, DM, PW, 0, 0, WSPG(bf16, WS_WIN1), INP(2) + DM, scr, lane)) continue;
        if (tr_matrix(r, INP(16), DM, DM, DM, 0, 0, WSPG(bf16, WS_WOUT1), nullptr, scr, lane)) continue;
        bool done = false;
#pragma unroll
        for (int l = 0; l < 2; ++l) {
            if (done) break;
            if (tr_matrix(r, INP(23) + (size_t)l * DM * DM, DM, DM, DM, 0, 0, WSPG(bf16, WS_WO) + (size_t)l * DM * DM, nullptr, scr, lane)) { done = true; break; }
            if (tr_matrix(r, INP(24) + (size_t)l * DM * 2 * FFH, 2 * FFH, DM, 2 * FFH, 0, 2, WSPG(bf16, WS_WFI) + (size_t)l * DM * 2 * FFH, INP(4) + l * DM, scr, lane)) { done = true; break; }
            if (tr_matrix(r, INP(25) + (size_t)l * FFH * DM, DM, FFH, DM, 0, 0, WSPG(bf16, WS_WFO) + (size_t)l * FFH * DM, nullptr, scr, lane)) { done = true; break; }
        }
    }
    for (int it = wi; it < 2 * DM; it += nw) {
        const int l = it >> 10, i = it & (DM - 1);
        const float gsc = INP(3)[l * DM + i] * C2X;
        const GAS f32x4* xr = (const GAS f32x4*)(INP(21) + ((size_t)l * DM + i) * DM) + lane;
        GAS v2u* o8 = (GAS v2u*)(WSPG(bf16, WS_WQ) + ((size_t)l * DM + i) * DM) + lane;
#pragma unroll
        for (int j = 0; j < 4; ++j) { const f32x4 v = __builtin_nontemporal_load(xr + 64 * j) * gsc; v2u w; w.x = pk2h(v[0], v[1]); w.y = pk2h(v[2], v[3]); o8[64 * j] = w; }
    }
    __syncthreads();
}
__device__ __forceinline__ void p0_prologue(Frame& F) {
    LAS float* scr = (LAS float*)(F.lds + F.wave * 16384);
    const int gw = F.bid * NWAVES + F.wave, NGW = F.G * NWAVES, lane = F.lane;
    for (int it = gw; it < 1536 + 2048; it += NGW) { int r = it;
        if (tr_matrix(r, INP(7), 3072, DM, 3072, 0, 1, WSPG(bf16, WS_WIN0), INP(2), scr, lane)) continue;
        bool done = false;
#pragma unroll
        for (int l = 0; l < 2; ++l) {
            if (done) break;
            if (tr_matrix(r, INP(22) + (size_t)l * DM * 2048, 2048, DM, DM, 0, 0, WSPG(bf16, WS_WK) + (size_t)l * DM * DM, INP(5), scr, lane)) { done = true; break; }
            if (tr_matrix(r, INP(22) + (size_t)l * DM * 2048, 2048, DM, DM, 1024, 0, WSPG(bf16, WS_WV) + (size_t)l * DM * DM, INP(5), scr, lane)) { done = true; break; }
        } }
    {   const GAS float* x = INP(0); GAS bf16* xb = WSPG(bf16, WS_XB); GAS float* ssq = WSPG(float, WS_SSQ);
        for (int m0 = gw; m0 < MROWS; m0 += 4 * NGW) {
            f32x4 v[4][4];
#pragma unroll
            for (int u = 0; u < 4; ++u) { const int m = m0 + u * NGW; const int mc = m < MROWS ? m : m0; const GAS f32x4* xr = (const GAS f32x4*)(x + (size_t)mc * DM) + lane;
#pragma unroll
                for (int j = 0; j < 4; ++j) v[u][j] = __builtin_nontemporal_load(xr + 64 * j); }
#pragma unroll
            for (int u = 0; u < 4; ++u) { const int m = m0 + u * NGW; float s = 0.f;
#pragma unroll
                for (int j = 0; j < 4; ++j) s += (v[u][j][0] * v[u][j][0] + v[u][j][1] * v[u][j][1]) + (v[u][j][2] * v[u][j][2] + v[u][j][3] * v[u][j][3]);
                s = wave_sum(s);
                if (m < MROWS) {
                    GAS v2u* o8 = (GAS v2u*)(xb + (size_t)m * DM) + lane;
#pragma unroll
                    for (int j = 0; j < 4; ++j) { v2u w; w.x = pk2h(v[u][j][0], v[u][j][1]); w.y = pk2h(v[u][j][2], v[u][j][3]); o8[64 * j] = w; }
                    if (lane == 0) { ssq[m] = s; ssq[MROWS + m] = 0.f; } } }
        } }
    {   const GAS float* x = INP(1); GAS bf16* xb = WSPG(bf16, WS_MEMB); GAS float* rm = WSPG(float, WS_RMEM);
        for (int m = gw; m < MMEM; m += NGW) {
            const GAS f32x4* xr = (const GAS f32x4*)(x + (size_t)m * DM) + lane; f32x4 v[4]; float s = 0.f;
#pragma unroll
            for (int j = 0; j < 4; ++j) { v[j] = __builtin_nontemporal_load(xr + 64 * j); s += (v[j][0] * v[j][0] + v[j][1] * v[j][1]) + (v[j][2] * v[j][2] + v[j][3] * v[j][3]); }
            s = wave_sum(s);
            GAS v2u* o8 = (GAS v2u*)(xb + (size_t)m * DM) + lane;
#pragma unroll
            for (int j = 0; j < 4; ++j) { v2u w; w.x = pk2h(v[j][0], v[j][1]); w.y = pk2h(v[j][2], v[j][3]); o8[64 * j] = w; }
            if (lane == 0) rm[m] = 1.0f / sqrtf(s * (1.0f / DM) + EPS);
        } }
    {   const int idx = F.bid * (NWAVES * 64) + F.tid, NT = F.G * NWAVES * 64;
        for (int i = idx; i < 512; i += NT) { const float a0 = INP(9)[i], a1 = INP(9)[512 + i], a2 = INP(9)[1024 + i]; const float mx = fmaxf(a0, fmaxf(a1, a2));
            const float e0 = __expf(a0 - mx), e1 = __expf(a1 - mx), e2 = __expf(a2 - mx); WSPG(float, WS_LB)[i] = e0 / (e0 + e1 + e2); }
        for (int i = idx; i < 4 * 128 * 128; i += NT) { const int t = (i >> 7) & 127, s = i & 127; WSPG(bf16, WS_SGUW)[i] = (bf16)(s <= t ? (pk2h(INP(19)[i], 0.f) & 0xffffu) : 0u); }
    }
}

constexpr int HG_QIN = 0, HG_KIN = 17408, HG_KOT = 34816, HG_VTT = 53248, HG_ATT = 71680, HG_STT = 80896, HG_OST = 115712, HG_DEC = 133120, HG_SSQ = 133632;
constexpr int P128 = 272, P64 = 144;
__device__ __forceinline__ float wave_scan(float v) {
#define HG_DPP(ctrl, rmask) v += __builtin_bit_cast(float, __builtin_amdgcn_update_dpp(0, __builtin_bit_cast(int, v), (ctrl), (rmask), 0xf, false))
    HG_DPP(0x111, 0xf); HG_DPP(0x112, 0xf); HG_DPP(0x114, 0xf); HG_DPP(0x118, 0xf); HG_DPP(0x142, 0xa); HG_DPP(0x143, 0xc);
#undef HG_DPP
    return v;
}
__device__ __forceinline__ void hgrn_unit(Frame& F, int b, int h) {
    LAS unsigned char* L = F.lds;
    int tid_ = F.tid; asm volatile("" : "+v"(tid_));
    const int tid = tid_, lane = tid & 63, w = __builtin_amdgcn_readfirstlane(tid >> 6), l31 = lane & 31, hh = lane >> 5;
    const GAS bf16* P = WSPG(bf16, WS_BIG); GAS bf16* MIX = WSPG(bf16, WS_MIX);
    const int vs = tid >> 3, vec = (tid & 7) * 16;
    const int eb = w & 3, cb = w >> 2;
    f32x16 S0, S1;
#pragma unroll
    for (int r = 0; r < 16; ++r) { S0[r] = 0.f; S1[r] = 0.f; }
    for (int i = tid; i < 34816 / 16; i += 512) *(LAS v4u*)(L + HG_STT + i * 16) = (v4u){0u, 0u, 0u, 0u};
    float onorm[16];
#pragma unroll
    for (int j = 0; j < 16; ++j) onorm[j] = INP(10)[h * 128 + vec + j];
    LAS float* DEC = (LAS float*)(L + HG_DEC); LAS float* SSQ = (LAS float*)(L + HG_SSQ);
    const GAS bf16* pbase = P + ((size_t)b * SEQ + lane) * PW + h * 128 + 16 * w;
    const GAS bf16* gbase = P + ((size_t)b * SEQ + vs) * PW + 1536 + h * 128 + vec;
    v4u ra0, ra1, ra2, ra3, ra4, ra5, rb0, rb1, rb2, rb3, rb4, rb5, ga0, ga1, gb0, gb1;
    ra0 = *(const GAS v4u*)(pbase); ra1 = *(const GAS v4u*)(pbase + 8); ra2 = *(const GAS v4u*)(pbase + 512); ra3 = *(const GAS v4u*)(pbase + 520); ra4 = *(const GAS v4u*)(pbase + 1024); ra5 = *(const GAS v4u*)(pbase + 1032);
    {   const GAS bf16* p1 = pbase + (size_t)64 * PW;
        rb0 = *(const GAS v4u*)(p1); rb1 = *(const GAS v4u*)(p1 + 8); rb2 = *(const GAS v4u*)(p1 + 512); rb3 = *(const GAS v4u*)(p1 + 520); rb4 = *(const GAS v4u*)(p1 + 1024); rb5 = *(const GAS v4u*)(p1 + 1032); }
    ga0 = *(const GAS v4u*)(gbase); ga1 = *(const GAS v4u*)(gbase + 8); gb0 = *(const GAS v4u*)(gbase + (size_t)64 * PW); gb1 = *(const GAS v4u*)(gbase + (size_t)64 * PW + 8);
    const int tq = (lane & 15) >> 2, tp = lane & 3, tblk = (lane >> 4) & 1;
    const int trl0 = 256 * (8 * hh + tq) + 16 * ((2 * tblk + (tp >> 1)) ^ ((2 * hh) & 3)) + 8 * (tp & 1), trl1 = 256 * (8 * hh + 4 + tq) + 16 * ((2 * tblk + (tp >> 1)) ^ ((2 * hh + 1) & 3)) + 8 * (tp & 1);
    auto trf = [&](const LAS unsigned char* base, const int c32, const int ks) -> bf16x8 {
        const int cx = ((c32 ^ tq) << 6) + 4096 * ks;
        const s16x4 lo = __builtin_amdgcn_ds_read_tr16_b64_v4i16((LAS s16x4*)(base + trl0 + cx)), hi = __builtin_amdgcn_ds_read_tr16_b64_v4i16((LAS s16x4*)(base + trl1 + cx));
        return (bf16x8){lo[0], lo[1], lo[2], lo[3], hi[0], hi[1], hi[2], hi[3]}; };
    auto chunk = [&](const int n, v4u& rq0, v4u& rq1, v4u& rk0, v4u& rk1, v4u& rv0, v4u& rv1, v4u& g0, v4u& g1) {
        const size_t m0 = (size_t)b * SEQ + n * 64;
        {   const unsigned qw[8] = {rq0.x, rq0.y, rq0.z, rq0.w, rq1.x, rq1.y, rq1.z, rq1.w}, kw[8] = {rk0.x, rk0.y, rk0.z, rk0.w, rk1.x, rk1.y, rk1.z, rk1.w}, vw[8] = {rv0.x, rv0.y, rv0.z, rv0.w, rv1.x, rv1.y, rv1.z, rv1.w};
            float kk[16], cm[16];
#pragma unroll
            for (int j2 = 0; j2 < 8; ++j2) { kk[2 * j2] = hlo(kw[j2]); kk[2 * j2 + 1] = hhi(kw[j2]); }
#pragma unroll
            for (int j = 0; j < 16; ++j) cm[j] = __builtin_amdgcn_logf(1.0f - kk[j]);
#define HG_STEP(ctrl, rmask) _Pragma("unroll") for (int j = 0; j < 16; ++j) cm[j] += __builtin_bit_cast(float, __builtin_amdgcn_update_dpp(0, __builtin_bit_cast(int, cm[j]), (ctrl), (rmask), 0xf, false))
            HG_STEP(0x111, 0xf); __builtin_amdgcn_sched_barrier(0); HG_STEP(0x112, 0xf); __builtin_amdgcn_sched_barrier(0); HG_STEP(0x114, 0xf); __builtin_amdgcn_sched_barrier(0); HG_STEP(0x118, 0xf); __builtin_amdgcn_sched_barrier(0);
#undef HG_STEP
#define HG_BC1(c, r) "v_add_f32_dpp " r ", " r ", " r " " c "\n\t"
#define HG_BC(c) asm("s_nop 4\n\t" HG_BC1(c, "%0") HG_BC1(c, "%1") HG_BC1(c, "%2") HG_BC1(c, "%3") HG_BC1(c, "%4") HG_BC1(c, "%5") HG_BC1(c, "%6") HG_BC1(c, "%7") \
                     HG_BC1(c, "%8") HG_BC1(c, "%9") HG_BC1(c, "%10") HG_BC1(c, "%11") HG_BC1(c, "%12") HG_BC1(c, "%13") HG_BC1(c, "%14") HG_BC1(c, "%15") \
                     : "+v"(cm[0]), "+v"(cm[1]), "+v"(cm[2]), "+v"(cm[3]), "+v"(cm[4]), "+v"(cm[5]), "+v"(cm[6]), "+v"(cm[7]), "+v"(cm[8]), "+v"(cm[9]), "+v"(cm[10]), "+v"(cm[11]), "+v"(cm[12]), "+v"(cm[13]), "+v"(cm[14]), "+v"(cm[15]))
            HG_BC("row_bcast:15 row_mask:0xa bank_mask:0xf"); HG_BC("row_bcast:31 row_mask:0xc bank_mask:0xf");
#undef HG_BC
#undef HG_BC1
            unsigned qo[8], ko[8], kt[8];
#pragma unroll
            for (int j = 0; j < 16; ++j) cm[j] = fexp2(cm[j]);
            if (lane == 63) {
#pragma unroll
                for (int g4 = 0; g4 < 4; ++g4) *(LAS f32x4*)(DEC + 16 * w + 4 * g4) = (f32x4){cm[4 * g4], cm[4 * g4 + 1], cm[4 * g4 + 2], cm[4 * g4 + 3]}; }
#pragma unroll
            for (int j2 = 0; j2 < 8; ++j2) {
                float qi[2], ki[2], kd[2];
#pragma unroll
                for (int t = 0; t < 2; ++t) { const int j = 2 * j2 + t;
                    const float e1 = cm[j], e2 = __builtin_amdgcn_rcpf(e1), dec = __builtin_bit_cast(float, __builtin_amdgcn_readlane(__builtin_bit_cast(int, e1), 63));
                    qi[t] = (t == 0 ? hlo(qw[j2]) : hhi(qw[j2])) * e1; ki[t] = kk[j] * e2; kd[t] = ki[t] * dec; }
                qo[j2] = pk2(qi[0], qi[1]); ko[j2] = pk2(ki[0], ki[1]); kt[j2] = pk2h(kd[0], kd[1]);
            }
            {   const int xr = ((lane & 3) << 2) | ((lane >> 2) & 3);
                LAS unsigned char* kp = L + HG_KOT + lane * 256; LAS unsigned char* vp = L + HG_VTT + lane * 256;
                *(LAS v4u*)(kp + (((2 * w) ^ xr) << 4)) = (v4u){kt[0], kt[1], kt[2], kt[3]}; *(LAS v4u*)(kp + (((2 * w + 1) ^ xr) << 4)) = (v4u){kt[4], kt[5], kt[6], kt[7]};
                *(LAS v4u*)(vp + (((2 * w) ^ xr) << 4)) = rv0; *(LAS v4u*)(vp + (((2 * w + 1) ^ xr) << 4)) = rv1; }
            *(LAS v4u*)(L + HG_QIN + lane * P128 + 32 * w) = (v4u){qo[0], qo[1], qo[2], qo[3]}; *(LAS v4u*)(L + HG_QIN + lane * P128 + 32 * w + 16) = (v4u){qo[4], qo[5], qo[6], qo[7]};
            *(LAS v4u*)(L + HG_KIN + lane * P128 + 32 * w) = (v4u){ko[0], ko[1], ko[2], ko[3]}; *(LAS v4u*)(L + HG_KIN + lane * P128 + 32 * w + 16) = (v4u){ko[4], ko[5], ko[6], ko[7]};
        }
        __syncthreads();
        {   const int n2c = n + 2 < 32 ? n + 2 : 31;
            const GAS bf16* pn = pbase + (size_t)n2c * 64 * PW;
            rq0 = *(const GAS v4u*)(pn); rq1 = *(const GAS v4u*)(pn + 8); rk0 = *(const GAS v4u*)(pn + 512); rk1 = *(const GAS v4u*)(pn + 520); rv0 = *(const GAS v4u*)(pn + 1024); rv1 = *(const GAS v4u*)(pn + 1032); }
        f32x16 o;
#pragma unroll
        for (int r = 0; r < 16; ++r) o[r] = 0.f;
        mma_lds<8>(o, L + HG_STT + (32 * eb + l31) * P128 + hh * 16, L + HG_QIN + (32 * cb + l31) * P128 + hh * 16);
        if (w < 3) {
            const int sb = w >> 1, cb2 = (w + 1) >> 1;
            f32x16 at;
#pragma unroll
            for (int r = 0; r < 16; ++r) at[r] = 0.f;
            mma_lds<8>(at, L + HG_KIN + (32 * sb + l31) * P128 + hh * 16, L + HG_QIN + (32 * cb2 + l31) * P128 + hh * 16);
            if (sb == cb2) {
#pragma unroll
                for (int r = 0; r < 16; ++r) { const int sl = (r & 3) + 8 * (r >> 2) + 4 * hh; if (sl > l31) at[r] = 0.f; } }
#pragma unroll
            for (int g4 = 0; g4 < 4; ++g4) *(LAS v2u*)(L + HG_ATT + (32 * cb2 + l31) * P64 + (32 * sb + 8 * g4 + 4 * hh) * 2) = (v2u){pk2h(at[4 * g4], at[4 * g4 + 1]), pk2h(at[4 * g4 + 2], at[4 * g4 + 3])};
        }
        __syncthreads();
        bf16x8 vfr[4];
#pragma unroll
        for (int ks = 0; ks < 4; ++ks) vfr[ks] = trf(L + HG_VTT, eb, ks);
        {   const LAS unsigned char* ab = L + HG_ATT + (32 * cb + l31) * P64 + hh * 16;
            bf16x8 af[4];
#pragma unroll
            for (int ks = 0; ks < 4; ++ks) if (ks < 2 + 2 * cb) af[ks] = ldsfrag(ab + ks * 32);
#pragma unroll
            for (int ks = 0; ks < 4; ++ks) if (ks < 2 + 2 * cb) o = MFMA32H(vfr[ks], af[ks], o); }
#pragma unroll
        for (int i2 = 0; i2 < 2; ++i2) {
            const int dkb = 2 * cb + i2;
            f32x16& S = i2 == 0 ? S0 : S1;
#pragma unroll
            for (int g4 = 0; g4 < 4; ++g4) { const f32x4 d4 = *(const LAS f32x4*)(DEC + 32 * dkb + 8 * g4 + 4 * hh);
#pragma unroll
                for (int j = 0; j < 4; ++j) S[4 * g4 + j] *= d4[j]; }
            {   bf16x8 kfr[4];
#pragma unroll
                for (int ks = 0; ks < 4; ++ks) kfr[ks] = trf(L + HG_KOT, dkb, ks);
#pragma unroll
                for (int ks = 0; ks < 4; ++ks) S = MFMA32H(kfr[ks], vfr[ks], S); }
#pragma unroll
            for (int g4 = 0; g4 < 4; ++g4) *(LAS v2u*)(L + HG_STT + (32 * eb + l31) * P128 + (32 * dkb + 8 * g4 + 4 * hh) * 2) = (v2u){pk2(S[4 * g4], S[4 * g4 + 1]), pk2(S[4 * g4 + 2], S[4 * g4 + 3])};
        }
        {   float ss = 0.f;
#pragma unroll
            for (int r = 0; r < 16; ++r) ss += o[r] * o[r];
            ss = x32_sum(ss);
            if (hh == 0) SSQ[eb * 64 + 32 * cb + l31] = ss;
#pragma unroll
            for (int g4 = 0; g4 < 4; ++g4) *(LAS v2u*)(L + HG_OST + (32 * cb + l31) * P128 + (32 * eb + 8 * g4 + 4 * hh) * 2) = (v2u){pk2h(o[4 * g4], o[4 * g4 + 1]), pk2h(o[4 * g4 + 2], o[4 * g4 + 3])}; }
        __syncthreads();
        {   const int c = vs;
            const float rn = 1.0f / sqrtf(((SSQ[c] + SSQ[64 + c]) + (SSQ[128 + c] + SSQ[192 + c])) * (1.0f / 128.0f) + EPS);
            const v4u o0 = *(const LAS v4u*)(L + HG_OST + c * P128 + vec * 2), o1 = *(const LAS v4u*)(L + HG_OST + c * P128 + vec * 2 + 16);
            const unsigned ow[8] = {o0.x, o0.y, o0.z, o0.w, o1.x, o1.y, o1.z, o1.w}, gw[8] = {g0.x, g0.y, g0.z, g0.w, g1.x, g1.y, g1.z, g1.w};
            {   const int n2c = n + 2 < 32 ? n + 2 : 31; g0 = *(const GAS v4u*)(gbase + (size_t)n2c * 64 * PW); g1 = *(const GAS v4u*)(gbase + (size_t)n2c * 64 * PW + 8); }
            unsigned res[8];
#pragma unroll
            for (int j = 0; j < 8; ++j) res[j] = pk2h(hlo(ow[j]) * rn * onorm[2 * j] * hlo(gw[j]), hhi(ow[j]) * rn * onorm[2 * j + 1] * hhi(gw[j]));
            *(GAS v4u*)(MIX + (m0 + c) * DM + h * 128 + vec) = (v4u){res[0], res[1], res[2], res[3]};
            *(GAS v4u*)(MIX + (m0 + c) * DM + h * 128 + vec + 8) = (v4u){res[4], res[5], res[6], res[7]};
        }
    };
#pragma unroll 1
    for (int n2 = 0; n2 < 32; n2 += 2) { chunk(n2, ra0, ra1, ra2, ra3, ra4, ra5, ga0, ga1); chunk(n2 + 1, rb0, rb1, rb2, rb3, rb4, rb5, gb0, gb1); }
    __syncthreads();
}

__device__ __forceinline__ void reduce16x2(float (&a)[16], int lane) {
#pragma unroll
    for (int i = 0; i < 8; ++i) { const bool up = (lane & 32) != 0; const float send = up ? a[i] : a[i + 8]; const float keep = up ? a[i + 8] : a[i]; a[i] = keep + __shfl_xor(send, 32); }
#pragma unroll
    for (int i = 0; i < 4; ++i) { const bool up = (lane & 16) != 0; const float send = up ? a[i] : a[i + 4]; const float keep = up ? a[i + 4] : a[i]; a[i] = keep + __shfl_xor(send, 16); }
#pragma unroll
    for (int i = 0; i < 2; ++i) { const bool up = (lane & 8) != 0; const float send = up ? a[i] : a[i + 2]; const float keep = up ? a[i + 2] : a[i]; a[i] = keep + __shfl_xor(send, 8); }
    { const bool up = (lane & 4) != 0; const float send = up ? a[0] : a[1]; const float keep = up ? a[1] : a[0]; a[0] = keep + __shfl_xor(send, 4); }
    a[0] += __shfl_xor(a[0], 2); a[0] += __shfl_xor(a[0], 1);
}
constexpr int CV_CT = 0, CV_PART = 98304;
__device__ __forceinline__ void conv_tiles(Frame& F, int first, int stride) {
    if (first >= 512) return;
    LAS unsigned char* L = F.lds;
    int tid_ = F.tid; asm volatile("" : "+v"(tid_));
    const int tid = tid_, lane = tid & 63, w = __builtin_amdgcn_readfirstlane(tid >> 6);
    const GAS bf16* P = WSPG(bf16, WS_BIG); GAS unsigned* MIX32 = WSPG(unsigned, WS_MIX);
    const int cp = tid & 255, th = tid >> 8;
    float w0[31], w1[31];
#pragma unroll
    for (int k = 0; k < 31; ++k) { const f32x2_t ww = *(const GAS f32x2_t*)(INP(11) + k * 512 + 2 * cp); w0[k] = ww.x; w1[k] = ww.y; }
    const f32x2_t bias = *(const GAS f32x2_t*)(INP(12) + 2 * cp), lng = *(const GAS f32x2_t*)(INP(13) + 2 * cp), lnb = *(const GAS f32x2_t*)(INP(14) + 2 * cp);
    LAS float* PART = (LAS float*)(L + CV_PART);
    const LAS unsigned* CT32 = (const LAS unsigned*)(L + CV_CT);
    v4u rows[12];
    auto load_rows = [&](int tile) { const int b = tile >> 5, t0 = (tile & 31) * 64;
#pragma unroll
        for (int i = 0; i < 12; ++i) { const int idx = tid + 512 * i, j = idx >> 6, c16 = idx & 63, t = t0 - 30 + j;
            rows[i] = (v4u){0u, 0u, 0u, 0u}; if (idx < 94 * 64 && t >= 0) rows[i] = *(const GAS v4u*)(P + ((size_t)b * SEQ + t) * PW + 2048 + c16 * 8); } };
    auto store_rows = [&]() {
#pragma unroll
        for (int i = 0; i < 12; ++i) { const int idx = tid + 512 * i; if (idx < 94 * 64) *(LAS v4u*)(L + CV_CT + (idx >> 6) * 1024 + (idx & 63) * 16) = rows[i]; } };
    load_rows(first);
#pragma unroll 1
    for (int tile = first; tile < 512; tile += stride) {
        const int b = tile >> 5, t0 = (tile & 31) * 64; const size_t m0 = (size_t)b * SEQ + t0;
        store_rows();
        __syncthreads();
        if (tile + stride < 512) load_rows(tile + stride);
#pragma unroll 1
        for (int grp = 0; grp < 4; ++grp) {
            const int tok0 = 32 * th + 8 * grp;
            float a0[8], a1[8];
#pragma unroll
            for (int i = 0; i < 8; ++i) { a0[i] = bias.x; a1[i] = bias.y; }
#pragma unroll
            for (int jj = 0; jj < 38; ++jj) { const unsigned v = CT32[(tok0 + jj) * 256 + cp]; const float x0 = hlo(v), x1 = hhi(v);
#pragma unroll
                for (int i = 0; i < 8; ++i) { const int k = jj - i; if (k >= 0 && k <= 30) { a0[i] += w0[k] * x0; a1[i] += w1[k] * x1; } } }
            float st[16];
#pragma unroll
            for (int i = 0; i < 8; ++i) { st[i] = a0[i] + a1[i]; st[8 + i] = a0[i] * a0[i] + a1[i] * a1[i]; }
            reduce16x2(st, lane);
            if ((lane & 3) == 0) PART[((grp & 1) * 8 + w) * 16 + (8 * ((lane >> 5) & 1) + 4 * ((lane >> 4) & 1) + 2 * ((lane >> 3) & 1) + ((lane >> 2) & 1))] = st[0];
            __syncthreads();
#pragma unroll
            for (int i = 0; i < 8; ++i) {
                float s = 0.f, q = 0.f;
#pragma unroll
                for (int ww = 0; ww < 4; ++ww) { s += PART[((grp & 1) * 8 + 4 * th + ww) * 16 + i]; q += PART[((grp & 1) * 8 + 4 * th + ww) * 16 + 8 + i]; }
                const float mu = s * (1.0f / 512.0f), var = q * (1.0f / 512.0f) - mu * mu, rstd = 1.0f / sqrtf(fmaxf(var, 0.f) + EPS);
                float y0 = (a0[i] - mu) * rstd * lng.x + lnb.x, y1 = (a1[i] - mu) * rstd * lng.y + lnb.y;
                y0 *= sigm(y0); y1 *= sigm(y1);
                MIX32[(m0 + tok0 + i) * 512 + 256 + cp] = pk2h(y0, y1);
            }
        }
        __syncthreads();
    }
}

constexpr int MB_KP = 144, MB_VOFF = 256 * MB_KP, MB_BUF = MB_VOFF + 256 * 128, MB_KM = 2 * MB_BUF;
__device__ __forceinline__ void moba_unit(Frame& F, int b, int hd, int jq) {
    LAS unsigned char* L = F.lds;
    int tid_ = F.tid; asm volatile("" : "+v"(tid_));
    const int tid = tid_, lane = tid & 63, w = __builtin_amdgcn_readfirstlane(tid >> 6), l31 = lane & 31, hh = lane >> 5;
    const GAS bf16* P = WSPG(bf16, WS_BIG); GAS bf16* MIX = WSPG(bf16, WS_MIX); const GAS float* kpart = WSPG(float, WS_KPART);
    const size_t m0 = (size_t)b * SEQ + jq * 256;
    const size_t qrow = m0 + 32 * w + l31;
    bf16x8 qf[4];
#pragma unroll
    for (int ks = 0; ks < 4; ++ks) qf[ks] = *(const GAS bf16x8*)(P + qrow * PW + hd * 64 + 16 * ks + 8 * hh);
    LAS float* KM = (LAS float*)(L + MB_KM);
    if (tid < jq * 64) { const int n = tid >> 6, d = tid & 63, pm = b * 8 + n, col = hd * 64 + d;
        KM[n * 64 + d] = (kpart[(size_t)(pm * 2) * 512 + col] + kpart[(size_t)(pm * 2 + 1) * 512 + col]) * (1.0f / 256.0f); }
    const int skey = tid >> 3, sch = tid & 7;
    v4u kreg[4], vreg[4];
    auto stage_load = [&](int blk) { const size_t mk = (size_t)b * SEQ + blk * 256;
#pragma unroll
        for (int j = 0; j < 4; ++j) { kreg[j] = *(const GAS v4u*)(P + (mk + skey + 64 * j) * PW + 512 + hd * 64 + 8 * sch); vreg[j] = *(const GAS v4u*)(P + (mk + skey + 64 * j) * PW + 1024 + hd * 64 + 8 * sch); } };
    auto stage_write = [&](int buf) {
#pragma unroll
        for (int j = 0; j < 4; ++j) { *(LAS v4u*)(L + buf * MB_BUF + (skey + 64 * j) * MB_KP + sch * 16) = kreg[j];
            *(LAS v4u*)(L + buf * MB_BUF + MB_VOFF + (skey + 64 * j) * 128 + ((sch ^ (((skey >> 1) & 1) << 2)) << 4)) = vreg[j]; } };
    stage_load(jq); stage_write(0);
    __syncthreads();
    unsigned sel = 0u;
    if (jq <= 3) sel = (1u << jq) - 1u;
    else {
        float sc[7];
#pragma unroll
        for (int n = 0; n < 7; ++n) { float p = 0.f;
            if (n < jq) {
#pragma unroll
                for (int ks = 0; ks < 4; ++ks)
#pragma unroll
                    for (int j = 0; j < 8; ++j) p += h2f((unsigned short)qf[ks][j]) * KM[n * 64 + 16 * ks + 8 * hh + j];
                p = x32_sum(p); } else p = -INFINITY;
            sc[n] = p; }
#pragma unroll
        for (int n = 0; n < 7; ++n) { int rank = 0;
#pragma unroll
            for (int n2 = 0; n2 < 7; ++n2) if (n2 != n) rank += (sc[n2] > sc[n] || (sc[n2] == sc[n] && n2 < n)) ? 1 : 0;
            if (n < jq && rank < 3) sel |= 1u << n; }
    }
    const int tq = (lane & 15) >> 2, tp = lane & 3, tblk = (lane >> 4) & 1, tqb = (tq >> 1) & 1;
    const int vt0 = (4 * hh + tq) * 128 + ((((0 ^ tqb) << 2) + 2 * tblk + (tp >> 1)) << 4) + 8 * (tp & 1), vt1 = (4 * hh + tq) * 128 + ((((1 ^ tqb) << 2) + 2 * tblk + (tp >> 1)) << 4) + 8 * (tp & 1);
    auto trfrag = [&](const LAS unsigned char* p) -> bf16x8 {
        const s16x4 lo = __builtin_amdgcn_ds_read_tr16_b64_v4i16((LAS s16x4*)p), hi = __builtin_amdgcn_ds_read_tr16_b64_v4i16((LAS s16x4*)(p + 1024));
        return (bf16x8){lo[0], lo[1], lo[2], lo[3], hi[0], hi[1], hi[2], hi[3]}; };
    if (w >= 4) __builtin_amdgcn_s_setprio(1);
    float negm = 0.f; bool first = true; f32x16 O0, O1, O2, cs;
#pragma unroll
    for (int r = 0; r < 16; ++r) { O0[r] = 0.f; O1[r] = 0.f; O2[r] = 0.f; }
    const bf16x8 ones = __builtin_bit_cast(bf16x8, (v4u){0x3C003C00u, 0x3C003C00u, 0x3C003C00u, 0x3C003C00u});
#pragma unroll 1
    for (int bi = 0; bi <= jq; ++bi) {
        const int buf = bi & 1;
        if (bi < jq) stage_load(bi);
        const bool own = bi == 0; const int blk = own ? jq : bi - 1;
        const bool mysel = own ? true : (((sel >> blk) & 1u) != 0u);
        const bool anysel = own ? true : (__ballot(mysel) != 0ull);
        const int nkt = own ? ((w >> 1) + 1) : (anysel ? 4 : 0);
        {   const float cv = mysel ? negm : NEGBIG;
#pragma unroll
            for (int r = 0; r < 16; ++r) cs[r] = cv; }
#pragma unroll 1
        for (int kt = 0; kt < nkt; ++kt) {
            f32x16 p0, p1;
            {   const LAS unsigned char* kb = L + buf * MB_BUF + (64 * kt + l31) * MB_KP + hh * 16;
                bf16x8 kfa[4], kfb[4];
#pragma unroll
                for (int ks = 0; ks < 4; ++ks) { kfa[ks] = ldsfrag(kb + ks * 32); kfb[ks] = ldsfrag(kb + 32 * MB_KP + ks * 32); }
                p0 = MFMA32H(kfa[0], qf[0], cs); p1 = MFMA32H(kfb[0], qf[0], cs);
#pragma unroll
                for (int ks = 1; ks < 4; ++ks) { p0 = MFMA32H(kfa[ks], qf[ks], p0); p1 = MFMA32H(kfb[ks], qf[ks], p1); } }
            bf16x8 vf[8];
            {   const LAS unsigned char* vb = L + buf * MB_BUF + MB_VOFF + 8192 * kt;
#pragma unroll
                for (int ks4 = 0; ks4 < 4; ++ks4) { vf[ks4 * 2] = trfrag(vb + vt0 + 2048 * ks4); vf[ks4 * 2 + 1] = trfrag(vb + vt1 + 2048 * ks4); } }
            if (own) { const int qrel = 32 * w + l31, kb0 = 64 * kt + 4 * hh;
                if (64 * kt + 63 > 32 * w) {
#pragma unroll
                    for (int r = 0; r < 16; ++r) { const int kv = kb0 + (r & 3) + 8 * (r >> 2); if (kv > qrel) p0[r] = NEGBIG; if (kv + 32 > qrel) p1[r] = NEGBIG; } }
            }
            float mxa = fmax_nn(fmax_nn(p0[0], p1[0]), p0[4]), mxb = fmax_nn(fmax_nn(p0[1], p1[1]), p0[5]), mxc = fmax_nn(fmax_nn(p0[2], p1[2]), p0[6]), mxd = fmax_nn(fmax_nn(p0[3], p1[3]), p0[7]);
            mxa = fmax_nn(fmax_nn(mxa, p1[4]), p0[8]); mxb = fmax_nn(fmax_nn(mxb, p1[5]), p0[9]); mxc = fmax_nn(fmax_nn(mxc, p1[6]), p0[10]); mxd = fmax_nn(fmax_nn(mxd, p1[7]), p0[11]);
            mxa = fmax_nn(fmax_nn(mxa, p1[8]), p0[12]); mxb = fmax_nn(fmax_nn(mxb, p1[9]), p0[13]); mxc = fmax_nn(fmax_nn(mxc, p1[10]), p0[14]); mxd = fmax_nn(fmax_nn(mxd, p1[11]), p0[15]);
            mxa = fmax_nn(fmax_nn(mxa, p1[12]), p1[13]); mxb = fmax_nn(fmax_nn(mxb, p1[14]), p1[15]);
            float mx = fmax_nn(fmax_nn(fmax_nn(mxa, mxb), mxc), mxd);
            mx = x32_max(mx);
            if (first || !__all(mx <= 8.0f)) {
                const float delta = first ? mx : fmaxf(mx, 0.f);
                negm -= delta;
#pragma unroll
                for (int r = 0; r < 16; ++r) { p0[r] -= delta; p1[r] -= delta; }
                if (!first) { const float alpha = fexp2(-delta);
#pragma unroll
                    for (int r = 0; r < 16; ++r) { O0[r] *= alpha; O1[r] *= alpha; O2[r] *= alpha; } }
                first = false;
                {   const float cv = mysel ? negm : NEGBIG;
#pragma unroll
                    for (int r = 0; r < 16; ++r) cs[r] = cv; }
            }
#pragma unroll
            for (int r = 0; r < 16; ++r) { p0[r] = fexp2(p0[r]); p1[r] = fexp2(p1[r]); }
#pragma unroll
            for (int sub = 0; sub < 2; ++sub)
#pragma unroll
                for (int s2 = 0; s2 < 2; ++s2) { const bf16x8 pb = packfrag(sub == 0 ? p0 : p1, s2);
                    O0 = MFMA32H(vf[(sub * 2 + s2) * 2], pb, O0);
                    O1 = MFMA32H(vf[(sub * 2 + s2) * 2 + 1], pb, O1);
                    O2 = MFMA32H(ones, pb, O2); }
        }
        if (bi < jq) stage_write(buf ^ 1);
        __syncthreads();
    }
    __builtin_amdgcn_s_setprio(0);
    {   const float inv = 1.0f / O2[0];
        GAS bf16* op = MIX + qrow * DM + hd * 64 + 4 * hh;
#pragma unroll
        for (int g4 = 0; g4 < 4; ++g4) {
            *(GAS v2u*)(op + 8 * g4) = (v2u){pk2h(O0[4 * g4] * inv, O0[4 * g4 + 1] * inv), pk2h(O0[4 * g4 + 2] * inv, O0[4 * g4 + 3] * inv)};
            *(GAS v2u*)(op + 32 + 8 * g4) = (v2u){pk2h(O1[4 * g4] * inv, O1[4 * g4 + 1] * inv), pk2h(O1[4 * g4 + 2] * inv, O1[4 * g4 + 3] * inv)}; }
    }
}

constexpr int SG_ZT = 0, SG_STAT = 34816, SG_OT = 40960, SG_PAR = 77824;
__device__ __forceinline__ void sgu_unit(Frame& F, int ucur, int unext, const v4u (&zr)[4], const v4u (&ur)[4], v4u (&nz)[4], v4u (&nu)[4]) {
    const int b = ucur >> 6, nc = (ucur >> 2) & 15, g = ucur & 3;
    LAS unsigned char* L = F.lds;
    int tid_ = F.tid; asm volatile("" : "+v"(tid_));
    const int tid = tid_, lane = tid & 63, w = __builtin_amdgcn_readfirstlane(tid >> 6), l31 = lane & 31, hh = lane >> 5;
    const GAS bf16* P = WSPG(bf16, WS_BIG); GAS bf16* MIX = WSPG(bf16, WS_MIX); const GAS bf16* Wb = WSPG(bf16, WS_SGUW) + g * 128 * 128;
    const size_t m0 = (size_t)b * SEQ + nc * 128;
    const int s = tid & 127, qt = tid >> 7, c0 = 32 * qt;
    const int tb0 = w >> 2;
    bf16x8 wf0[4], wf1[8];
#pragma unroll
    for (int ks = 0; ks < 4; ++ks) if (ks < 2 * (tb0 + 1)) wf0[ks] = *(const GAS bf16x8*)(Wb + (32 * tb0 + l31) * 128 + 8 * hh + 16 * ks);
#pragma unroll
    for (int ks = 0; ks < 8; ++ks) if (ks < 2 * (4 - tb0)) wf1[ks] = *(const GAS bf16x8*)(Wb + (32 * (3 - tb0) + l31) * 128 + 8 * hh + 16 * ks);
    if (unext >= 0) {
        const int b2 = unext >> 6, nc2 = (unext >> 2) & 15, g2 = unext & 3; const size_t m2 = (size_t)b2 * SEQ + nc2 * 128;
        const GAS bf16* zp = P + (m2 + s) * PW + 2048 + g2 * 128 + c0; const GAS bf16* up = P + (m2 + (tid >> 2)) * PW + 1536 + g2 * 128 + (tid & 3) * 32;
#pragma unroll
        for (int j4 = 0; j4 < 4; ++j4) { nz[j4] = *(const GAS v4u*)(zp + 8 * j4); nu[j4] = *(const GAS v4u*)(up + 8 * j4); } }
    float z[32];
#pragma unroll
    for (int j4 = 0; j4 < 4; ++j4) { const unsigned vw[4] = {zr[j4].x, zr[j4].y, zr[j4].z, zr[j4].w};
#pragma unroll
        for (int j = 0; j < 4; ++j) { z[8 * j4 + 2 * j] = hlo(vw[j]); z[8 * j4 + 2 * j + 1] = hhi(vw[j]); } }
    float sm = 0.f, sq = 0.f;
#pragma unroll
    for (int j = 0; j < 32; ++j) { sm += z[j]; sq += z[j] * z[j]; }
    LAS float* ST = (LAS float*)(L + SG_STAT);
    ST[(qt * 128 + s) * 2] = sm; ST[(qt * 128 + s) * 2 + 1] = sq;
    __syncthreads();
    {   float a = 0.f, q = 0.f;
#pragma unroll
        for (int k = 0; k < 4; ++k) { a += ST[(k * 128 + s) * 2]; q += ST[(k * 128 + s) * 2 + 1]; }
        const float mu = a * (1.0f / 128.0f), var = q * (1.0f / 128.0f) - mu * mu, rstd = 1.0f / sqrtf(fmaxf(var, 0.f) + EPS);
        const LAS float* lg = (const LAS float*)(L + SG_PAR) + g * 128 + c0; const LAS float* lbp = lg + 512;
#pragma unroll
        for (int i4 = 0; i4 < 4; ++i4) { unsigned pw[4];
#pragma unroll
            for (int h2 = 0; h2 < 2; ++h2) { const int j4 = 2 * i4 + h2; const f32x4 g4v = *(const LAS f32x4*)(lg + 4 * j4), b4v = *(const LAS f32x4*)(lbp + 4 * j4);
                pw[2 * h2] = pk2h((z[4 * j4] - mu) * rstd * g4v[0] + b4v[0], (z[4 * j4 + 1] - mu) * rstd * g4v[1] + b4v[1]);
                pw[2 * h2 + 1] = pk2h((z[4 * j4 + 2] - mu) * rstd * g4v[2] + b4v[2], (z[4 * j4 + 3] - mu) * rstd * g4v[3] + b4v[3]); }
            *(LAS v4u*)(L + SG_ZT + s * 256 + (((4 * qt + i4) ^ (((s & 3) << 2) | ((s >> 2) & 3))) << 4)) = (v4u){pw[0], pw[1], pw[2], pw[3]}; }
    }
    __syncthreads();
    const int cb = w & 3;
    const int zq = (lane & 15) >> 2, zp = lane & 3, zblk = (lane >> 4) & 1;
    const int zt0 = (8 * hh + zq) * 256 + (((4 * cb + 2 * zblk + (zp >> 1)) ^ ((zq << 2) | ((2 * hh) & 3))) << 4) + 8 * (zp & 1);
    const int zt1 = (8 * hh + 4 + zq) * 256 + (((4 * cb + 2 * zblk + (zp >> 1)) ^ ((zq << 2) | ((2 * hh + 1) & 3))) << 4) + 8 * (zp & 1);
#pragma unroll
    for (int it = 0; it < 2; ++it) {
        const int tb = it == 0 ? tb0 : 3 - tb0;
        f32x16 acc;
#pragma unroll
        for (int r = 0; r < 16; ++r) acc[r] = 0.f;
        const int nks = 2 * (tb + 1);
#pragma unroll
        for (int ks = 0; ks < (it == 0 ? 4 : 8); ++ks) if (ks < nks) {
            const s16x4 lo = __builtin_amdgcn_ds_read_tr16_b64_v4i16((LAS s16x4*)(L + SG_ZT + zt0 + 4096 * ks)), hi = __builtin_amdgcn_ds_read_tr16_b64_v4i16((LAS s16x4*)(L + SG_ZT + zt1 + 4096 * ks));
            acc = MFMA32H(((bf16x8){lo[0], lo[1], lo[2], lo[3], hi[0], hi[1], hi[2], hi[3]}), it == 0 ? wf0[ks] : wf1[ks], acc); }
        const float bias = ((const LAS float*)(L + SG_PAR))[1024 + g * 128 + 32 * tb + l31];
#pragma unroll
        for (int g4 = 0; g4 < 4; ++g4) *(LAS v2u*)(L + SG_OT + (32 * tb + l31) * P128 + (32 * cb + 8 * g4 + 4 * hh) * 2) = (v2u){pk2h(acc[4 * g4] + bias, acc[4 * g4 + 1] + bias), pk2h(acc[4 * g4 + 2] + bias, acc[4 * g4 + 3] + bias)};
    }
    __syncthreads();
    {   const int t = tid >> 2, cc = (tid & 3) * 32;
        GAS bf16* op = MIX + (m0 + t) * DM + 512 + g * 128 + cc;
#pragma unroll
        for (int j4 = 0; j4 < 4; ++j4) { const v4u u = ur[j4], mx = *(const LAS v4u*)(L + SG_OT + t * P128 + (cc + 8 * j4) * 2);
            *(GAS v4u*)(op + 8 * j4) = (v4u){pk2h(hlo(u.x) * hlo(mx.x), hhi(u.x) * hhi(mx.x)), pk2h(hlo(u.y) * hlo(mx.y), hhi(u.y) * hhi(mx.y)), pk2h(hlo(u.z) * hlo(mx.z), hhi(u.z) * hhi(mx.z)), pk2h(hlo(u.w) * hlo(mx.w), hhi(u.w) * hhi(mx.w))}; }
    }
    __syncthreads();
}

__device__ __forceinline__ void sgu_units(Frame& F, int first, int stride) {
    if (first >= 1024) return;
    const int tid = F.tid, s = tid & 127, c0 = 32 * (tid >> 7);
    const GAS bf16* P = WSPG(bf16, WS_BIG);
    {   LAS float* PAR = (LAS float*)(F.lds + SG_PAR);
        PAR[tid] = INP(17)[tid]; PAR[512 + tid] = INP(18)[tid]; PAR[1024 + tid] = INP(20)[tid]; }
    v4u za[4], ua[4], zb[4], ub[4];
    {   const int b = first >> 6, nc = (first >> 2) & 15, g = first & 3; const size_t m0 = (size_t)b * SEQ + nc * 128;
        const GAS bf16* zp = P + (m0 + s) * PW + 2048 + g * 128 + c0; const GAS bf16* up = P + (m0 + (tid >> 2)) * PW + 1536 + g * 128 + (tid & 3) * 32;
#pragma unroll
        for (int j4 = 0; j4 < 4; ++j4) { za[j4] = *(const GAS v4u*)(zp + 8 * j4); ua[j4] = *(const GAS v4u*)(up + 8 * j4); } }
#pragma unroll 1
    for (int u = first; u < 1024; u += 2 * stride) {
        const int u1 = u + stride, u2 = u + 2 * stride;
        sgu_unit(F, u, u1 < 1024 ? u1 : -1, za, ua, zb, ub);
        if (u1 < 1024) sgu_unit(F, u1, u2 < 1024 ? u2 : -1, zb, ub, za, ua);
    }
}

__device__ __forceinline__ void final_norm(Frame& F) {
    const int gw = F.bid * NWAVES + F.wave, NGW = F.G * NWAVES, lane = F.lane;
    const GAS float* ssq = WSPG(float, WS_SSQ); const GAS float* gn = INP(6);
    f32x4 gv[4];
#pragma unroll
    for (int j = 0; j < 4; ++j) gv[j] = *(const GAS f32x4*)(gn + 4 * lane + 256 * j);
    for (int m0 = gw; m0 < MROWS; m0 += 4 * NGW) {
        v2u w[4][4]; float sv[4];
#pragma unroll
        for (int u = 0; u < 4; ++u) { const int m = m0 + u * NGW; const int mc = m < MROWS ? m : m0; sv[u] = ssq[mc];
            const GAS v2u* xr = (const GAS v2u*)(WSPG(bf16, WS_XB) + (size_t)mc * DM) + lane;
#pragma unroll
            for (int j = 0; j < 4; ++j) w[u][j] = __builtin_nontemporal_load(xr + 64 * j); }
#pragma unroll
        for (int u = 0; u < 4; ++u) { const int m = m0 + u * NGW;
            if (m < MROWS) { const float r = 1.0f / sqrtf(sv[u] * (1.0f / DM) + EPS); GAS f32x4* orow = (GAS f32x4*)(F.out + (size_t)m * DM) + lane;
#pragma unroll
                for (int j = 0; j < 4; ++j) { f32x4 v = (f32x4){hlo(w[u][j].x), hhi(w[u][j].x), hlo(w[u][j].y), hhi(w[u][j].y)}; v = v * r * gv[j]; __builtin_nontemporal_store(v, orow + 64 * j); } } }
    }
}


#ifdef DIS_HGRN
#define HGRN_CALL(...)
#else
#define HGRN_CALL hgrn_unit
#endif
#ifdef DIS_CONV
#define CONV_CALL(...)
#else
#define CONV_CALL conv_tiles
#endif
#ifdef DIS_MOBA
#define MOBA_CALL(...)
#else
#define MOBA_CALL moba_unit
#endif
#ifdef DIS_SGU
#define SGU_CALL(...)
#else
#define SGU_CALL sgu_units
#endif
#ifndef REP_HGRN
#define REP_HGRN 1
#endif
#ifndef REP_CONV
#define REP_CONV 1
#endif
#ifndef REP_MOBA
#define REP_MOBA 1
#endif
#ifndef REP_SGU
#define REP_SGU 1
#endif
#ifndef REP_FFN
#define REP_FFN 1
#endif
#ifndef REP_P0
#define REP_P0 1
#endif
#ifndef GSEL
#define GSEL 0
#endif
#ifdef DIS_GEMM
template <class Epi, class Sched, bool A, bool B> __device__ __forceinline__ void gemm_dummy(LAS unsigned char*, const pg8::Gemm, const Sched&, const Epi&) {}
#define GEMM_CALL gemm_dummy
#else
#define GEMM_CALL pg8::gemm_phase
#endif
__device__ __forceinline__ void sub_barrier(Frame& F, unsigned* cnt, unsigned n) {
    asm volatile("s_waitcnt vmcnt(0)" ::: "memory"); __syncthreads();
    if (F.tid == 0) {
        __threadfence();
        asm volatile("s_waitcnt vmcnt(0)" ::: "memory");
        (void)__hip_atomic_fetch_add(cnt, 1u, __ATOMIC_RELAXED, __HIP_MEMORY_SCOPE_AGENT);
        unsigned sp = 0;
        while (__hip_atomic_load(cnt, __ATOMIC_RELAXED, __HIP_MEMORY_SCOPE_AGENT) < n) { __builtin_amdgcn_s_sleep(2); if (++sp > (1u << 22)) break; }
        __threadfence();
        asm volatile("s_waitcnt vmcnt(0)" ::: "memory");
    }
    __syncthreads();
}
template <int l> __device__ __forceinline__ void layer_phases(Frame& F, const int lo, const int hi, const XcdBarrier& bar, const int vcu) {
#define IN(k) (lo <= (k) && (k) < hi)
#define SEAM(k) do { if (IN(k) && IN((k) + 1)) xcd_barrier(bar); } while (0)
#define PH_ENTER() asm volatile("" : "+s"(F.ws), "+s"(F.out))
#define XB WSP(bf16, WS_XB)
#define BIG WSP(bf16, WS_BIG)
#define MIX WSP(bf16, WS_MIX)
#define QO WSP(bf16, WS_QO)
#define SSQ WSP(float, WS_SSQ)

        constexpr int pb = l == 0 ? 2 : 9;
        if (l == 1) {
            if (IN(8)) { PH_ENTER();
                pg8::Gemm g{XB, WSP(bf16, WS_WIN1), DM, DM, DM}; pg8::StaticOrder S; S.init(MROWS, PW, F.G, F.bid, DM, DM);
                pg8::EpiIn1 E{BIG, SSQ + MROWS, WSP(float, WS_KPART), C2M};
                GEMM_CALL<pg8::EpiIn1, pg8::StaticOrder, true, true>(F.lds, g, S, E);
            } SEAM(8);
        }
        if (IN(pb)) { PH_ENTER();
            if (l == 0) {
                const int nh = F.G > 64 ? 64 : F.G;
                for (int rep = 0; rep < REP_HGRN; ++rep)
                if (F.bid < nh) { for (int u = F.bid; u < 64; u += nh) HGRN_CALL(F, u >> 2, u & 3); }
                for (int rep = 0; rep < REP_CONV; ++rep)
                {   const bool split = F.G > 64; const int g2 = split ? F.G - 64 : F.G, c2 = split ? F.bid - 64 : F.bid;
                    if (c2 >= 0) {
                        CONV_CALL(F, c2, g2);
#pragma unroll 1
                        for (int q = 0; q < 4; ++q) {
                            pg8::Gemm g{WSP(bf16, WS_MEMB), WSP(bf16, (q & 1) ? WS_WV : WS_WK) + (size_t)(q >> 1) * DM * DM, DM, DM, DM}; pg8::StaticOrder S; S.init(MMEM, DM, g2, ((c2 - 64 * q - 128) % g2 + g2) % g2, DM, DM);
                            pg8::EpiK E{WSP(bf16, (q & 1) ? WS_VT : WS_KB) + (size_t)(q >> 1) * MMEM * DM, WSP(float, WS_RMEM)};
                            GEMM_CALL<pg8::EpiK, pg8::StaticOrder, true, true>(F.lds, g, S, E); }
                        convert_rest(F, c2 * NWAVES + F.wave, g2 * NWAVES);
                        sub_barrier(F, (unsigned*)(F.ws + WS_CTL) + 900, (unsigned)g2);
                        {   int k256 = 256; asm volatile("" : "+s"(k256));
                            {   pg8::Gemm g{WSP(bf16, WS_KB), WSP(bf16, WS_WQ), k256, DM, DM}; pg8::SubOrder S{g2, (c2 + 64) % g2, 0};
                                pg8::EpiSub E{QO, 0};
                                GEMM_CALL<pg8::EpiSub, pg8::SubOrder, true, true>(F.lds, g, S, E); }
                            {   pg8::Gemm g{WSP(bf16, WS_WO), WSP(bf16, WS_VT), k256, DM, DM}; pg8::SubOrder S{g2, (c2 + 128) % g2, 1};
                                pg8::EpiSub E{QO + (size_t)16 * DM * DM, 1};
                                GEMM_CALL<pg8::EpiSub, pg8::SubOrder, true, true>(F.lds, g, S, E); }
                            {   pg8::Gemm g{WSP(bf16, WS_KB) + (size_t)MMEM * DM, WSP(bf16, WS_WQ) + (size_t)DM * DM, k256, DM, DM}; pg8::SubOrder S{g2, c2 % g2, 0};
                                pg8::EpiSub E{(bf16*)F.out, 0};
                                GEMM_CALL<pg8::EpiSub, pg8::SubOrder, true, true>(F.lds, g, S, E); }
                            {   pg8::Gemm g{WSP(bf16, WS_WO) + (size_t)DM * DM, WSP(bf16, WS_VT) + (size_t)MMEM * DM, k256, DM, DM}; pg8::SubOrder S{g2, c2 % g2, 1};
                                pg8::EpiSub E{(bf16*)F.out + (size_t)16 * DM * DM, 1};
                                GEMM_CALL<pg8::EpiSub, pg8::SubOrder, true, true>(F.lds, g, S, E); } }
                    } }
            } else {
                for (int rep = 0; rep < REP_MOBA; ++rep)
                for (int p = vcu; p < 512; p += F.G) { const int b = p >> 5, hd = (p >> 2) & 7, pj = p & 3; MOBA_CALL(F, b, hd, 7 - pj); MOBA_CALL(F, b, hd, pj); }
                for (int rep = 0; rep < REP_SGU; ++rep)
                SGU_CALL(F, vcu, F.G);
            }
        } SEAM(pb);
        if (IN(pb + 1)) { PH_ENTER();
            pg8::Gemm g{MIX, WSP(bf16, l == 0 ? WS_WOUT0 : WS_WOUT1), DM, DM, DM}; pg8::StaticOrder S; S.init(MROWS, DM, F.G, F.bid, DM, DM);
            constexpr int j = 1 + 3 * l;
            for (int i = F.bid * (NWAVES * 64) + F.tid; i < MROWS; i += F.G * NWAVES * 64) (SSQ + ((j + 1) & 1) * MROWS)[i] = 0.f;
            pg8::EpiRes E{XB, nullptr, SSQ + (j & 1) * MROWS};
            GEMM_CALL<pg8::EpiRes, pg8::StaticOrder, true, true>(F.lds, g, S, E);
        } SEAM(pb + 1);
        if (IN(pb + 2)) { PH_ENTER();
            pg8::Gemm g{XB, l == 0 ? QO : (bf16*)F.out, DM, DM, DM}; pg8::StaticOrder S; S.init(MROWS, DM, F.G, F.bid, DM, DM, DM);
            pg8::EpiSoftmax E{MIX, SSQ + ((1 + 3 * l) & 1) * MROWS, (LAS float*)(F.lds + RING_BYTES)};
#ifndef DIS_SM
            GEMM_CALL<pg8::EpiSoftmax, pg8::StaticOrder, true, true>(F.lds, g, S, E);
#endif
        } SEAM(pb + 2);
        if (IN(pb + 3)) { PH_ENTER();
            pg8::Gemm g{MIX, (l == 0 ? QO : (bf16*)F.out) + (size_t)16 * DM * DM, DM, DM, DM}; pg8::StaticOrder S; S.init(MROWS, DM, F.G, F.bid, DM, DM, DM);
            constexpr int j = 2 + 3 * l;
            for (int i = F.bid * (NWAVES * 64) + F.tid; i < MROWS; i += F.G * NWAVES * 64) (SSQ + ((j + 1) & 1) * MROWS)[i] = 0.f;
            pg8::EpiRes E{XB, nullptr, SSQ + (j & 1) * MROWS};
            GEMM_CALL<pg8::EpiRes, pg8::StaticOrder, true, true>(F.lds, g, S, E);
        } SEAM(pb + 3);
        if (IN(pb + 4)) { PH_ENTER();
            pg8::Gemm g{XB, WSP(bf16, WS_WFI) + (size_t)l * DM * 2 * FFH, DM, DM, DM}; pg8::StaticOrder S; S.init(MROWS, 2 * FFH, F.G, F.bid, DM, DM);
            pg8::EpiFfn E{BIG, SSQ + ((2 + 3 * l) & 1) * MROWS};
            for (int rep = 0; rep < REP_FFN; ++rep)
            GEMM_CALL<pg8::EpiFfn, pg8::StaticOrder, true, true>(F.lds, g, S, E);
        } SEAM(pb + 4);
        if (IN(pb + 5)) { PH_ENTER();
            pg8::Gemm g{BIG, WSP(bf16, WS_WFO) + (size_t)l * FFH * DM, FFH, FFH, FFH}; pg8::StaticOrder S; S.init(MROWS, DM, F.G, F.bid, FFH, FFH);
            constexpr int j = 3 + 3 * l;
            for (int i = F.bid * (NWAVES * 64) + F.tid; i < MROWS; i += F.G * NWAVES * 64) (SSQ + ((j + 1) & 1) * MROWS)[i] = 0.f;
            pg8::EpiRes E{XB, nullptr, SSQ + (j & 1) * MROWS};
            GEMM_CALL<pg8::EpiRes, pg8::StaticOrder, true, true>(F.lds, g, S, E);
        } SEAM(pb + 5);

#undef IN
#undef SEAM
#undef PH_ENTER
#undef XB
#undef BIG
#undef MIX
#undef QO
#undef SSQ
}

__global__ void __launch_bounds__(NWAVES * 64, 2) fwd_kernel(Args args) {
    extern __shared__ __attribute__((aligned(16))) unsigned char lds[];
    Frame F;
    F.lds = (LAS unsigned char*)lds;
    F.tid = threadIdx.x; F.lane = F.tid & 63; F.wave = __builtin_amdgcn_readfirstlane(F.tid >> 6);
    F.G = gridDim.x; F.bid = blockIdx.x;
    F.ka = (const CAS Args*)__builtin_amdgcn_kernarg_segment_ptr();
    F.out = args.out; F.ws = args.ws;
    const int vcu = (F.G % 8 == 0) ? (F.bid % 8) * (F.G / 8) + F.bid / 8 : F.bid;
    volatile LAS unsigned* MISC = (volatile LAS unsigned*)(F.lds + MISC_OFF);
    for (int u = F.tid; u < (LDS_BYTES - LDSCTL_OFF) / 4; u += NWAVES * 64) ((LAS unsigned*)(F.lds + LDSCTL_OFF))[u] = 0u;
    __syncthreads();
    const int lo = args.ph_lo, hi = args.ph_hi;
    unsigned* barw = (unsigned*)(F.ws + WS_CTL) + CW_BAR;
    XcdBarrier bar; bar.bar = barw; bar.x = 0; bar.st = nullptr;
    if (hi - lo > 1) bar = xcd_barrier_post(barw, MISC + 8);
#define IN(k) (lo <= (k) && (k) < hi)
#define PH_ENTER() asm volatile("" : "+s"(F.ws), "+s"(F.out))
#define SEAM(k) do { if (IN(k) && IN((k) + 1)) xcd_barrier(bar); } while (0)
#define XB WSP(bf16, WS_XB)
#define BIG WSP(bf16, WS_BIG)
#define MIX WSP(bf16, WS_MIX)
#define QO WSP(bf16, WS_QO)
#define SSQ WSP(float, WS_SSQ)

    #ifndef DIS_P0
    for (int rep = 0; rep < REP_P0; ++rep)
    if (IN(0)) { PH_ENTER(); p0_prologue(F); }
#endif
    SEAM(0);

    if (IN(1)) { PH_ENTER();
        pg8::Gemm g{XB, WSP(bf16, WS_WIN0), DM, DM, DM}; pg8::StaticOrder S; S.init(MROWS, 3072, F.G, F.bid, DM, DM);
        pg8::EpiIn0 E{BIG, SSQ, WSP(float, WS_LB)};
        GEMM_CALL<pg8::EpiIn0, pg8::StaticOrder, true, true>(F.lds, g, S, E);
    } SEAM(1);

    layer_phases<0>(F, lo, hi, bar, vcu);
    layer_phases<1>(F, lo, hi, bar, vcu);
    #ifndef DIS_FIN
    if (IN(15)) final_norm(F);
#endif
#undef IN
#undef SEAM
#undef XB
#undef BIG
#undef MIX
#undef QO
#undef SSQ
}

extern "C" void kernel_launch(void* const* d_in, const int* in_sizes, int n_in, void* d_out, int out_size, void* d_ws, size_t ws_size, hipStream_t stream) {
    static int grid = 0;
    if (grid == 0) {
        if (n_in != 26 || in_sizes[0] != MROWS * DM || out_size != MROWS * DM || ws_size < WS_END) {
            fprintf(stderr, "kernel_launch: unexpected shapes (n_in %d, in0 %d, out %d, ws %zu); nothing launched\n", n_in, n_in > 0 ? in_sizes[0] : -1, out_size, ws_size); grid = -1; return; }
        int dev = 0, cus = 0;
        if (hipGetDevice(&dev) != hipSuccess || hipDeviceGetAttribute(&cus, hipDeviceAttributeMultiprocessorCount, dev) != hipSuccess) { fprintf(stderr, "kernel_launch: device query failed\n"); grid = -1; return; }
        if (hipFuncSetAttribute((const void*)fwd_kernel, hipFuncAttributeMaxDynamicSharedMemorySize, LDS_BYTES) != hipSuccess) { fprintf(stderr, "kernel_launch: hipFuncSetAttribute failed\n"); grid = -1; return; }
        (void)hipGetLastError();
        grid = cus > 256 ? 256 : cus;
    }
    if (grid < 0) return;
    (void)hipMemsetAsync((char*)d_ws + WS_CTL, 0, CTL_ZERO_BYTES, stream);
    Args a{};
    for (int i = 0; i < 26; ++i) a.in[i] = (const float*)d_in[i];
    a.out = (float*)d_out; a.ws = (unsigned char*)d_ws;
#if MK_ONE_LAUNCH
    a.ph_lo = 0; a.ph_hi = NPH;
    hipLaunchKernelGGL(fwd_kernel, dim3(grid), dim3(NWAVES * 64), LDS_BYTES, stream, a);
#else
    for (int p = 0; p < NPH; ++p) { a.ph_lo = p; a.ph_hi = p + 1; hipLaunchKernelGGL(fwd_kernel, dim3(grid), dim3(NWAVES * 64), LDS_BYTES, stream, a); }
#endif
}
```

```cpp
#include <hip/hip_runtime.h>
#include <cstdio>
#include <cstdint>
#include <cmath>
namespace pg8 {
#define PG8_LAS __attribute__((address_space(3)))
typedef unsigned short bf16_t;
typedef short bf16x8 __attribute__((ext_vector_type(8)));
typedef float f32x4 __attribute__((ext_vector_type(4)));
typedef unsigned u32x4 __attribute__((ext_vector_type(4)));
typedef __attribute__((address_space(1))) u32x4 gu32x4_t; typedef __attribute__((address_space(1))) f32x4 gf32x4_t;
constexpr int BM = 256, BK = 64, HALF = 128, HTB = HALF * BK * 2  , STAGE_BYTES = 8 * HTB, NXCD = 8, WGM = 8;

__host__ __device__ __forceinline__ int lds_byte(int r, int c) { const int st = (r >> 4) * 2 + (c >> 5), rr = r & 15, cc = c & 31, ob = rr * 64 + cc * 2; return st * 1024 + (ob ^ (((ob >> 9) & 1) << 5)); }
__host__ __device__ __forceinline__ void stage_rc(int b, int& R, int& C) { const int st = b / 1024, sb = b % 1024, swz = sb ^ (((sb >> 9) & 1) << 5); R = (st >> 1) * 16 + swz / 64; C = (st & 1) * 32 + (swz % 64) / 2; }
__host__ __device__ __forceinline__ int perm32(int rho) { const int n = rho >> 4, i = rho & 15; return 8 * (i >> 2) + 4 * n + (i & 3); }

struct Unit { int pm, pn; unsigned aoff, boff; };
struct Gemm { const bf16_t* A; const bf16_t* Bt; int K, lda, ldb; };

struct StaticOrder {
    int nM, nN, nwg, G, c, lda, ldb, bbatch;
    __host__ __device__ void init(int M, int N, int G_, int c_, int lda_, int ldb_, int bbatch_ = 0) { nM = M / BM; nN = N / BM; nwg = nM * nN; G = G_; c = c_; lda = lda_; ldb = ldb_; bbatch = bbatch_; }
    __host__ __device__ bool next(int i, Unit& u) const {
        const long L = (long)i * G + c; if (L >= nwg) return false;
        int wgid = (int)L; { const int q = nwg / NXCD, r = nwg % NXCD, xcd = wgid % NXCD, off = wgid / NXCD; wgid = (xcd < r ? xcd * (q + 1) : r * (q + 1) + (xcd - r) * q) + off; }
        const int nig = WGM * nN, gid = wgid / nig, fm = gid * WGM, gsz = (nM - fm) < WGM ? (nM - fm) : WGM;
        u.pm = fm + ((wgid % nig) % gsz); u.pn = (wgid % nig) / gsz;
        u.aoff = (unsigned)u.pm * (unsigned)(BM * lda); u.boff = ((unsigned)u.pn * BM + (unsigned)(u.pm >> 3) * (unsigned)bbatch) * (unsigned)ldb; return true;
    }
    __device__ __forceinline__ void a_ready(const Unit&) const {}
    __device__ __forceinline__ void done(const Unit&) const {}
};

typedef _Float16 h16x8 __attribute__((ext_vector_type(8))); typedef _Float16 h16x2 __attribute__((ext_vector_type(2))); typedef float f32x2c __attribute__((ext_vector_type(2)));
__device__ __forceinline__ unsigned cvt_pk_bf16(float lo, float hi) { const f32x2c v = {lo, hi}; const h16x2 h = __builtin_convertvector(v, h16x2); return __builtin_bit_cast(unsigned, h); }
typedef float f32x2 __attribute__((ext_vector_type(2)));
__device__ __forceinline__ float fq_sum(float x) { float a = x, b = x; asm("s_nop 1\n\tv_permlane16_swap_b32 %0, %1" : "+v"(a), "+v"(b)); float c = a + b, d = c; asm("s_nop 1\n\tv_permlane32_swap_b32 %0, %1" : "+v"(c), "+v"(d)); return c + d; }
__device__ __forceinline__ float fq_max(float x) { float a = x, b = x; asm("s_nop 1\n\tv_permlane16_swap_b32 %0, %1" : "+v"(a), "+v"(b)); float c = fmaxf(a, b), d = c; asm("s_nop 1\n\tv_permlane32_swap_b32 %0, %1" : "+v"(c), "+v"(d)); return fmaxf(c, d); }
__device__ __forceinline__ f32x2 gelu_pk(f32x2 v) {
    const f32x2 av = __builtin_elementwise_abs(v), d = av * 0.2316418882f + 1.0f;
    f32x2 t; t.x = __builtin_amdgcn_rcpf(d.x); t.y = __builtin_amdgcn_rcpf(d.y);
    f32x2 q = t * 0.5307027145f + (-0.7265760135f); q = q * t + 0.7107068705f; q = q * t + (-0.142248368f); q = q * t + 0.127414796f; q = q * t;
    const f32x2 s = (v * v) * (-0.72134752044f);
    f32x2 e; e.x = __builtin_amdgcn_exp2f(s.x); e.y = __builtin_amdgcn_exp2f(s.y);
    const f32x2 m = v * (q * e), r = v - m;
    f32x2 o; o.x = v.x < 0.f ? m.x : r.x; o.y = v.y < 0.f ? m.y : r.y; return o;
}


constexpr int RM = 32768;
constexpr float EPS_ = 1e-6f, LOG2E_ = 1.4426950408889634f;
__device__ __forceinline__ float sigm(float x) { return __builtin_amdgcn_rcpf(1.0f + __builtin_amdgcn_exp2f(-x * LOG2E_)); }
__device__ __forceinline__ float silu_(float x) { return x * sigm(x); }
__device__ __forceinline__ u32x4 pack8(const f32x4 a, const f32x4 b) { u32x4 w; w.x = cvt_pk_bf16(a[0], a[1]); w.y = cvt_pk_bf16(a[2], a[3]); w.z = cvt_pk_bf16(b[0], b[1]); w.w = cvt_pk_bf16(b[2], b[3]); return w; }
__device__ __forceinline__ void row_sums(const float* ssq, int pm, int wr, int lane, float (&raw)[2]) {
#pragma unroll
    for (int ai = 0; ai < 2; ++ai) raw[ai] = ((const __attribute__((address_space(1))) float*)ssq)[pm * BM + ai * HALF + wr * 64 + lane];
}
__device__ __forceinline__ void row_scales(const float (&raw)[2], float (&v)[2]) {
#pragma unroll
    for (int ai = 0; ai < 2; ++ai) v[ai] = __builtin_amdgcn_rsqf(raw[ai] * (1.0f / 1024.0f) + EPS_);
}
#define ROWSCALE(ai, m) __shfl(rv[ai], 16 * (m) + fr)
#define ROWFENCE() asm volatile("" ::: "memory")
__device__ __forceinline__ f32x2 swiglu_pk(f32x2 a, f32x2 g) {
    const f32x2 t = a * (-LOG2E_); f32x2 e; e.x = __builtin_amdgcn_exp2f(t.x); e.y = __builtin_amdgcn_exp2f(t.y);
    const f32x2 d = e + 1.0f; f32x2 s; s.x = __builtin_amdgcn_rcpf(d.x); s.y = __builtin_amdgcn_rcpf(d.y);
    return (a * g) * s;
}
__device__ __forceinline__ f32x2 swiglu_rs(f32x2 a, f32x2 g, float rc, float r2) {
    const f32x2 t = a * rc; f32x2 e; e.x = __builtin_amdgcn_exp2f(t.x); e.y = __builtin_amdgcn_exp2f(t.y);
    const f32x2 d = e + 1.0f; f32x2 s; s.x = __builtin_amdgcn_rcpf(d.x); s.y = __builtin_amdgcn_rcpf(d.y);
    return ((a * g) * r2) * s;
}
__device__ __forceinline__ f32x2 xsig_pk(f32x2 x, f32x2 y) {
    const f32x2 t = y * (-LOG2E_); f32x2 e; e.x = __builtin_amdgcn_exp2f(t.x); e.y = __builtin_amdgcn_exp2f(t.y);
    const f32x2 d = e + 1.0f; f32x2 s; s.x = __builtin_amdgcn_rcpf(d.x); s.y = __builtin_amdgcn_rcpf(d.y);
    return x * s;
}
__device__ __forceinline__ f32x4 xsig4(const f32x4 x, const f32x4 y) { const f32x2 lo = xsig_pk((f32x2){x[0], x[1]}, (f32x2){y[0], y[1]}), hi = xsig_pk((f32x2){x[2], x[3]}, (f32x2){y[2], y[3]}); return (f32x4){lo.x, lo.y, hi.x, hi.y}; }
struct EpiIn0 {
    static constexpr bool PERM = true, AFTER_DRAIN = false, PRE = true;
    bf16_t* P; const float* ssq; const float* lb;
    __device__ __forceinline__ void pre(const Unit& u, int wr, int lane, float (&raw)[2]) const { row_sums(ssq, u.pm, wr, lane, raw); }
    __device__ __forceinline__ void operator()(const f32x4 (&acc)[2][2][4][2], const Unit& u, int wr, int wc, int fr, int fq, const float (&raw)[2]) const {
        float rv[2]; row_scales(raw, rv);
        const int row0 = u.pm * BM + wr * 64 + fr, pn = u.pn;
        if (pn < 8) {
            const int typ = pn >> 1;
#pragma unroll
            for (int bj = 0; bj < 2; ++bj) { const int col0 = pn * BM + bj * HALF + wc * 32 + 8 * fq;
                f32x4 l0 = (f32x4){0.f, 0.f, 0.f, 0.f}, l1 = l0;
                if (typ == 1) { l0 = 1.0f - *(const gf32x4_t*)(lb + col0 - 512); l1 = 1.0f - *(const gf32x4_t*)(lb + col0 - 508); }
#pragma unroll
                for (int ai = 0; ai < 2; ++ai)
#pragma unroll
                    for (int m = 0; m < 4; ++m) { const float r = ROWSCALE(ai, m); f32x4 v0 = acc[ai][bj][m][0] * r, v1 = acc[ai][bj][m][1] * r;
                        if (typ == 0 || typ == 3) { v0 = xsig4(v0, v0); v1 = xsig4(v1, v1); }
                        else if (typ == 1) { v0 = xsig4(l0, -v0); v1 = xsig4(l1, -v1); }
                        *(gu32x4_t*)(P + (size_t)(row0 + ai * HALF + m * 16) * 2560 + col0) = pack8(v0, v1); ROWFENCE(); } }
        } else {
            const int col0 = 2048 + (pn - 8) * HALF + wc * 32 + 8 * fq;
#pragma unroll
            for (int ai = 0; ai < 2; ++ai)
#pragma unroll
                for (int m = 0; m < 4; ++m) { const float r = ROWSCALE(ai, m);
                    const f32x4 v0 = xsig4(acc[ai][0][m][0] * r, acc[ai][1][m][0] * r), v1 = xsig4(acc[ai][0][m][1] * r, acc[ai][1][m][1] * r);
                    *(gu32x4_t*)(P + (size_t)(row0 + ai * HALF + m * 16) * 2560 + col0) = pack8(v0, v1); ROWFENCE(); }
        }
    }
};
struct EpiIn1 {
    static constexpr bool PERM = true, AFTER_DRAIN = false, PRE = true;
    bf16_t* P; const float* ssq; float* kpart; float qscale;
    __device__ __forceinline__ void pre(const Unit& u, int wr, int lane, float (&raw)[2]) const { row_sums(ssq, u.pm, wr, lane, raw); }
    __device__ __forceinline__ void operator()(const f32x4 (&acc)[2][2][4][2], const Unit& u, int wr, int wc, int fr, int fq, const float (&raw)[2]) const {
        float rv[2]; row_scales(raw, rv);
        const int row0 = u.pm * BM + wr * 64 + fr, pn = u.pn;
        const int typ = pn < 2 ? 0 : (pn < 4 ? 1 : (pn < 6 ? 2 : 3));
#pragma unroll
        for (int bj = 0; bj < 2; ++bj) { const int col0 = pn * BM + bj * HALF + wc * 32 + 8 * fq;
            f32x4 cs0 = (f32x4){0.f, 0.f, 0.f, 0.f}, cs1 = cs0;
#pragma unroll
            for (int ai = 0; ai < 2; ++ai)
#pragma unroll
                for (int m = 0; m < 4; ++m) { const float r = ROWSCALE(ai, m); f32x4 v0 = acc[ai][bj][m][0] * r, v1 = acc[ai][bj][m][1] * r;
                    if (typ == 0) { v0 = v0 * qscale; v1 = v1 * qscale; }
                    else if (typ == 1) { cs0 += v0; cs1 += v1; }
                    else if (typ == 3) { f32x2 a = gelu_pk((f32x2){v0[0], v0[1]}), b = gelu_pk((f32x2){v0[2], v0[3]}), c = gelu_pk((f32x2){v1[0], v1[1]}), d = gelu_pk((f32x2){v1[2], v1[3]});
                        v0 = (f32x4){a.x, a.y, b.x, b.y}; v1 = (f32x4){c.x, c.y, d.x, d.y}; }
                    *(gu32x4_t*)(P + (size_t)(row0 + ai * HALF + m * 16) * 2560 + col0) = pack8(v0, v1); ROWFENCE(); }
            if (typ == 1) {
#pragma unroll
                for (int i = 0; i < 4; ++i) {
#pragma unroll
                    for (int o = 1; o < 16; o <<= 1) { cs0[i] += __shfl_xor(cs0[i], o); cs1[i] += __shfl_xor(cs1[i], o); } }
                if (fr == 0) { float* kp = kpart + (size_t)(u.pm * 2 + wr) * 512 + (col0 - 512); *(gf32x4_t*)kp = cs0; *(gf32x4_t*)(kp + 4) = cs1; }
            } }
    }
};
struct EpiRes {
    static constexpr bool PERM = true, AFTER_DRAIN = false, PRE = false;
    bf16_t* xb; float* outf; float* ssqw;
    static __device__ __forceinline__ float hadd_lo(unsigned w, float c) { float d; asm("v_fma_mix_f32 %0, %1, 1.0, %2 op_sel_hi:[1,0,0]" : "=v"(d) : "v"(w), "v"(c)); return d; }
    static __device__ __forceinline__ float hadd_hi(unsigned w, float c) { float d; asm("v_fma_mix_f32 %0, %1, 1.0, %2 op_sel:[1,0,0] op_sel_hi:[1,0,0]" : "=v"(d) : "v"(w), "v"(c)); return d; }
    __device__ __forceinline__ void operator()(const f32x4 (&acc)[2][2][4][2], const Unit& u, int wr, int wc, int fr, int fq) const {
        typedef __attribute__((address_space(1))) u32x4 gu32x4;
        const int row0 = u.pm * BM + wr * 64 + fr;
#pragma unroll
        for (int ai = 0; ai < 2; ++ai)
#pragma unroll
            for (int m = 0; m < 4; ++m) { const int row = row0 + ai * HALF + m * 16; float ss = 0.f, s2 = 0.f;
#pragma unroll
                for (int bj = 0; bj < 2; ++bj) { const size_t off = (size_t)row * 1024 + u.pn * BM + bj * HALF + wc * 32 + 8 * fq;
                    const u32x4 b = *(const gu32x4*)(xb + off);
                    const f32x4 a0 = acc[ai][bj][m][0], a1 = acc[ai][bj][m][1];
                    const f32x4 v0 = (f32x4){hadd_lo(b.x, a0[0]), hadd_hi(b.x, a0[1]), hadd_lo(b.y, a0[2]), hadd_hi(b.y, a0[3])};
                    const f32x4 v1 = (f32x4){hadd_lo(b.z, a1[0]), hadd_hi(b.z, a1[1]), hadd_lo(b.w, a1[2]), hadd_hi(b.w, a1[3])};
#pragma unroll
                    for (int e = 0; e < 4; ++e) { ss = __builtin_fmaf(v0[e], v0[e], ss); s2 = __builtin_fmaf(v1[e], v1[e], s2); }
                    *(gu32x4*)(xb + off) = pack8(v0, v1); }
                ss += s2;
                ss = fq_sum(ss);
                if (fq == 0) atomicAdd(ssqw + row, ss);
                ROWFENCE(); }
    }
};
struct EpiFfn {
    static constexpr bool PERM = true, AFTER_DRAIN = false, PRE = true;
    bf16_t* H; const float* ssq;
    __device__ __forceinline__ void pre(const Unit& u, int wr, int lane, float (&raw)[2]) const { row_sums(ssq, u.pm, wr, lane, raw); }
    __device__ __forceinline__ void operator()(const f32x4 (&acc)[2][2][4][2], const Unit& u, int wr, int wc, int fr, int fq, const float (&raw)[2]) const {
        float rv[2]; row_scales(raw, rv);
        const int row0 = u.pm * BM + wr * 64 + fr, col0 = u.pn * HALF + wc * 32 + 8 * fq;
#pragma unroll
        for (int ai = 0; ai < 2; ++ai)
#pragma unroll
            for (int m = 0; m < 4; ++m) { const float r = ROWSCALE(ai, m), rc = -r * LOG2E_, r2 = r * r;
                const f32x4 a0 = acc[ai][0][m][0], a1 = acc[ai][0][m][1], g0 = acc[ai][1][m][0], g1 = acc[ai][1][m][1];
                const f32x2 p0 = swiglu_rs((f32x2){a0[0], a0[1]}, (f32x2){g0[0], g0[1]}, rc, r2), p1 = swiglu_rs((f32x2){a0[2], a0[3]}, (f32x2){g0[2], g0[3]}, rc, r2),
                            p2 = swiglu_rs((f32x2){a1[0], a1[1]}, (f32x2){g1[0], g1[1]}, rc, r2), p3 = swiglu_rs((f32x2){a1[2], a1[3]}, (f32x2){g1[2], g1[3]}, rc, r2);
                *(gu32x4_t*)(H + (size_t)(row0 + ai * HALF + m * 16) * 2816 + col0) = pack8((f32x4){p0.x, p0.y, p1.x, p1.y}, (f32x4){p2.x, p2.y, p3.x, p3.y}); ROWFENCE(); }
    }
};
struct SubOrder {
    int G, c, mode;
    __device__ __forceinline__ bool next(int i, Unit& u) const {
        const int L = i * G + c; if (L >= 256) return false;
        const unsigned b = L >> 4, h = (L >> 2) & 3, t = L & 3; u.pm = L; u.pn = 0;
        const unsigned x = (b * 256u) * 1024u + h * 256u, y = (t * 256u) * 1024u + h * 256u;
        u.aoff = mode == 0 ? x : y; u.boff = mode == 0 ? y : x; return true;
    }
    __device__ __forceinline__ void a_ready(const Unit&) const {}
    __device__ __forceinline__ void done(const Unit&) const {}
};
struct EpiSub {
    static constexpr bool PERM = true, AFTER_DRAIN = false, PRE = false;
    bf16_t* O; int mode;
    __device__ __forceinline__ void operator()(const f32x4 (&acc)[2][2][4][2], const Unit& u, int wr, int wc, int fr, int fq) const {
        const int L = u.pm, b = L >> 4, h = (L >> 2) & 3, t = L & 3;
        const int rb = b * 1024 + (mode == 0 ? h : t) * 256 + wr * 64 + fr, cb = (mode == 0 ? t : h) * 256 + wc * 32 + 8 * fq;
#pragma unroll
        for (int ai = 0; ai < 2; ++ai)
#pragma unroll
            for (int m = 0; m < 4; ++m)
#pragma unroll
                for (int bj = 0; bj < 2; ++bj) *(gu32x4_t*)(O + (size_t)(rb + ai * HALF + m * 16) * 1024 + cb + bj * HALF) = pack8(acc[ai][bj][m][0], acc[ai][bj][m][1]);
    }
};
struct EpiSoftmax {
    static constexpr bool PERM = true, AFTER_DRAIN = false, PRE = true;
    bf16_t* P; const float* ssq; PG8_LAS float* scr;
    __device__ __forceinline__ void pre(const Unit& u, int wr, int lane, float (&raw)[2]) const { row_sums(ssq, u.pm, wr, lane, raw); }
    __device__ __forceinline__ void operator()(f32x4 (&acc)[2][2][4][2], const Unit& u, int wr, int wc, int fr, int fq, const float (&raw)[2]) const {
        float rv[2]; row_scales(raw, rv);
        PG8_LAS float* MX = scr; PG8_LAS float* SM = scr + 1024;
        float mx[2][4];
#pragma unroll
        for (int ai = 0; ai < 2; ++ai)
#pragma unroll
            for (int m = 0; m < 4; ++m) { const float r = ROWSCALE(ai, m); float v = -3.0e38f;
#pragma unroll
                for (int bj = 0; bj < 2; ++bj)
#pragma unroll
                    for (int n = 0; n < 2; ++n) { acc[ai][bj][m][n] = acc[ai][bj][m][n] * r; const f32x4 x = acc[ai][bj][m][n]; v = fmaxf(v, fmaxf(fmaxf(x[0], x[1]), fmaxf(x[2], x[3]))); }
                v = fq_max(v);
                if (fq == 0) MX[(ai * HALF + wr * 64 + m * 16 + fr) * 4 + wc] = v; }
        asm volatile("s_waitcnt lgkmcnt(0)" ::: "memory"); __builtin_amdgcn_s_barrier(); asm volatile("" ::: "memory");
#pragma unroll
        for (int ai = 0; ai < 2; ++ai)
#pragma unroll
            for (int m = 0; m < 4; ++m) { const f32x4 q = *(const PG8_LAS f32x4*)(MX + (ai * HALF + wr * 64 + m * 16 + fr) * 4); const float mm = fmaxf(fmaxf(q[0], q[1]), fmaxf(q[2], q[3])); float sm = 0.f;
#pragma unroll
                for (int bj = 0; bj < 2; ++bj)
#pragma unroll
                    for (int n = 0; n < 2; ++n) { f32x4 x = acc[ai][bj][m][n];
#pragma unroll
                        for (int i = 0; i < 4; ++i) { x[i] = __builtin_amdgcn_exp2f(x[i] - mm); sm += x[i]; }
                        acc[ai][bj][m][n] = x; }
                sm = fq_sum(sm);
                if (fq == 0) SM[(ai * HALF + wr * 64 + m * 16 + fr) * 4 + wc] = sm; }
        asm volatile("s_waitcnt lgkmcnt(0)" ::: "memory"); __builtin_amdgcn_s_barrier(); asm volatile("" ::: "memory");
        const int row0 = u.pm * BM + wr * 64 + fr;
#pragma unroll
        for (int ai = 0; ai < 2; ++ai)
#pragma unroll
            for (int m = 0; m < 4; ++m) { const f32x4 q = *(const PG8_LAS f32x4*)(SM + (ai * HALF + wr * 64 + m * 16 + fr) * 4); const float inv = __builtin_amdgcn_rcpf((q[0] + q[1]) + (q[2] + q[3]));
#pragma unroll
                for (int bj = 0; bj < 2; ++bj) *(gu32x4_t*)(P + (size_t)(row0 + ai * HALF + m * 16) * 1024 + u.pn * BM + bj * HALF + wc * 32 + 8 * fq) = pack8(acc[ai][bj][m][0] * inv, acc[ai][bj][m][1] * inv);
                ROWFENCE(); }
    }
};
struct EpiK {
    static constexpr bool PERM = true, AFTER_DRAIN = false, PRE = false;
    bf16_t* O; const float* rmem;
    __device__ __forceinline__ void operator()(const f32x4 (&acc)[2][2][4][2], const Unit& u, int wr, int wc, int fr, int fq) const {
        const int row0 = u.pm * BM + wr * 64 + fr;
#pragma unroll
        for (int ai = 0; ai < 2; ++ai)
#pragma unroll
            for (int m = 0; m < 4; ++m) { const int row = row0 + ai * HALF + m * 16; const float r = rmem[row];
#pragma unroll
                for (int bj = 0; bj < 2; ++bj) *(gu32x4_t*)(O + (size_t)row * 1024 + u.pn * BM + bj * HALF + wc * 32 + 8 * fq) = pack8(acc[ai][bj][m][0] * r, acc[ai][bj][m][1] * r); }
    }
};
template <class Epi, class Sched, bool ALIGN_EPI = false, bool SP2 = false>
__device__ __forceinline__ void gemm_phase(PG8_LAS unsigned char* lds, const Gemm g, const Sched& S, const Epi& E) {
    int tid_ = threadIdx.x; asm volatile("" : "+v"(tid_));
    const int tid = tid_, wid = __builtin_amdgcn_readfirstlane(tid >> 6), lane = tid & 63, wr = wid >> 2, wc = wid & 3, fr = lane & 15, fq = lane >> 4;
    const int K = g.K, nt = K / BK;
    unsigned voffA[2], voffB[2];
#pragma unroll
    for (int i = 0; i < 2; ++i) { int R, C; stage_rc(tid * 16 + i * 8192, R, C); const int Rb = Epi::PERM ? ((R & ~31) + perm32(R & 31)) : R;
        voffA[i] = (unsigned)(R * g.lda + C) * 2u; voffB[i] = (unsigned)(Rb * g.ldb + C) * 2u; }
    const size_t kstep = (size_t)(BK * 2);
    const size_t hstepA = (size_t)HALF * g.lda * 2, hstepB = (size_t)HALF * g.ldb * 2;
    const unsigned ldsw = (unsigned)wid * 1024u;
    const int aoff = lds_byte(wr * 64 + fr, fq * 8), boff = lds_byte(wc * 32 + fr, fq * 8);
#define PG8_SA(b, h) (((b) * 2 + (h)) * HTB)
#define PG8_SB(b, h) ((4 + (b) * 2 + (h)) * HTB)
#define PG8_STAGE(bufoff, gbase, voff) do { _Pragma("unroll") for (int _i = 0; _i < 2; ++_i) \
        __builtin_amdgcn_global_load_lds((const unsigned*)((const char*)(gbase) + (voff)[_i]), (PG8_LAS unsigned*)(lds + (bufoff) + ldsw + _i * 8192), 16, 0, 0); } while (0)
#define PG8_LDA(dst, b, h) do { _Pragma("unroll") for (int m = 0; m < 4; ++m) _Pragma("unroll") for (int k = 0; k < 2; ++k) dst[m][k] = *(const PG8_LAS bf16x8*)(lds + PG8_SA(b, h) + aoff + m * 2048 + k * 1024); } while (0)
#define PG8_LDB(dst, b, h) do { _Pragma("unroll") for (int n = 0; n < 2; ++n) _Pragma("unroll") for (int k = 0; k < 2; ++k) dst[n][k] = *(const PG8_LAS bf16x8*)(lds + PG8_SB(b, h) + boff + n * 2048 + k * 1024); } while (0)
#define PG8_MMA(ai, bj, At, Bt) do { __builtin_amdgcn_s_setprio(1); _Pragma("unroll") for (int m = 0; m < 4; ++m) _Pragma("unroll") for (int n = 0; n < 2; ++n) _Pragma("unroll") for (int k = 0; k < 2; ++k) \
        acc[ai][bj][m][n] = __builtin_amdgcn_mfma_f32_16x16x32_f16(__builtin_bit_cast(h16x8, Bt[n][k]), __builtin_bit_cast(h16x8, At[m][k]), acc[ai][bj][m][n], 0, 0, 0); __builtin_amdgcn_s_setprio(0); } while (0)
#define PG8_WAIT_V(n) asm volatile("s_waitcnt vmcnt(" #n ")" ::: "memory")
#define PG8_WAIT_L(n) asm volatile("s_waitcnt lgkmcnt(" #n ")" ::: "memory")
#define PG8_BAR __builtin_amdgcn_s_barrier()
#define PG8_SCHED __builtin_amdgcn_sched_barrier(0)
    Unit cur, nxt; int ui = 0;
    if (!S.next(0, cur)) return;
    f32x4 acc[2][2][4][2];
#pragma unroll
    for (int a = 0; a < 2; ++a)
#pragma unroll
        for (int b = 0; b < 2; ++b)
#pragma unroll
            for (int m = 0; m < 4; ++m)
#pragma unroll
                for (int n = 0; n < 2; ++n) acc[a][b][m][n] = (f32x4){0.f, 0.f, 0.f, 0.f};
    bf16x8 At[4][2], B0[2][2], B1[2][2];
    const char* cA = (const char*)g.A + (size_t)cur.aoff * 2; const char* cB = (const char*)g.Bt + (size_t)cur.boff * 2;
    float raw[2] = {0.f, 0.f};
    if constexpr (Epi::PRE) E.pre(cur, wr, lane, raw);
    S.a_ready(cur);
    if constexpr (SP2) {
        PG8_STAGE(PG8_SB(0, 0), cB, voffB); PG8_STAGE(PG8_SB(0, 1), cB + hstepB, voffB); PG8_STAGE(PG8_SA(0, 0), cA, voffA); PG8_STAGE(PG8_SA(0, 1), cA + hstepA, voffA);
        if (wr == 1) PG8_BAR;
        PG8_WAIT_V(2); PG8_BAR;
        PG8_STAGE(PG8_SB(1, 0), cB + kstep, voffB); PG8_STAGE(PG8_SA(1, 0), cA + kstep, voffA); PG8_STAGE(PG8_SB(1, 1), cB + hstepB + kstep, voffB);
        PG8_WAIT_V(6); PG8_BAR;
    } else {
        PG8_STAGE(PG8_SB(0, 0), cB, voffB); PG8_STAGE(PG8_SA(0, 0), cA, voffA); PG8_STAGE(PG8_SB(0, 1), cB + hstepB, voffB); PG8_STAGE(PG8_SA(0, 1), cA + hstepA, voffA);
        if (wr == 1) PG8_BAR;
        PG8_WAIT_V(4); PG8_BAR;
        PG8_STAGE(PG8_SB(1, 0), cB + kstep, voffB); PG8_STAGE(PG8_SA(1, 0), cA + kstep, voffA); PG8_STAGE(PG8_SB(1, 1), cB + hstepB + kstep, voffB);
        PG8_WAIT_V(6); PG8_BAR;
    }
    for (;;) {
        const bool has_next = S.next(ui + 1, nxt);
        const char* nA = has_next ? (const char*)g.A + (size_t)nxt.aoff * 2 : cA; const char* nB = has_next ? (const char*)g.Bt + (size_t)nxt.boff * 2 : cB;
        for (int t = 0; t < nt; t += 2) {
            const bool last = (t == nt - 2);
            const char* a1 = cA + (size_t)(t + 1) * kstep;
            const char* a2 = last ? nA : cA + (size_t)(t + 2) * kstep; const char* b2 = last ? nB : cB + (size_t)(t + 2) * kstep;
            const char* a3 = a2 + kstep; const char* b3 = b2 + kstep;
            if (last && has_next) S.a_ready(nxt);
            if constexpr (SP2) {
            PG8_LDB(B0, 0, 0); PG8_LDB(B1, 0, 1); PG8_SCHED; PG8_LDA(At, 0, 0); PG8_STAGE(PG8_SA(1, 1), a1 + hstepA, voffA);
            PG8_WAIT_V(8); PG8_WAIT_L(0); PG8_BAR; PG8_MMA(0, 0, At, B0); PG8_MMA(0, 1, At, B1); PG8_BAR; PG8_SCHED;
            PG8_LDA(At, 0, 1); PG8_STAGE(PG8_SB(0, 0), b2, voffB); PG8_STAGE(PG8_SB(0, 1), b2 + hstepB, voffB); PG8_STAGE(PG8_SA(0, 0), a2, voffA);
            PG8_WAIT_V(8); PG8_WAIT_L(0); PG8_BAR; PG8_MMA(1, 0, At, B0); PG8_MMA(1, 1, At, B1); PG8_BAR; PG8_SCHED;
            PG8_LDB(B0, 1, 0); PG8_LDB(B1, 1, 1); PG8_SCHED; PG8_LDA(At, 1, 0); PG8_STAGE(PG8_SA(0, 1), a2 + hstepA, voffA);
            PG8_WAIT_V(8); PG8_WAIT_L(0); PG8_BAR; PG8_MMA(0, 0, At, B0); PG8_MMA(0, 1, At, B1); PG8_BAR; PG8_SCHED;
            PG8_LDA(At, 1, 1); PG8_STAGE(PG8_SB(1, 0), b3, voffB); PG8_STAGE(PG8_SB(1, 1), b3 + hstepB, voffB); PG8_STAGE(PG8_SA(1, 0), a3, voffA);
            PG8_WAIT_V(8); PG8_WAIT_L(0); PG8_BAR; PG8_MMA(1, 0, At, B0); PG8_MMA(1, 1, At, B1); PG8_BAR; PG8_SCHED;
            } else {
            PG8_LDB(B0, 0, 0); PG8_SCHED; PG8_LDA(At, 0, 0); PG8_STAGE(PG8_SA(1, 1), a1 + hstepA, voffA);
            PG8_WAIT_L(8); PG8_BAR; PG8_WAIT_L(0); PG8_MMA(0, 0, At, B0); PG8_BAR; PG8_SCHED;
            PG8_LDB(B1, 0, 1); PG8_STAGE(PG8_SB(0, 0), b2, voffB);
            PG8_BAR; PG8_WAIT_L(0); PG8_MMA(0, 1, At, B1); PG8_BAR;
            PG8_LDA(At, 0, 1); PG8_STAGE(PG8_SA(0, 0), a2, voffA);
            PG8_BAR; PG8_WAIT_L(0); PG8_MMA(1, 0, At, B0); PG8_BAR; PG8_SCHED;
            PG8_STAGE(PG8_SB(0, 1), b2 + hstepB, voffB);
            PG8_WAIT_V(6); PG8_BAR; PG8_MMA(1, 1, At, B1); PG8_BAR;
            PG8_LDB(B0, 1, 0); PG8_SCHED; PG8_LDA(At, 1, 0); PG8_STAGE(PG8_SA(0, 1), a2 + hstepA, voffA);
            PG8_WAIT_L(8); PG8_BAR; PG8_WAIT_L(0); PG8_MMA(0, 0, At, B0); PG8_BAR; PG8_SCHED;
            PG8_LDB(B1, 1, 1); PG8_STAGE(PG8_SB(1, 0), b3, voffB);
            PG8_BAR; PG8_WAIT_L(0); PG8_MMA(0, 1, At, B1); PG8_BAR;
            PG8_LDA(At, 1, 1); PG8_STAGE(PG8_SA(1, 0), a3, voffA);
            PG8_BAR; PG8_WAIT_L(0); PG8_MMA(1, 0, At, B0); PG8_BAR; PG8_SCHED;
            PG8_STAGE(PG8_SB(1, 1), b3 + hstepB, voffB);
            PG8_WAIT_V(6); PG8_BAR; PG8_MMA(1, 1, At, B1); PG8_BAR;
            }
        }
        if constexpr (ALIGN_EPI) { if (wr == 0) PG8_BAR; }
        if constexpr (!Epi::AFTER_DRAIN) { if constexpr (Epi::PRE) E(acc, cur, wr, wc, fr, fq, raw); else E(acc, cur, wr, wc, fr, fq); S.done(cur); }
        if (!has_next) break;
#pragma unroll
        for (int a = 0; a < 2; ++a)
#pragma unroll
            for (int b = 0; b < 2; ++b)
#pragma unroll
                for (int m = 0; m < 4; ++m)
#pragma unroll
                    for (int n = 0; n < 2; ++n) acc[a][b][m][n] = (f32x4){0.f, 0.f, 0.f, 0.f};
        cur = nxt; cA = nA; cB = nB; ++ui;
        if constexpr (Epi::PRE) E.pre(cur, wr, lane, raw);
        if constexpr (ALIGN_EPI) { if (wr == 1) PG8_BAR; }
    }
    PG8_WAIT_V(0);
    if constexpr (!ALIGN_EPI) { if (wr == 0) PG8_BAR; }
    PG8_BAR;
    if constexpr (Epi::AFTER_DRAIN) { E.fused(acc, cur, wr, wc, fr, fq, lds, wid, lane); S.done(cur); }
#undef PG8_SA
#undef PG8_SB
#undef PG8_STAGE
#undef PG8_LDA
#undef PG8_LDB
#undef PG8_MMA
#undef PG8_WAIT_V
#undef PG8_WAIT_L
#undef PG8_BAR
#undef PG8_SCHED
}
}

constexpr int NWAVES = 8;
constexpr int BATCH = 16, SEQ = 2048, DM = 1024, MROWS = BATCH * SEQ, MEMLEN = 256, MMEM = BATCH * MEMLEN, FFH = 2816, PW = 2560;
constexpr float EPS = 1e-6f, LOG2E = 1.4426950408889634f;
constexpr float C2M = 0.125f * LOG2E;
constexpr float C2X = 0.0625f * LOG2E;
constexpr float NEGBIG = -1.0e30f;
constexpr int NPH = 16;
#ifndef MK_ONE_LAUNCH
#define MK_ONE_LAUNCH 1
#endif

constexpr size_t MiB = 1u << 20;
constexpr size_t WS_CTL = 0, CTL_ZERO_BYTES = 64 * 1024;
constexpr size_t WS_LB = 1 * MiB, WS_RMEM = 1 * MiB + 4096, WS_SGUW = 1 * MiB + 65536, WS_KPART = 1 * MiB + 512 * 1024;
constexpr size_t WS_SSQ = 2 * MiB;
constexpr size_t WS_WIN0 = 4 * MiB, WS_WOUT0 = 10 * MiB, WS_WIN1 = 12 * MiB, WS_WOUT1 = 17 * MiB, WS_WQ = 19 * MiB, WS_WO = 23 * MiB, WS_WK = 27 * MiB, WS_WV = 31 * MiB,
                 WS_WFI = 35 * MiB, WS_WFO = 57 * MiB;
constexpr size_t WS_MEMB = 68 * MiB, WS_KB = 76 * MiB, WS_VT = 92 * MiB;
constexpr size_t WS_XB = 112 * MiB, WS_BIG = 176 * MiB, WS_MIX = 352 * MiB, WS_QO = 416 * MiB, WS_END = 480 * MiB;
constexpr int CW_BAR = 1024;

constexpr int RING_BYTES = 131072, LDS_BYTES = 147456, LDSCTL_OFF = LDS_BYTES - 512, MISC_OFF = LDSCTL_OFF;

#define GAS __attribute__((address_space(1)))
#define LAS __attribute__((address_space(3)))
typedef unsigned short bf16;
typedef unsigned v4u __attribute__((ext_vector_type(4)));
typedef unsigned v2u __attribute__((ext_vector_type(2)));
typedef float f32x4 __attribute__((ext_vector_type(4)));
typedef float f32x16 __attribute__((ext_vector_type(16)));
typedef short bf16x8 __attribute__((ext_vector_type(8)));
typedef short s16x4 __attribute__((ext_vector_type(4)));
typedef GAS unsigned gu32;
#define LDS_WAIT() asm volatile("s_waitcnt lgkmcnt(0)" ::: "memory")
#define VM_WAIT() asm volatile("s_waitcnt vmcnt(0)" ::: "memory")
__device__ __forceinline__ float bf2f(unsigned short b) { return __uint_as_float(((unsigned)b) << 16); }
__device__ __forceinline__ float bflo(unsigned w) { return __uint_as_float(w << 16); }
__device__ __forceinline__ float bfhi(unsigned w) { return __uint_as_float(w & 0xffff0000u); }
typedef float f32x2_t __attribute__((ext_vector_type(2))); typedef __bf16 bf16x2_t __attribute__((ext_vector_type(2)));
__device__ __forceinline__ unsigned pk2(float lo, float hi) { f32x2_t v = {lo, hi}; bf16x2_t b = __builtin_convertvector(v, bf16x2_t); return __builtin_bit_cast(unsigned, b); }
typedef _Float16 h16x8 __attribute__((ext_vector_type(8))); typedef _Float16 h16x2 __attribute__((ext_vector_type(2)));
__device__ __forceinline__ unsigned pk2h(float lo, float hi) { f32x2_t v = {lo, hi}; h16x2 h = __builtin_convertvector(v, h16x2); return __builtin_bit_cast(unsigned, h); }
__device__ __forceinline__ float h2f(unsigned short b) { return (float)__builtin_bit_cast(_Float16, b); }
__device__ __forceinline__ float hlo(unsigned w) { return (float)__builtin_bit_cast(h16x2, w)[0]; }
__device__ __forceinline__ float hhi(unsigned w) { return (float)__builtin_bit_cast(h16x2, w)[1]; }
__device__ __forceinline__ float fmax_nn(float a, float b) { return __builtin_elementwise_maximum(a, b); }
__device__ __forceinline__ float x32_max(float x) { float a = x, b = x; asm("s_nop 1\n\tv_permlane32_swap_b32 %0, %1" : "+v"(a), "+v"(b)); return fmax_nn(a, b); }
__device__ __forceinline__ float x32_sum(float x) { float a = x, b = x; asm("s_nop 1\n\tv_permlane32_swap_b32 %0, %1" : "+v"(a), "+v"(b)); return a + b; }
__device__ __forceinline__ float fexp2(float x) { return __builtin_amdgcn_exp2f(x); }
__device__ __forceinline__ float fexp(float x) { return __builtin_amdgcn_exp2f(x * LOG2E); }
__device__ __forceinline__ float sigm(float x) { return __builtin_amdgcn_rcpf(1.0f + __builtin_amdgcn_exp2f(-x * LOG2E)); }
__device__ __forceinline__ float wave_sum(float v) {
#pragma unroll
    for (int o = 1; o < 64; o <<= 1) v += __shfl_xor(v, o);
    return v;
}
#define MFMA32(a, b, c) __builtin_amdgcn_mfma_f32_32x32x16_bf16((a), (b), (c), 0, 0, 0)
#define MFMA32H(a, b, c) __builtin_amdgcn_mfma_f32_32x32x16_f16(__builtin_bit_cast(h16x8, (a)), __builtin_bit_cast(h16x8, (b)), (c), 0, 0, 0)
__device__ __forceinline__ bf16x8 ldsfrag(const LAS unsigned char* p) { return *(const LAS bf16x8*)p; }
__device__ __forceinline__ bf16x8 ldsfrag2(const LAS unsigned char* p0, const LAS unsigned char* p1) {
    const s16x4 lo = *(const LAS s16x4*)p0, hi = *(const LAS s16x4*)p1;
    return (bf16x8){lo[0], lo[1], lo[2], lo[3], hi[0], hi[1], hi[2], hi[3]};
}
__device__ __forceinline__ bf16x8 packfrag(const f32x16& p, int s2) {
    v4u w; w.x = pk2h(p[8 * s2 + 0], p[8 * s2 + 1]); w.y = pk2h(p[8 * s2 + 2], p[8 * s2 + 3]); w.z = pk2h(p[8 * s2 + 4], p[8 * s2 + 5]); w.w = pk2h(p[8 * s2 + 6], p[8 * s2 + 7]);
    return __builtin_bit_cast(bf16x8, w);
}
template <int NKS, bool H = false> __device__ __forceinline__ void mma_lds(f32x16& acc, const LAS unsigned char* pa, const LAS unsigned char* pb) {
    bf16x8 fa[NKS], fb[NKS];
#pragma unroll
    for (int ks = 0; ks < NKS; ++ks) { fa[ks] = ldsfrag(pa + ks * 32); fb[ks] = ldsfrag(pb + ks * 32); }
#pragma unroll
    for (int ks = 0; ks < NKS; ++ks) { if constexpr (H) acc = MFMA32H(fa[ks], fb[ks], acc); else acc = MFMA32(fa[ks], fb[ks], acc); }
}
#define XB_TMO      128
#define XB_XCNT(j)  (256  + 64 * (j))
#define XB_XSUB(j)  (1280 + 64 * (j))
#define XB_XGEN(j)  (2304 + 64 * (j))
#define XB_TOP      3328
#define XB_TOPGEN   3392
#define XCD_BAR_WORDS 3456
#define XB_SPIN_CAP (1u << 18)

__device__ __forceinline__ unsigned xb_ld(unsigned* p)              { return __hip_atomic_load(p, __ATOMIC_RELAXED, __HIP_MEMORY_SCOPE_AGENT); }
__device__ __forceinline__ unsigned xb_add(unsigned* p, unsigned v) { return __hip_atomic_fetch_add(p, v, __ATOMIC_RELAXED, __HIP_MEMORY_SCOPE_AGENT); }
__device__ __forceinline__ unsigned xb_xcc_id() { return (unsigned)__builtin_amdgcn_s_getreg((3 << 11) | 20) & 0xFu; }
#define XB_SPIN(cond, bar) do { unsigned _sp = 0; while (cond) { __builtin_amdgcn_s_sleep(1); \
    if ((++_sp & 255u) == 0u) { if (xb_ld(&(bar)[XB_TMO])) break; if (_sp > XB_SPIN_CAP) { atomicAdd(&(bar)[XB_TMO], 1u); break; } } } } while (0)

struct XcdBarrier {
    unsigned* bar; unsigned x;
    volatile LAS unsigned* st;
};

__device__ __forceinline__ XcdBarrier xcd_barrier_post(unsigned* bar, volatile LAS unsigned* st) {
    XcdBarrier b; b.bar = bar; b.x = xb_xcc_id(); b.st = st;
    if (threadIdx.x == 0) (void)xb_add(&bar[XB_XCNT(b.x)], 1u);
    return b;
}
__device__ __forceinline__ void xcd_barrier_complete(unsigned* bar, unsigned x, unsigned& nloc, unsigned& nx) {
    const unsigned G = gridDim.x * gridDim.y * gridDim.z;
    unsigned sum, cnt, mine, sp = 0u;
    for (;;) {
        sum = 0u; cnt = 0u; mine = 0u;
#pragma unroll
        for (unsigned j = 0; j < 16; ++j) { const unsigned c = xb_ld(&bar[XB_XCNT(j)]); sum += c; cnt += (c > 0u) ? 1u : 0u; mine = (j == x) ? c : mine; }
        if (sum == G) break;
        __builtin_amdgcn_s_sleep(1);
        if ((++sp & 255u) == 0u) { if (xb_ld(&bar[XB_TMO])) break; if (sp > XB_SPIN_CAP) { atomicAdd(&bar[XB_TMO], 1u); break; } }
    }
    nloc = mine > 0u ? mine : 1u; nx = cnt > 0u ? cnt : 1u;
}

__device__ __forceinline__ void xcd_barrier(const XcdBarrier& b) {
    asm volatile("s_waitcnt vmcnt(0)" ::: "memory");
    __syncthreads();
    if (threadIdx.x == 0) {
        unsigned* bar = b.bar;
        __builtin_amdgcn_s_waitcnt(0);
        unsigned nloc = b.st[0], nx = b.st[1];
        if (nloc == 0u) { xcd_barrier_complete(bar, b.x, nloc, nx); b.st[0] = nloc; b.st[1] = nx; }
        const unsigned old = xb_add(&bar[XB_XSUB(b.x)], 1u);
        const unsigned gen = old / nloc;
        if (old + 1u == (gen + 1u) * nloc) {
            __builtin_amdgcn_fence(__ATOMIC_RELEASE, "agent");
            asm volatile("s_waitcnt vmcnt(0)" ::: "memory");
            const unsigned og = xb_add(&bar[XB_TOP], 1u);
            const unsigned tg = og / nx;
            if (og + 1u == (tg + 1u) * nx) xb_add(&bar[XB_TOPGEN], 1u);
            else XB_SPIN(xb_ld(&bar[XB_TOPGEN]) == tg, bar);
            __builtin_amdgcn_fence(__ATOMIC_ACQUIRE, "agent");
            xb_add(&bar[XB_XGEN(b.x)], 1u);
            asm volatile("s_waitcnt vmcnt(0)" ::: "memory");
        } else {
            XB_SPIN(xb_ld(&bar[XB_XGEN(b.x)]) == gen, bar);
            __builtin_amdgcn_fence(__ATOMIC_ACQUIRE, "agent");
            asm volatile("s_waitcnt vmcnt(0)" ::: "memory");
        }
    }
    __syncthreads();
}

#define CAS __attribute__((address_space(4)))
struct Args { const float* in[26]; float* out; unsigned char* ws; int ph_lo, ph_hi; };
struct Frame {
    LAS unsigned char* lds;
    int tid, lane, wave, G, bid;
    const CAS struct Args* ka;
    float* out; unsigned char* ws;
};
#define WSP(T, off) ((T*)(F.ws + (off)))
#define WSPG(T, off) ((GAS T*)((GAS unsigned char*)F.ws + (off)))
#define INP(k) ((const GAS float*)F.ka->in[k])

__device__ __forceinline__ void tr_item(const GAS float* W, int ldw, int K, int scol0, int k0, GAS bf16* WT, int drow0, const GAS float* gain, LAS float* scr, int lane) {
    f32x4 v[8]; float gn[8];
#pragma unroll
    for (int i = 0; i < 8; ++i) { const int kk = 8 * i + (lane >> 3); v[i] = __builtin_nontemporal_load((const GAS f32x4*)(W + (size_t)(k0 + kk) * ldw + scol0 + 4 * (lane & 7))); gn[i] = gain ? gain[k0 + kk] : 1.0f; }
#pragma unroll
    for (int i = 0; i < 8; ++i) { const int kk = 8 * i + (lane >> 3); LAS float* d = scr + kk * 33 + 4 * (lane & 7);
        d[0] = v[i][0] * gn[i]; d[1] = v[i][1] * gn[i]; d[2] = v[i][2] * gn[i]; d[3] = v[i][3] * gn[i]; }
    LDS_WAIT(); asm volatile("" ::: "memory");
    const int c = lane & 7;
#pragma unroll
    for (int j = 0; j < 4; ++j) { const int n = (lane >> 3) + 8 * j; const LAS float* s = scr + (8 * c) * 33 + n;
        v4u o; o.x = pk2h(s[0 * 33], s[1 * 33]); o.y = pk2h(s[2 * 33], s[3 * 33]); o.z = pk2h(s[4 * 33], s[5 * 33]); o.w = pk2h(s[6 * 33], s[7 * 33]);
        *(GAS v4u*)(WT + (size_t)(drow0 + n) * K + k0 + 8 * c) = o; }
    LDS_WAIT(); asm volatile("" ::: "memory");
}
__device__ __forceinline__ bool tr_matrix(int& r, const GAS float* W, int ldw, int K, int N, int soff, int map, GAS bf16* WT, const GAS float* gain, LAS float* scr, int lane) {
    const int nblk = N / 32, cnt = (K / 64) * nblk;
    if (r >= cnt) { r -= cnt; return false; }
    const int kb = r / nblk, nb = r % nblk, d0 = 32 * nb; int sc = d0;
    if (map == 1 && d0 >= 2048) { const int q = d0 - 2048; sc = 2048 + ((q >> 7) & 1) * 512 + (q >> 8) * 128 + (q & 127); }
    if (map == 2) sc = ((d0 >> 7) & 1) * FFH + (d0 >> 8) * 128 + (d0 & 127);
    tr_item(W, ldw, K, soff + sc, 64 * kb, WT, d0, gain, scr, lane);
    return true;
}
__device__ __forceinline__ void convert_rest(Frame& F, int wi, int nw) {
    LAS float* scr = (LAS float*)(F.lds + F.wave * 16384);
    const int lane = F.lane;
    constexpr int NITEMS = 512 + 1280 + 512 + 2 * (512 + 2816 + 1408);
    for (int it = wi; it < NITEMS; it += nw) {
        int r = it;
        if (tr_matrix(r, INP(8), DM, DM, DM, 0, 0, WSPG(bf16, WS_WOUT0), nullptr, scr, lane)) continue;
        if (tr_matrix(r, INP(15), PW, DM, PW, 0, 0, WSPG(bf16, WS_WIN1), INP(2) + DM, scr, lane)) continue;
        if (tr_matrix(r, INP(16), DM, DM, DM, 0, 0, WSPG(bf16, WS_WOUT1), nullptr, scr, lane)) continue;
        bool done = false;
#pragma unroll
        for (int l = 0; l < 2; ++l) {
            if (done) break;
            if (tr_matrix(r, INP(23) + (size_t)l * DM * DM, DM, DM, DM, 0, 0, WSPG(bf16, WS_WO) + (size_t)l * DM * DM, nullptr, scr, lane)) { done = true; break; }
            if (tr_matrix(r, INP(24) + (size_t)l * DM * 2 * FFH, 2 * FFH, DM, 2 * FFH, 0, 2, WSPG(bf16, WS_WFI) + (size_t)l * DM * 2 * FFH, INP(4) + l * DM, scr, lane)) { done = true; break; }
            if (tr_matrix(r, INP(25) + (size_t)l * FFH * DM, DM, FFH, DM, 0, 0, WSPG(bf16, WS_WFO) + (size_t)l * FFH * DM, nullptr, scr, lane)) { done = true; break; }
        }
    }
    for (int it = wi; it < 2 * DM; it += nw) {
        const int l = it >> 10, i = it & (DM - 1);
        const float gsc = INP(3)[l * DM + i] * C2X;
        const GAS f32x4* xr = (const GAS f32x4*)(INP(21) + ((size_t)l * DM + i) * DM) + lane;
        GAS v2u* o8 = (GAS v2u*)(WSPG(bf16, WS_WQ) + ((size_t)l * DM + i) * DM) + lane;
#pragma unroll
        for (int j = 0; j < 4; ++j) { const f32x4 v = __builtin_nontemporal_load(xr + 64 * j) * gsc; v2u w; w.x = pk2h(v[0], v[1]); w.y = pk2h(v[2], v[3]); o8[64 * j] = w; }
    }
    __syncthreads();
}
__device__ __forceinline__ void p0_prologue(Frame& F) {
    LAS float* scr = (LAS float*)(F.lds + F.wave * 16384);
    const int gw = F.bid * NWAVES + F.wave, NGW = F.G * NWAVES, lane = F.lane;
    for (int it = gw; it < 1536 + 2048; it += NGW) { int r = it;
        if (tr_matrix(r, INP(7), 3072, DM, 3072, 0, 1, WSPG(bf16, WS_WIN0), INP(2), scr, lane)) continue;
        bool done = false;
#pragma unroll
        for (int l = 0; l < 2; ++l) {
            if (done) break;
            if (tr_matrix(r, INP(22) + (size_t)l * DM * 2048, 2048, DM, DM, 0, 0, WSPG(bf16, WS_WK) + (size_t)l * DM * DM, INP(5), scr, lane)) { done = true; break; }
            if (tr_matrix(r, INP(22) + (size_t)l * DM * 2048, 2048, DM, DM, 1024, 0, WSPG(bf16, WS_WV) + (size_t)l * DM * DM, INP(5), scr, lane)) { done = true; break; }
        } }
    {   const GAS float* x = INP(0); GAS bf16* xb = WSPG(bf16, WS_XB); GAS float* ssq = WSPG(float, WS_SSQ);
        for (int m0 = gw; m0 < MROWS; m0 += 4 * NGW) {
            f32x4 v[4][4];
#pragma unroll
            for (int u = 0; u < 4; ++u) { const int m = m0 + u * NGW; const int mc = m < MROWS ? m : m0; const GAS f32x4* xr = (const GAS f32x4*)(x + (size_t)mc * DM) + lane;
#pragma unroll
                for (int j = 0; j < 4; ++j) v[u][j] = __builtin_nontemporal_load(xr + 64 * j); }
#pragma unroll
            for (int u = 0; u < 4; ++u) { const int m = m0 + u * NGW; float s = 0.f;
#pragma unroll
                for (int j = 0; j < 4; ++j) s += (v[u][j][0] * v[u][j][0] + v[u][j][1] * v[u][j][1]) + (v[u][j][2] * v[u][j][2] + v[u][j][3] * v[u][j][3]);
                s = wave_sum(s);
                if (m < MROWS) {
                    GAS v2u* o8 = (GAS v2u*)(xb + (size_t)m * DM) + lane;
#pragma unroll
                    for (int j = 0; j < 4; ++j) { v2u w; w.x = pk2h(v[u][j][0], v[u][j][1]); w.y = pk2h(v[u][j][2], v[u][j][3]); o8[64 * j] = w; }
                    if (lane == 0) { ssq[m] = s; ssq[MROWS + m] = 0.f; } } }
        } }
    {   const GAS float* x = INP(1); GAS bf16* xb = WSPG(bf16, WS_MEMB); GAS float* rm = WSPG(float, WS_RMEM);
        for (int m = gw; m < MMEM; m += NGW) {
            const GAS f32x4* xr = (const GAS f32x4*)(x + (size_t)m * DM) + lane; f32x4 v[4]; float s = 0.f;
#pragma unroll
            for (int j = 0; j < 4; ++j) { v[j] = __builtin_nontemporal_load(xr + 64 * j); s += (v[j][0] * v[j][0] + v[j][1] * v[j][1]) + (v[j][2] * v[j][2] + v[j][3] * v[j][3]); }
            s = wave_sum(s);
            GAS v2u* o8 = (GAS v2u*)(xb + (size_t)m * DM) + lane;
#pragma unroll
            for (int j = 0; j < 4; ++j) { v2u w; w.x = pk2h(v[j][0], v[j][1]); w.y = pk2h(v[j][2], v[j][3]); o8[64 * j] = w; }
            if (lane == 0) rm[m] = __builtin_amdgcn_rsqf(s * (1.0f / DM) + EPS);
        } }
    {   const int idx = F.bid * (NWAVES * 64) + F.tid, NT = F.G * NWAVES * 64;
        for (int i = idx; i < 512; i += NT) { const float a0 = INP(9)[i], a1 = INP(9)[512 + i], a2 = INP(9)[1024 + i]; const float mx = fmaxf(a0, fmaxf(a1, a2));
            const float e0 = __expf(a0 - mx), e1 = __expf(a1 - mx), e2 = __expf(a2 - mx); WSPG(float, WS_LB)[i] = e0 / (e0 + e1 + e2); }
        for (int i = idx; i < 4 * 128 * 128; i += NT) { const int t = (i >> 7) & 127, s = i & 127; WSPG(bf16, WS_SGUW)[i] = (bf16)(s <= t ? (pk2h(INP(19)[i], 0.f) & 0xffffu) : 0u); }
    }
}

constexpr int HG_QIN = 0, HG_KIN = 17408, HG_KOT = 34816, HG_VTT = 53248, HG_ATT = 71680, HG_STT = 80896, HG_OST = 115712, HG_DEC = 133120, HG_SSQ = 133632;
constexpr int P128 = 272, P64 = 144;
__device__ __forceinline__ float wave_scan(float v) {
#define HG_DPP(ctrl, rmask) v += __builtin_bit_cast(float, __builtin_amdgcn_update_dpp(0, __builtin_bit_cast(int, v), (ctrl), (rmask), 0xf, false))
    HG_DPP(0x111, 0xf); HG_DPP(0x112, 0xf); HG_DPP(0x114, 0xf); HG_DPP(0x118, 0xf); HG_DPP(0x142, 0xa); HG_DPP(0x143, 0xc);
#undef HG_DPP
    return v;
}
__device__ __forceinline__ void hgrn_unit(Frame& F, int b, int h) {
    LAS unsigned char* L = F.lds;
    int tid_ = F.tid; asm volatile("" : "+v"(tid_));
    const int tid = tid_, lane = tid & 63, w = __builtin_amdgcn_readfirstlane(tid >> 6), l31 = lane & 31, hh = lane >> 5;
    const GAS bf16* P = WSPG(bf16, WS_BIG); GAS bf16* MIX = WSPG(bf16, WS_MIX);
    const int vs = tid >> 3, vec = (tid & 7) * 16;
    const int eb = w & 3, cb = w >> 2;
    f32x16 S0, S1;
#pragma unroll
    for (int r = 0; r < 16; ++r) { S0[r] = 0.f; S1[r] = 0.f; }
    for (int i = tid; i < 34816 / 16; i += 512) *(LAS v4u*)(L + HG_STT + i * 16) = (v4u){0u, 0u, 0u, 0u};
    float onorm[16];
#pragma unroll
    for (int j = 0; j < 16; ++j) onorm[j] = INP(10)[h * 128 + vec + j];
    LAS float* DEC = (LAS float*)(L + HG_DEC); LAS float* SSQ = (LAS float*)(L + HG_SSQ);
    const GAS bf16* pbase = P + ((size_t)b * SEQ + lane) * PW + h * 128 + 16 * w;
    const GAS bf16* gbase = P + ((size_t)b * SEQ + vs) * PW + 1536 + h * 128 + vec;
    v4u ra0, ra1, ra2, ra3, ra4, ra5, rb0, rb1, rb2, rb3, rb4, rb5, ga0, ga1, gb0, gb1;
    ra0 = *(const GAS v4u*)(pbase); ra1 = *(const GAS v4u*)(pbase + 8); ra2 = *(const GAS v4u*)(pbase + 512); ra3 = *(const GAS v4u*)(pbase + 520); ra4 = *(const GAS v4u*)(pbase + 1024); ra5 = *(const GAS v4u*)(pbase + 1032);
    {   const GAS bf16* p1 = pbase + (size_t)64 * PW;
        rb0 = *(const GAS v4u*)(p1); rb1 = *(const GAS v4u*)(p1 + 8); rb2 = *(const GAS v4u*)(p1 + 512); rb3 = *(const GAS v4u*)(p1 + 520); rb4 = *(const GAS v4u*)(p1 + 1024); rb5 = *(const GAS v4u*)(p1 + 1032); }
    ga0 = *(const GAS v4u*)(gbase); ga1 = *(const GAS v4u*)(gbase + 8); gb0 = *(const GAS v4u*)(gbase + (size_t)64 * PW); gb1 = *(const GAS v4u*)(gbase + (size_t)64 * PW + 8);
    const int tq = (lane & 15) >> 2, tp = lane & 3, tblk = (lane >> 4) & 1;
    const int trl0 = 256 * (8 * hh + tq) + 16 * ((2 * tblk + (tp >> 1)) ^ ((2 * hh) & 3)) + 8 * (tp & 1), trl1 = 256 * (8 * hh + 4 + tq) + 16 * ((2 * tblk + (tp >> 1)) ^ ((2 * hh + 1) & 3)) + 8 * (tp & 1);
    auto trf = [&](const LAS unsigned char* base, const int c32, const int ks) -> bf16x8 {
        const int cx = ((c32 ^ tq) << 6) + 4096 * ks;
        const s16x4 lo = __builtin_amdgcn_ds_read_tr16_b64_v4i16((LAS s16x4*)(base + trl0 + cx)), hi = __builtin_amdgcn_ds_read_tr16_b64_v4i16((LAS s16x4*)(base + trl1 + cx));
        return (bf16x8){lo[0], lo[1], lo[2], lo[3], hi[0], hi[1], hi[2], hi[3]}; };
    auto chunk = [&](const int n, v4u& rq0, v4u& rq1, v4u& rk0, v4u& rk1, v4u& rv0, v4u& rv1, v4u& g0, v4u& g1) {
        const size_t m0 = (size_t)b * SEQ + n * 64;
        {   const unsigned qw[8] = {rq0.x, rq0.y, rq0.z, rq0.w, rq1.x, rq1.y, rq1.z, rq1.w}, kw[8] = {rk0.x, rk0.y, rk0.z, rk0.w, rk1.x, rk1.y, rk1.z, rk1.w}, vw[8] = {rv0.x, rv0.y, rv0.z, rv0.w, rv1.x, rv1.y, rv1.z, rv1.w};
            float kk[16], cm[16];
#pragma unroll
            for (int j2 = 0; j2 < 8; ++j2) { kk[2 * j2] = hlo(kw[j2]); kk[2 * j2 + 1] = hhi(kw[j2]); }
#pragma unroll
            for (int j = 0; j < 16; ++j) cm[j] = __builtin_amdgcn_logf(1.0f - kk[j]);
#define HG_STEP(ctrl, rmask) _Pragma("unroll") for (int j = 0; j < 16; ++j) cm[j] += __builtin_bit_cast(float, __builtin_amdgcn_update_dpp(0, __builtin_bit_cast(int, cm[j]), (ctrl), (rmask), 0xf, false))
            HG_STEP(0x111, 0xf); __builtin_amdgcn_sched_barrier(0); HG_STEP(0x112, 0xf); __builtin_amdgcn_sched_barrier(0); HG_STEP(0x114, 0xf); __builtin_amdgcn_sched_barrier(0); HG_STEP(0x118, 0xf); __builtin_amdgcn_sched_barrier(0);
#undef HG_STEP
#define HG_BC1(c, r) "v_add_f32_dpp " r ", " r ", " r " " c "\n\t"
#define HG_BC(c) asm("s_nop 4\n\t" HG_BC1(c, "%0") HG_BC1(c, "%1") HG_BC1(c, "%2") HG_BC1(c, "%3") HG_BC1(c, "%4") HG_BC1(c, "%5") HG_BC1(c, "%6") HG_BC1(c, "%7") \
                     HG_BC1(c, "%8") HG_BC1(c, "%9") HG_BC1(c, "%10") HG_BC1(c, "%11") HG_BC1(c, "%12") HG_BC1(c, "%13") HG_BC1(c, "%14") HG_BC1(c, "%15") \
                     : "+v"(cm[0]), "+v"(cm[1]), "+v"(cm[2]), "+v"(cm[3]), "+v"(cm[4]), "+v"(cm[5]), "+v"(cm[6]), "+v"(cm[7]), "+v"(cm[8]), "+v"(cm[9]), "+v"(cm[10]), "+v"(cm[11]), "+v"(cm[12]), "+v"(cm[13]), "+v"(cm[14]), "+v"(cm[15]))
            HG_BC("row_bcast:15 row_mask:0xa bank_mask:0xf"); HG_BC("row_bcast:31 row_mask:0xc bank_mask:0xf");
#undef HG_BC
#undef HG_BC1
            unsigned qo[8], ko[8], kt[8];
#pragma unroll
            for (int j = 0; j < 16; ++j) cm[j] = fexp2(cm[j]);
            if (lane == 63) {
#pragma unroll
                for (int g4 = 0; g4 < 4; ++g4) *(LAS f32x4*)(DEC + 16 * w + 4 * g4) = (f32x4){cm[4 * g4], cm[4 * g4 + 1], cm[4 * g4 + 2], cm[4 * g4 + 3]}; }
#pragma unroll
            for (int j2 = 0; j2 < 8; ++j2) {
                float qi[2], ki[2], kd[2];
#pragma unroll
                for (int t = 0; t < 2; ++t) { const int j = 2 * j2 + t;
                    const float e1 = cm[j], e2 = __builtin_amdgcn_rcpf(e1), dec = __builtin_bit_cast(float, __builtin_amdgcn_readlane(__builtin_bit_cast(int, e1), 63));
                    qi[t] = (t == 0 ? hlo(qw[j2]) : hhi(qw[j2])) * e1; ki[t] = kk[j] * e2; kd[t] = ki[t] * dec; }
                qo[j2] = pk2(qi[0], qi[1]); ko[j2] = pk2(ki[0], ki[1]); kt[j2] = pk2h(kd[0], kd[1]);
            }
            {   const int xr = ((lane & 3) << 2) | ((lane >> 2) & 3);
                LAS unsigned char* kp = L + HG_KOT + lane * 256; LAS unsigned char* vp = L + HG_VTT + lane * 256;
                *(LAS v4u*)(kp + (((2 * w) ^ xr) << 4)) = (v4u){kt[0], kt[1], kt[2], kt[3]}; *(LAS v4u*)(kp + (((2 * w + 1) ^ xr) << 4)) = (v4u){kt[4], kt[5], kt[6], kt[7]};
                *(LAS v4u*)(vp + (((2 * w) ^ xr) << 4)) = rv0; *(LAS v4u*)(vp + (((2 * w + 1) ^ xr) << 4)) = rv1; }
            *(LAS v4u*)(L + HG_QIN + lane * P128 + 32 * w) = (v4u){qo[0], qo[1], qo[2], qo[3]}; *(LAS v4u*)(L + HG_QIN + lane * P128 + 32 * w + 16) = (v4u){qo[4], qo[5], qo[6], qo[7]};
            *(LAS v4u*)(L + HG_KIN + lane * P128 + 32 * w) = (v4u){ko[0], ko[1], ko[2], ko[3]}; *(LAS v4u*)(L + HG_KIN + lane * P128 + 32 * w + 16) = (v4u){ko[4], ko[5], ko[6], ko[7]};
        }
        __syncthreads();
        {   const int n2c = n + 2 < 32 ? n + 2 : 31;
            const GAS bf16* pn = pbase + (size_t)n2c * 64 * PW;
            rq0 = *(const GAS v4u*)(pn); rq1 = *(const GAS v4u*)(pn + 8); rk0 = *(const GAS v4u*)(pn + 512); rk1 = *(const GAS v4u*)(pn + 520); rv0 = *(const GAS v4u*)(pn + 1024); rv1 = *(const GAS v4u*)(pn + 1032); }
        f32x16 o;
#pragma unroll
        for (int r = 0; r < 16; ++r) o[r] = 0.f;
        mma_lds<8>(o, L + HG_STT + (32 * eb + l31) * P128 + hh * 16, L + HG_QIN + (32 * cb + l31) * P128 + hh * 16);
        if (w < 3) {
            const int sb = w >> 1, cb2 = (w + 1) >> 1;
            f32x16 at;
#pragma unroll
            for (int r = 0; r < 16; ++r) at[r] = 0.f;
            mma_lds<8>(at, L + HG_KIN + (32 * sb + l31) * P128 + hh * 16, L + HG_QIN + (32 * cb2 + l31) * P128 + hh * 16);
            if (sb == cb2) {
#pragma unroll
                for (int r = 0; r < 16; ++r) { const int sl = (r & 3) + 8 * (r >> 2) + 4 * hh; if (sl > l31) at[r] = 0.f; } }
#pragma unroll
            for (int g4 = 0; g4 < 4; ++g4) *(LAS v2u*)(L + HG_ATT + (32 * cb2 + l31) * P64 + (32 * sb + 8 * g4 + 4 * hh) * 2) = (v2u){pk2h(at[4 * g4], at[4 * g4 + 1]), pk2h(at[4 * g4 + 2], at[4 * g4 + 3])};
        }
        __syncthreads();
        bf16x8 vfr[4];
#pragma unroll
        for (int ks = 0; ks < 4; ++ks) vfr[ks] = trf(L + HG_VTT, eb, ks);
        {   const LAS unsigned char* ab = L + HG_ATT + (32 * cb + l31) * P64 + hh * 16;
            bf16x8 af[4];
#pragma unroll
            for (int ks = 0; ks < 4; ++ks) if (ks < 2 + 2 * cb) af[ks] = ldsfrag(ab + ks * 32);
#pragma unroll
            for (int ks = 0; ks < 4; ++ks) if (ks < 2 + 2 * cb) o = MFMA32H(vfr[ks], af[ks], o); }
#pragma unroll
        for (int i2 = 0; i2 < 2; ++i2) {
            const int dkb = 2 * cb + i2;
            f32x16& S = i2 == 0 ? S0 : S1;
#pragma unroll
            for (int g4 = 0; g4 < 4; ++g4) { const f32x4 d4 = *(const LAS f32x4*)(DEC + 32 * dkb + 8 * g4 + 4 * hh);
#pragma unroll
                for (int j = 0; j < 4; ++j) S[4 * g4 + j] *= d4[j]; }
            {   bf16x8 kfr[4];
#pragma unroll
                for (int ks = 0; ks < 4; ++ks) kfr[ks] = trf(L + HG_KOT, dkb, ks);
#pragma unroll
                for (int ks = 0; ks < 4; ++ks) S = MFMA32H(kfr[ks], vfr[ks], S); }
#pragma unroll
            for (int g4 = 0; g4 < 4; ++g4) *(LAS v2u*)(L + HG_STT + (32 * eb + l31) * P128 + (32 * dkb + 8 * g4 + 4 * hh) * 2) = (v2u){pk2(S[4 * g4], S[4 * g4 + 1]), pk2(S[4 * g4 + 2], S[4 * g4 + 3])};
        }
        {   float ss = 0.f;
#pragma unroll
            for (int r = 0; r < 16; ++r) ss += o[r] * o[r];
            ss = x32_sum(ss);
            if (hh == 0) SSQ[eb * 64 + 32 * cb + l31] = ss;
#pragma unroll
            for (int g4 = 0; g4 < 4; ++g4) *(LAS v2u*)(L + HG_OST + (32 * cb + l31) * P128 + (32 * eb + 8 * g4 + 4 * hh) * 2) = (v2u){pk2h(o[4 * g4], o[4 * g4 + 1]), pk2h(o[4 * g4 + 2], o[4 * g4 + 3])}; }
        __syncthreads();
        {   const int c = vs;
            const float rn = __builtin_amdgcn_rsqf(((SSQ[c] + SSQ[64 + c]) + (SSQ[128 + c] + SSQ[192 + c])) * (1.0f / 128.0f) + EPS);
            const v4u o0 = *(const LAS v4u*)(L + HG_OST + c * P128 + vec * 2), o1 = *(const LAS v4u*)(L + HG_OST + c * P128 + vec * 2 + 16);
            const unsigned ow[8] = {o0.x, o0.y, o0.z, o0.w, o1.x, o1.y, o1.z, o1.w}, gw[8] = {g0.x, g0.y, g0.z, g0.w, g1.x, g1.y, g1.z, g1.w};
            {   const int n2c = n + 2 < 32 ? n + 2 : 31; g0 = *(const GAS v4u*)(gbase + (size_t)n2c * 64 * PW); g1 = *(const GAS v4u*)(gbase + (size_t)n2c * 64 * PW + 8); }
            unsigned res[8];
#pragma unroll
            for (int j = 0; j < 8; ++j) res[j] = pk2h(hlo(ow[j]) * rn * onorm[2 * j] * hlo(gw[j]), hhi(ow[j]) * rn * onorm[2 * j + 1] * hhi(gw[j]));
            *(GAS v4u*)(MIX + (m0 + c) * DM + h * 128 + vec) = (v4u){res[0], res[1], res[2], res[3]};
            *(GAS v4u*)(MIX + (m0 + c) * DM + h * 128 + vec + 8) = (v4u){res[4], res[5], res[6], res[7]};
        }
    };
#pragma unroll 1
    for (int n2 = 0; n2 < 32; n2 += 2) { chunk(n2, ra0, ra1, ra2, ra3, ra4, ra5, ga0, ga1); chunk(n2 + 1, rb0, rb1, rb2, rb3, rb4, rb5, gb0, gb1); }
    __syncthreads();
}

__device__ __forceinline__ void reduce16x2(float (&a)[16], int lane) {
#pragma unroll
    for (int i = 0; i < 8; ++i) { const bool up = (lane & 32) != 0; const float send = up ? a[i] : a[i + 8]; const float keep = up ? a[i + 8] : a[i]; a[i] = keep + __shfl_xor(send, 32); }
#pragma unroll
    for (int i = 0; i < 4; ++i) { const bool up = (lane & 16) != 0; const float send = up ? a[i] : a[i + 4]; const float keep = up ? a[i + 4] : a[i]; a[i] = keep + __shfl_xor(send, 16); }
#pragma unroll
    for (int i = 0; i < 2; ++i) { const bool up = (lane & 8) != 0; const float send = up ? a[i] : a[i + 2]; const float keep = up ? a[i + 2] : a[i]; a[i] = keep + __shfl_xor(send, 8); }
    { const bool up = (lane & 4) != 0; const float send = up ? a[0] : a[1]; const float keep = up ? a[1] : a[0]; a[0] = keep + __shfl_xor(send, 4); }
    a[0] += __shfl_xor(a[0], 2); a[0] += __shfl_xor(a[0], 1);
}
constexpr int CV_CT = 0, CV_PART = 98304;
__device__ __forceinline__ void conv_tiles(Frame& F, int first, int stride) {
    if (first >= 512) return;
    LAS unsigned char* L = F.lds;
    int tid_ = F.tid; asm volatile("" : "+v"(tid_));
    const int tid = tid_, lane = tid & 63, w = __builtin_amdgcn_readfirstlane(tid >> 6);
    const GAS bf16* P = WSPG(bf16, WS_BIG); GAS unsigned* MIX32 = WSPG(unsigned, WS_MIX);
    const int cp = tid & 255, th = tid >> 8;
    float w0[31], w1[31];
#pragma unroll
    for (int k = 0; k < 31; ++k) { const f32x2_t ww = *(const GAS f32x2_t*)(INP(11) + k * 512 + 2 * cp); w0[k] = ww.x; w1[k] = ww.y; }
    const f32x2_t bias = *(const GAS f32x2_t*)(INP(12) + 2 * cp), lng = *(const GAS f32x2_t*)(INP(13) + 2 * cp), lnb = *(const GAS f32x2_t*)(INP(14) + 2 * cp);
    LAS float* PART = (LAS float*)(L + CV_PART);
    const LAS unsigned* CT32 = (const LAS unsigned*)(L + CV_CT);
    v4u rows[12];
    auto load_rows = [&](int tile) { const int b = tile >> 5, t0 = (tile & 31) * 64;
#pragma unroll
        for (int i = 0; i < 12; ++i) { const int idx = tid + 512 * i, j = idx >> 6, c16 = idx & 63, t = t0 - 30 + j;
            rows[i] = (v4u){0u, 0u, 0u, 0u}; if (idx < 94 * 64 && t >= 0) rows[i] = *(const GAS v4u*)(P + ((size_t)b * SEQ + t) * PW + 2048 + c16 * 8); } };
    auto store_rows = [&]() {
#pragma unroll
        for (int i = 0; i < 12; ++i) { const int idx = tid + 512 * i; if (idx < 94 * 64) *(LAS v4u*)(L + CV_CT + (idx >> 6) * 1024 + (idx & 63) * 16) = rows[i]; } };
    load_rows(first);
#pragma unroll 1
    for (int tile = first; tile < 512; tile += stride) {
        const int b = tile >> 5, t0 = (tile & 31) * 64; const size_t m0 = (size_t)b * SEQ + t0;
        store_rows();
        __syncthreads();
        if (tile + stride < 512) load_rows(tile + stride);
#pragma unroll 1
        for (int grp = 0; grp < 4; ++grp) {
            const int tok0 = 32 * th + 8 * grp;
            float a0[8], a1[8];
#pragma unroll
            for (int i = 0; i < 8; ++i) { a0[i] = bias.x; a1[i] = bias.y; }
#pragma unroll
            for (int jj = 0; jj < 38; ++jj) { const unsigned v = CT32[(tok0 + jj) * 256 + cp]; const float x0 = hlo(v), x1 = hhi(v);
#pragma unroll
                for (int i = 0; i < 8; ++i) { const int k = jj - i; if (k >= 0 && k <= 30) { a0[i] += w0[k] * x0; a1[i] += w1[k] * x1; } } }
            float st[16];
#pragma unroll
            for (int i = 0; i < 8; ++i) { st[i] = a0[i] + a1[i]; st[8 + i] = a0[i] * a0[i] + a1[i] * a1[i]; }
            reduce16x2(st, lane);
            if ((lane & 3) == 0) PART[((grp & 1) * 8 + w) * 16 + (8 * ((lane >> 5) & 1) + 4 * ((lane >> 4) & 1) + 2 * ((lane >> 3) & 1) + ((lane >> 2) & 1))] = st[0];
            __syncthreads();
#pragma unroll
            for (int i = 0; i < 8; ++i) {
                float s = 0.f, q = 0.f;
#pragma unroll
                for (int ww = 0; ww < 4; ++ww) { s += PART[((grp & 1) * 8 + 4 * th + ww) * 16 + i]; q += PART[((grp & 1) * 8 + 4 * th + ww) * 16 + 8 + i]; }
                const float mu = s * (1.0f / 512.0f), var = q * (1.0f / 512.0f) - mu * mu, rstd = __builtin_amdgcn_rsqf(fmaxf(var, 0.f) + EPS);
                float y0 = (a0[i] - mu) * rstd * lng.x + lnb.x, y1 = (a1[i] - mu) * rstd * lng.y + lnb.y;
                y0 *= sigm(y0); y1 *= sigm(y1);
                MIX32[(m0 + tok0 + i) * 512 + 256 + cp] = pk2h(y0, y1);
            }
        }
        __syncthreads();
    }
}

constexpr int MB_KP = 144, MB_VOFF = 256 * MB_KP, MB_BUF = MB_VOFF + 256 * 128, MB_KM = 2 * MB_BUF;
__device__ __forceinline__ void moba_unit(Frame& F, int b, int hd, int jq) {
    LAS unsigned char* L = F.lds;
    int tid_ = F.tid; asm volatile("" : "+v"(tid_));
    const int tid = tid_, lane = tid & 63, w = __builtin_amdgcn_readfirstlane(tid >> 6), l31 = lane & 31, hh = lane >> 5;
    const GAS bf16* P = WSPG(bf16, WS_BIG); GAS bf16* MIX = WSPG(bf16, WS_MIX); const GAS float* kpart = WSPG(float, WS_KPART);
    const size_t m0 = (size_t)b * SEQ + jq * 256;
    const size_t qrow = m0 + 32 * w + l31;
    bf16x8 qf[4];
#pragma unroll
    for (int ks = 0; ks < 4; ++ks) qf[ks] = *(const GAS bf16x8*)(P + qrow * PW + hd * 64 + 16 * ks + 8 * hh);
    LAS float* KM = (LAS float*)(L + MB_KM);
    if (tid < jq * 64) { const int n = tid >> 6, d = tid & 63, pm = b * 8 + n, col = hd * 64 + d;
        KM[n * 64 + d] = (kpart[(size_t)(pm * 2) * 512 + col] + kpart[(size_t)(pm * 2 + 1) * 512 + col]) * (1.0f / 256.0f); }
    const int skey = tid >> 3, sch = tid & 7;
    v4u kreg[4], vreg[4];
    auto stage_load = [&](int blk) { const size_t mk = (size_t)b * SEQ + blk * 256;
#pragma unroll
        for (int j = 0; j < 4; ++j) { kreg[j] = *(const GAS v4u*)(P + (mk + skey + 64 * j) * PW + 512 + hd * 64 + 8 * sch); vreg[j] = *(const GAS v4u*)(P + (mk + skey + 64 * j) * PW + 1024 + hd * 64 + 8 * sch); } };
    auto stage_write = [&](int buf) {
#pragma unroll
        for (int j = 0; j < 4; ++j) { *(LAS v4u*)(L + buf * MB_BUF + (skey + 64 * j) * MB_KP + sch * 16) = kreg[j];
            *(LAS v4u*)(L + buf * MB_BUF + MB_VOFF + (skey + 64 * j) * 128 + ((sch ^ (((skey >> 1) & 1) << 2)) << 4)) = vreg[j]; } };
    stage_load(jq); stage_write(0);
    __syncthreads();
    unsigned sel = 0u;
    if (jq <= 3) sel = (1u << jq) - 1u;
    else {
        float sc[7];
#pragma unroll
        for (int n = 0; n < 7; ++n) { float p = 0.f;
            if (n < jq) {
#pragma unroll
                for (int ks = 0; ks < 4; ++ks)
#pragma unroll
                    for (int j = 0; j < 8; ++j) p += h2f((unsigned short)qf[ks][j]) * KM[n * 64 + 16 * ks + 8 * hh + j];
                p = x32_sum(p); } else p = -INFINITY;
            sc[n] = p; }
#pragma unroll
        for (int n = 0; n < 7; ++n) { int rank = 0;
#pragma unroll
            for (int n2 = 0; n2 < 7; ++n2) if (n2 != n) rank += (sc[n2] > sc[n] || (sc[n2] == sc[n] && n2 < n)) ? 1 : 0;
            if (n < jq && rank < 3) sel |= 1u << n; }
    }
    const int tq = (lane & 15) >> 2, tp = lane & 3, tblk = (lane >> 4) & 1, tqb = (tq >> 1) & 1;
    const int vt0 = (4 * hh + tq) * 128 + ((((0 ^ tqb) << 2) + 2 * tblk + (tp >> 1)) << 4) + 8 * (tp & 1), vt1 = (4 * hh + tq) * 128 + ((((1 ^ tqb) << 2) + 2 * tblk + (tp >> 1)) << 4) + 8 * (tp & 1);
    auto trfrag = [&](const LAS unsigned char* p) -> bf16x8 {
        const s16x4 lo = __builtin_amdgcn_ds_read_tr16_b64_v4i16((LAS s16x4*)p), hi = __builtin_amdgcn_ds_read_tr16_b64_v4i16((LAS s16x4*)(p + 1024));
        return (bf16x8){lo[0], lo[1], lo[2], lo[3], hi[0], hi[1], hi[2], hi[3]}; };
    if (w >= 4) __builtin_amdgcn_s_setprio(1);
    float negm = 0.f; bool first = true; f32x16 O0, O1, O2, cs;
#pragma unroll
    for (int r = 0; r < 16; ++r) { O0[r] = 0.f; O1[r] = 0.f; O2[r] = 0.f; }
    const bf16x8 ones = __builtin_bit_cast(bf16x8, (v4u){0x3C003C00u, 0x3C003C00u, 0x3C003C00u, 0x3C003C00u});
#pragma unroll 1
    for (int bi = 0; bi <= jq; ++bi) {
        const int buf = bi & 1;
        if (bi < jq) stage_load(bi);
        const bool own = bi == 0; const int blk = own ? jq : bi - 1;
        const bool mysel = own ? true : (((sel >> blk) & 1u) != 0u);
        const bool anysel = own ? true : (__ballot(mysel) != 0ull);
        const int nkt = own ? ((w >> 1) + 1) : (anysel ? 4 : 0);
        {   const float cv = mysel ? negm : NEGBIG;
#pragma unroll
            for (int r = 0; r < 16; ++r) cs[r] = cv; }
#pragma unroll 1
        for (int kt = 0; kt < nkt; ++kt) {
            f32x16 p0, p1;
            {   const LAS unsigned char* kb = L + buf * MB_BUF + (64 * kt + l31) * MB_KP + hh * 16;
                bf16x8 kfa[4], kfb[4];
#pragma unroll
                for (int ks = 0; ks < 4; ++ks) { kfa[ks] = ldsfrag(kb + ks * 32); kfb[ks] = ldsfrag(kb + 32 * MB_KP + ks * 32); }
                p0 = MFMA32H(kfa[0], qf[0], cs); p1 = MFMA32H(kfb[0], qf[0], cs);
#pragma unroll
                for (int ks = 1; ks < 4; ++ks) { p0 = MFMA32H(kfa[ks], qf[ks], p0); p1 = MFMA32H(kfb[ks], qf[ks], p1); } }
            bf16x8 vf[8];
            {   const LAS unsigned char* vb = L + buf * MB_BUF + MB_VOFF + 8192 * kt;
#pragma unroll
                for (int ks4 = 0; ks4 < 4; ++ks4) { vf[ks4 * 2] = trfrag(vb + vt0 + 2048 * ks4); vf[ks4 * 2 + 1] = trfrag(vb + vt1 + 2048 * ks4); } }
            if (own) { const int qrel = 32 * w + l31, kb0 = 64 * kt + 4 * hh;
                if (64 * kt + 63 > 32 * w) {
#pragma unroll
                    for (int r = 0; r < 16; ++r) { const int kv = kb0 + (r & 3) + 8 * (r >> 2); if (kv > qrel) p0[r] = NEGBIG; if (kv + 32 > qrel) p1[r] = NEGBIG; } }
            }
            float mxa = fmax_nn(fmax_nn(p0[0], p1[0]), p0[4]), mxb = fmax_nn(fmax_nn(p0[1], p1[1]), p0[5]), mxc = fmax_nn(fmax_nn(p0[2], p1[2]), p0[6]), mxd = fmax_nn(fmax_nn(p0[3], p1[3]), p0[7]);
            mxa = fmax_nn(fmax_nn(mxa, p1[4]), p0[8]); mxb = fmax_nn(fmax_nn(mxb, p1[5]), p0[9]); mxc = fmax_nn(fmax_nn(mxc, p1[6]), p0[10]); mxd = fmax_nn(fmax_nn(mxd, p1[7]), p0[11]);
            mxa = fmax_nn(fmax_nn(mxa, p1[8]), p0[12]); mxb = fmax_nn(fmax_nn(mxb, p1[9]), p0[13]); mxc = fmax_nn(fmax_nn(mxc, p1[10]), p0[14]); mxd = fmax_nn(fmax_nn(mxd, p1[11]), p0[15]);
            mxa = fmax_nn(fmax_nn(mxa, p1[12]), p1[13]); mxb = fmax_nn(fmax_nn(mxb, p1[14]), p1[15]);
            float mx = fmax_nn(fmax_nn(fmax_nn(mxa, mxb), mxc), mxd);
            mx = x32_max(mx);
            if (first || !__all(mx <= 8.0f)) {
                const float delta = first ? mx : fmaxf(mx, 0.f);
                negm -= delta;
#pragma unroll
                for (int r = 0; r < 16; ++r) { p0[r] -= delta; p1[r] -= delta; }
                if (!first) { const float alpha = fexp2(-delta);
#pragma unroll
                    for (int r = 0; r < 16; ++r) { O0[r] *= alpha; O1[r] *= alpha; O2[r] *= alpha; } }
                first = false;
                {   const float cv = mysel ? negm : NEGBIG;
#pragma unroll
                    for (int r = 0; r < 16; ++r) cs[r] = cv; }
            }
#pragma unroll
            for (int r = 0; r < 16; ++r) { p0[r] = fexp2(p0[r]); p1[r] = fexp2(p1[r]); }
#pragma unroll
            for (int sub = 0; sub < 2; ++sub)
#pragma unroll
                for (int s2 = 0; s2 < 2; ++s2) { const bf16x8 pb = packfrag(sub == 0 ? p0 : p1, s2);
                    O0 = MFMA32H(vf[(sub * 2 + s2) * 2], pb, O0);
                    O1 = MFMA32H(vf[(sub * 2 + s2) * 2 + 1], pb, O1);
                    O2 = MFMA32H(ones, pb, O2); }
        }
        if (bi < jq) stage_write(buf ^ 1);
        __syncthreads();
    }
    __builtin_amdgcn_s_setprio(0);
    {   const float inv = 1.0f / O2[0];
        GAS bf16* op = MIX + qrow * DM + hd * 64 + 4 * hh;
#pragma unroll
        for (int g4 = 0; g4 < 4; ++g4) {
            *(GAS v2u*)(op + 8 * g4) = (v2u){pk2h(O0[4 * g4] * inv, O0[4 * g4 + 1] * inv), pk2h(O0[4 * g4 + 2] * inv, O0[4 * g4 + 3] * inv)};
            *(GAS v2u*)(op + 32 + 8 * g4) = (v2u){pk2h(O1[4 * g4] * inv, O1[4 * g4 + 1] * inv), pk2h(O1[4 * g4 + 2] * inv, O1[4 * g4 + 3] * inv)}; }
    }
}

constexpr int SG_ZT = 0, SG_STAT = 34816, SG_OT = 40960, SG_PAR = 77824;
__device__ __forceinline__ void sgu_unit(Frame& F, int ucur, int unext, const v4u (&zr)[4], const v4u (&ur)[4], v4u (&nz)[4], v4u (&nu)[4]) {
    const int b = ucur >> 6, nc = (ucur >> 2) & 15, g = ucur & 3;
    LAS unsigned char* L = F.lds;
    int tid_ = F.tid; asm volatile("" : "+v"(tid_));
    const int tid = tid_, lane = tid & 63, w = __builtin_amdgcn_readfirstlane(tid >> 6), l31 = lane & 31, hh = lane >> 5;
    const GAS bf16* P = WSPG(bf16, WS_BIG); GAS bf16* MIX = WSPG(bf16, WS_MIX); const GAS bf16* Wb = WSPG(bf16, WS_SGUW) + g * 128 * 128;
    const size_t m0 = (size_t)b * SEQ + nc * 128;
    const int s = tid & 127, qt = tid >> 7, c0 = 32 * qt;
    const int tb0 = w >> 2;
    bf16x8 wf0[4], wf1[8];
#pragma unroll
    for (int ks = 0; ks < 4; ++ks) if (ks < 2 * (tb0 + 1)) wf0[ks] = *(const GAS bf16x8*)(Wb + (32 * tb0 + l31) * 128 + 8 * hh + 16 * ks);
#pragma unroll
    for (int ks = 0; ks < 8; ++ks) if (ks < 2 * (4 - tb0)) wf1[ks] = *(const GAS bf16x8*)(Wb + (32 * (3 - tb0) + l31) * 128 + 8 * hh + 16 * ks);
    if (unext >= 0) {
        const int b2 = unext >> 6, nc2 = (unext >> 2) & 15, g2 = unext & 3; const size_t m2 = (size_t)b2 * SEQ + nc2 * 128;
        const GAS bf16* zp = P + (m2 + s) * PW + 2048 + g2 * 128 + c0; const GAS bf16* up = P + (m2 + (tid >> 2)) * PW + 1536 + g2 * 128 + (tid & 3) * 32;
#pragma unroll
        for (int j4 = 0; j4 < 4; ++j4) { nz[j4] = *(const GAS v4u*)(zp + 8 * j4); nu[j4] = *(const GAS v4u*)(up + 8 * j4); } }
    float z[32];
#pragma unroll
    for (int j4 = 0; j4 < 4; ++j4) { const unsigned vw[4] = {zr[j4].x, zr[j4].y, zr[j4].z, zr[j4].w};
#pragma unroll
        for (int j = 0; j < 4; ++j) { z[8 * j4 + 2 * j] = hlo(vw[j]); z[8 * j4 + 2 * j + 1] = hhi(vw[j]); } }
    float sm = 0.f, sq = 0.f;
#pragma unroll
    for (int j = 0; j < 32; ++j) { sm += z[j]; sq += z[j] * z[j]; }
    LAS float* ST = (LAS float*)(L + SG_STAT);
    ST[(qt * 128 + s) * 2] = sm; ST[(qt * 128 + s) * 2 + 1] = sq;
    __syncthreads();
    {   float a = 0.f, q = 0.f;
#pragma unroll
        for (int k = 0; k < 4; ++k) { a += ST[(k * 128 + s) * 2]; q += ST[(k * 128 + s) * 2 + 1]; }
        const float mu = a * (1.0f / 128.0f), var = q * (1.0f / 128.0f) - mu * mu, rstd = __builtin_amdgcn_rsqf(fmaxf(var, 0.f) + EPS);
        const LAS float* lg = (const LAS float*)(L + SG_PAR) + g * 128 + c0; const LAS float* lbp = lg + 512;
#pragma unroll
        for (int i4 = 0; i4 < 4; ++i4) { unsigned pw[4];
#pragma unroll
            for (int h2 = 0; h2 < 2; ++h2) { const int j4 = 2 * i4 + h2; const f32x4 g4v = *(const LAS f32x4*)(lg + 4 * j4), b4v = *(const LAS f32x4*)(lbp + 4 * j4);
                pw[2 * h2] = pk2h((z[4 * j4] - mu) * rstd * g4v[0] + b4v[0], (z[4 * j4 + 1] - mu) * rstd * g4v[1] + b4v[1]);
                pw[2 * h2 + 1] = pk2h((z[4 * j4 + 2] - mu) * rstd * g4v[2] + b4v[2], (z[4 * j4 + 3] - mu) * rstd * g4v[3] + b4v[3]); }
            *(LAS v4u*)(L + SG_ZT + s * 256 + (((4 * qt + i4) ^ (((s & 3) << 2) | ((s >> 2) & 3))) << 4)) = (v4u){pw[0], pw[1], pw[2], pw[3]}; }
    }
    __syncthreads();
    const int cb = w & 3;
    const int zq = (lane & 15) >> 2, zp = lane & 3, zblk = (lane >> 4) & 1;
    const int zt0 = (8 * hh + zq) * 256 + (((4 * cb + 2 * zblk + (zp >> 1)) ^ ((zq << 2) | ((2 * hh) & 3))) << 4) + 8 * (zp & 1);
    const int zt1 = (8 * hh + 4 + zq) * 256 + (((4 * cb + 2 * zblk + (zp >> 1)) ^ ((zq << 2) | ((2 * hh + 1) & 3))) << 4) + 8 * (zp & 1);
#pragma unroll
    for (int it = 0; it < 2; ++it) {
        const int tb = it == 0 ? tb0 : 3 - tb0;
        f32x16 acc;
#pragma unroll
        for (int r = 0; r < 16; ++r) acc[r] = 0.f;
        const int nks = 2 * (tb + 1);
#pragma unroll
        for (int ks = 0; ks < (it == 0 ? 4 : 8); ++ks) if (ks < nks) {
            const s16x4 lo = __builtin_amdgcn_ds_read_tr16_b64_v4i16((LAS s16x4*)(L + SG_ZT + zt0 + 4096 * ks)), hi = __builtin_amdgcn_ds_read_tr16_b64_v4i16((LAS s16x4*)(L + SG_ZT + zt1 + 4096 * ks));
            acc = MFMA32H(((bf16x8){lo[0], lo[1], lo[2], lo[3], hi[0], hi[1], hi[2], hi[3]}), it == 0 ? wf0[ks] : wf1[ks], acc); }
        const float bias = ((const LAS float*)(L + SG_PAR))[1024 + g * 128 + 32 * tb + l31];
#pragma unroll
        for (int g4 = 0; g4 < 4; ++g4) *(LAS v2u*)(L + SG_OT + (32 * tb + l31) * P128 + (32 * cb + 8 * g4 + 4 * hh) * 2) = (v2u){pk2h(acc[4 * g4] + bias, acc[4 * g4 + 1] + bias), pk2h(acc[4 * g4 + 2] + bias, acc[4 * g4 + 3] + bias)};
    }
    __syncthreads();
    {   const int t = tid >> 2, cc = (tid & 3) * 32;
        GAS bf16* op = MIX + (m0 + t) * DM + 512 + g * 128 + cc;
#pragma unroll
        for (int j4 = 0; j4 < 4; ++j4) { const v4u u = ur[j4], mx = *(const LAS v4u*)(L + SG_OT + t * P128 + (cc + 8 * j4) * 2);
            *(GAS v4u*)(op + 8 * j4) = (v4u){pk2h(hlo(u.x) * hlo(mx.x), hhi(u.x) * hhi(mx.x)), pk2h(hlo(u.y) * hlo(mx.y), hhi(u.y) * hhi(mx.y)), pk2h(hlo(u.z) * hlo(mx.z), hhi(u.z) * hhi(mx.z)), pk2h(hlo(u.w) * hlo(mx.w), hhi(u.w) * hhi(mx.w))}; }
    }
    __syncthreads();
}

__device__ __forceinline__ void sgu_units(Frame& F, int first, int stride) {
    if (first >= 1024) return;
    const int tid = F.tid, s = tid & 127, c0 = 32 * (tid >> 7);
    const GAS bf16* P = WSPG(bf16, WS_BIG);
    {   LAS float* PAR = (LAS float*)(F.lds + SG_PAR);
        PAR[tid] = INP(17)[tid]; PAR[512 + tid] = INP(18)[tid]; PAR[1024 + tid] = INP(20)[tid]; }
    v4u za[4], ua[4], zb[4], ub[4];
    {   const int b = first >> 6, nc = (first >> 2) & 15, g = first & 3; const size_t m0 = (size_t)b * SEQ + nc * 128;
        const GAS bf16* zp = P + (m0 + s) * PW + 2048 + g * 128 + c0; const GAS bf16* up = P + (m0 + (tid >> 2)) * PW + 1536 + g * 128 + (tid & 3) * 32;
#pragma unroll
        for (int j4 = 0; j4 < 4; ++j4) { za[j4] = *(const GAS v4u*)(zp + 8 * j4); ua[j4] = *(const GAS v4u*)(up + 8 * j4); } }
#pragma unroll 1
    for (int u = first; u < 1024; u += 2 * stride) {
        const int u1 = u + stride, u2 = u + 2 * stride;
        sgu_unit(F, u, u1 < 1024 ? u1 : -1, za, ua, zb, ub);
        if (u1 < 1024) sgu_unit(F, u1, u2 < 1024 ? u2 : -1, zb, ub, za, ua);
    }
}

__device__ __forceinline__ void final_norm(Frame& F) {
    const int gw = F.bid * NWAVES + F.wave, NGW = F.G * NWAVES, lane = F.lane;
    const GAS float* ssq = WSPG(float, WS_SSQ); const GAS float* gn = INP(6);
    f32x4 gv[4];
#pragma unroll
    for (int j = 0; j < 4; ++j) gv[j] = *(const GAS f32x4*)(gn + 4 * lane + 256 * j);
    for (int m0 = gw; m0 < MROWS; m0 += 4 * NGW) {
        v2u w[4][4]; float sv[4];
#pragma unroll
        for (int u = 0; u < 4; ++u) { const int m = m0 + u * NGW; const int mc = m < MROWS ? m : m0; sv[u] = ssq[mc];
            const GAS v2u* xr = (const GAS v2u*)(WSPG(bf16, WS_XB) + (size_t)mc * DM) + lane;
#pragma unroll
            for (int j = 0; j < 4; ++j) w[u][j] = __builtin_nontemporal_load(xr + 64 * j); }
#pragma unroll
        for (int u = 0; u < 4; ++u) { const int m = m0 + u * NGW;
            if (m < MROWS) { const float r = __builtin_amdgcn_rsqf(sv[u] * (1.0f / DM) + EPS); GAS f32x4* orow = (GAS f32x4*)(F.out + (size_t)m * DM) + lane;
#pragma unroll
                for (int j = 0; j < 4; ++j) { f32x4 v = (f32x4){hlo(w[u][j].x), hhi(w[u][j].x), hlo(w[u][j].y), hhi(w[u][j].y)}; v = v * r * gv[j]; __builtin_nontemporal_store(v, orow + 64 * j); } } }
    }
}


#ifdef DIS_HGRN
#define HGRN_CALL(...)
#else
#define HGRN_CALL hgrn_unit
#endif
#ifdef DIS_CONV
#define CONV_CALL(...)
#else
#define CONV_CALL conv_tiles
#endif
#ifdef DIS_MOBA
#define MOBA_CALL(...)
#else
#define MOBA_CALL moba_unit
#endif
#ifdef DIS_SGU
#define SGU_CALL(...)
#else
#define SGU_CALL sgu_units
#endif
#ifndef REP_HGRN
#define REP_HGRN 1
#endif
#ifndef REP_CONV
#define REP_CONV 1
#endif
#ifndef REP_MOBA
#define REP_MOBA 1
#endif
#ifndef REP_SGU
#define REP_SGU 1
#endif
#ifndef REP_FFN
#define REP_FFN 1
#endif
#ifndef REP_P0
#define REP_P0 1
#endif
#ifndef GSEL
#define GSEL 0
#endif
#ifdef DIS_GEMM
template <class Epi, class Sched, bool A, bool B> __device__ __forceinline__ void gemm_dummy(LAS unsigned char*, const pg8::Gemm, const Sched&, const Epi&) {}
#define GEMM_CALL gemm_dummy
#else
#define GEMM_CALL pg8::gemm_phase
#endif
__device__ __forceinline__ void sub_barrier(Frame& F, unsigned* cnt, unsigned n) {
    asm volatile("s_waitcnt vmcnt(0)" ::: "memory"); __syncthreads();
    if (F.tid == 0) {
        __threadfence();
        asm volatile("s_waitcnt vmcnt(0)" ::: "memory");
        (void)__hip_atomic_fetch_add(cnt, 1u, __ATOMIC_RELAXED, __HIP_MEMORY_SCOPE_AGENT);
        unsigned sp = 0;
        while (__hip_atomic_load(cnt, __ATOMIC_RELAXED, __HIP_MEMORY_SCOPE_AGENT) < n) { __builtin_amdgcn_s_sleep(2); if (++sp > (1u << 22)) break; }
        __threadfence();
        asm volatile("s_waitcnt vmcnt(0)" ::: "memory");
    }
    __syncthreads();
}
template <int l> __device__ __forceinline__ void layer_phases(Frame& F, const int lo, const int hi, const XcdBarrier& bar, const int vcu) {
#define IN(k) (lo <= (k) && (k) < hi)
#define SEAM(k) do { if (IN(k) && IN((k) + 1)) xcd_barrier(bar); } while (0)
#define PH_ENTER() asm volatile("" : "+s"(F.ws), "+s"(F.out))
#define XB WSP(bf16, WS_XB)
#define BIG WSP(bf16, WS_BIG)
#define MIX WSP(bf16, WS_MIX)
#define QO WSP(bf16, WS_QO)
#define SSQ WSP(float, WS_SSQ)

        constexpr int pb = l == 0 ? 2 : 9;
        if (l == 1) {
            if (IN(8)) { PH_ENTER();
                pg8::Gemm g{XB, WSP(bf16, WS_WIN1), DM, DM, DM}; pg8::StaticOrder S; S.init(MROWS, PW, F.G, F.bid, DM, DM);
                pg8::EpiIn1 E{BIG, SSQ + MROWS, WSP(float, WS_KPART), C2M};
                GEMM_CALL<pg8::EpiIn1, pg8::StaticOrder, true, true>(F.lds, g, S, E);
            } SEAM(8);
        }
        if (IN(pb)) { PH_ENTER();
            if (l == 0) {
                const int nh = F.G > 64 ? 64 : F.G;
                for (int rep = 0; rep < REP_HGRN; ++rep)
                if (F.bid < nh) { for (int u = F.bid; u < 64; u += nh) HGRN_CALL(F, u >> 2, u & 3); }
                for (int rep = 0; rep < REP_CONV; ++rep)
                {   const bool split = F.G > 64; const int g2 = split ? F.G - 64 : F.G, c2 = split ? F.bid - 64 : F.bid;
                    if (c2 >= 0) {
                        CONV_CALL(F, c2, g2);
#pragma unroll 1
                        for (int q = 0; q < 4; ++q) {
                            pg8::Gemm g{WSP(bf16, WS_MEMB), WSP(bf16, (q & 1) ? WS_WV : WS_WK) + (size_t)(q >> 1) * DM * DM, DM, DM, DM}; pg8::StaticOrder S; S.init(MMEM, DM, g2, ((c2 - 64 * q - 128) % g2 + g2) % g2, DM, DM);
                            pg8::EpiK E{WSP(bf16, (q & 1) ? WS_VT : WS_KB) + (size_t)(q >> 1) * MMEM * DM, WSP(float, WS_RMEM)};
                            GEMM_CALL<pg8::EpiK, pg8::StaticOrder, true, true>(F.lds, g, S, E); }
                        convert_rest(F, c2 * NWAVES + F.wave, g2 * NWAVES);
                        sub_barrier(F, (unsigned*)(F.ws + WS_CTL) + 900, (unsigned)g2);
                        {   int k256 = 256; asm volatile("" : "+s"(k256));
                            {   pg8::Gemm g{WSP(bf16, WS_KB), WSP(bf16, WS_WQ), k256, DM, DM}; pg8::SubOrder S{g2, (c2 + 64) % g2, 0};
                                pg8::EpiSub E{QO, 0};
                                GEMM_CALL<pg8::EpiSub, pg8::SubOrder, true, true>(F.lds, g, S, E); }
                            {   pg8::Gemm g{WSP(bf16, WS_WO), WSP(bf16, WS_VT), k256, DM, DM}; pg8::SubOrder S{g2, (c2 + 128) % g2, 1};
                                pg8::EpiSub E{QO + (size_t)16 * DM * DM, 1};
                                GEMM_CALL<pg8::EpiSub, pg8::SubOrder, true, true>(F.lds, g, S, E); }
                            {   pg8::Gemm g{WSP(bf16, WS_KB) + (size_t)MMEM * DM, WSP(bf16, WS_WQ) + (size_t)DM * DM, k256, DM, DM}; pg8::SubOrder S{g2, c2 % g2, 0};
                                pg8::EpiSub E{(bf16*)F.out, 0};
                                GEMM_CALL<pg8::EpiSub, pg8::SubOrder, true, true>(F.lds, g, S, E); }
                            {   pg8::Gemm g{WSP(bf16, WS_WO) + (size_t)DM * DM, WSP(bf16, WS_VT) + (size_t)MMEM * DM, k256, DM, DM}; pg8::SubOrder S{g2, c2 % g2, 1};
                                pg8::EpiSub E{(bf16*)F.out + (size_t)16 * DM * DM, 1};
                                GEMM_CALL<pg8::EpiSub, pg8::SubOrder, true, true>(F.lds, g, S, E); } }
                    } }
            } else {
                for (int rep = 0; rep < REP_MOBA; ++rep)
                for (int p = vcu; p < 512; p += F.G) { const int b = p >> 5, hd = (p >> 2) & 7, pj = p & 3; MOBA_CALL(F, b, hd, 7 - pj); MOBA_CALL(F, b, hd, pj); }
                for (int rep = 0; rep < REP_SGU; ++rep)
                SGU_CALL(F, vcu, F.G);
            }
        } SEAM(pb);
        if (IN(pb + 1)) { PH_ENTER();
            pg8::Gemm g{MIX, WSP(bf16, l == 0 ? WS_WOUT0 : WS_WOUT1), DM, DM, DM}; pg8::StaticOrder S; S.init(MROWS, DM, F.G, F.bid, DM, DM);
            constexpr int j = 1 + 3 * l;
            for (int i = F.bid * (NWAVES * 64) + F.tid; i < MROWS; i += F.G * NWAVES * 64) (SSQ + ((j + 1) & 1) * MROWS)[i] = 0.f;
            pg8::EpiRes E{XB, nullptr, SSQ + (j & 1) * MROWS};
            GEMM_CALL<pg8::EpiRes, pg8::StaticOrder, true, true>(F.lds, g, S, E);
        } SEAM(pb + 1);
        if (IN(pb + 2)) { PH_ENTER();
            pg8::Gemm g{XB, l == 0 ? QO : (bf16*)F.out, DM, DM, DM}; pg8::StaticOrder S; S.init(MROWS, DM, F.G, F.bid, DM, DM, DM);
            pg8::EpiSoftmax E{MIX, SSQ + ((1 + 3 * l) & 1) * MROWS, (LAS float*)(F.lds + RING_BYTES)};
#ifndef DIS_SM
            GEMM_CALL<pg8::EpiSoftmax, pg8::StaticOrder, true, true>(F.lds, g, S, E);
#endif
        } SEAM(pb + 2);
        if (IN(pb + 3)) { PH_ENTER();
            pg8::Gemm g{MIX, (l == 0 ? QO : (bf16*)F.out) + (size_t)16 * DM * DM, DM, DM, DM}; pg8::StaticOrder S; S.init(MROWS, DM, F.G, F.bid, DM, DM, DM);
            constexpr int j = 2 + 3 * l;
            for (int i = F.bid * (NWAVES * 64) + F.tid; i < MROWS; i += F.G * NWAVES * 64) (SSQ + ((j + 1) & 1) * MROWS)[i] = 0.f;
            pg8::EpiRes E{XB, nullptr, SSQ + (j & 1) * MROWS};
            GEMM_CALL<pg8::EpiRes, pg8::StaticOrder, true, true>(F.lds, g, S, E);
        } SEAM(pb + 3);
        if (IN(pb + 4)) { PH_ENTER();
            pg8::Gemm g{XB, WSP(bf16, WS_WFI) + (size_t)l * DM * 2 * FFH, DM, DM, DM}; pg8::StaticOrder S; S.init(MROWS, 2 * FFH, F.G, F.bid, DM, DM);
            pg8::EpiFfn E{BIG, SSQ + ((2 + 3 * l) & 1) * MROWS};
            for (int rep = 0; rep < REP_FFN; ++rep)
            GEMM_CALL<pg8::EpiFfn, pg8::StaticOrder, true, true>(F.lds, g, S, E);
        } SEAM(pb + 4);
        if (IN(pb + 5)) { PH_ENTER();
            pg8::Gemm g{BIG, WSP(bf16, WS_WFO) + (size_t)l * FFH * DM, FFH, FFH, FFH}; pg8::StaticOrder S; S.init(MROWS, DM, F.G, F.bid, FFH, FFH);
            constexpr int j = 3 + 3 * l;
            for (int i = F.bid * (NWAVES * 64) + F.tid; i < MROWS; i += F.G * NWAVES * 64) (SSQ + ((j + 1) & 1) * MROWS)[i] = 0.f;
            pg8::EpiRes E{XB, nullptr, SSQ + (j & 1) * MROWS};
            GEMM_CALL<pg8::EpiRes, pg8::StaticOrder, true, true>(F.lds, g, S, E);
        } SEAM(pb + 5);

#undef IN
#undef SEAM
#undef PH_ENTER
#undef XB
#undef BIG
#undef MIX
#undef QO
#undef SSQ
}

__global__ void __launch_bounds__(NWAVES * 64, 2) fwd_kernel(Args args) {
    extern __shared__ __attribute__((aligned(16))) unsigned char lds[];
    Frame F;
    F.lds = (LAS unsigned char*)lds;
    F.tid = threadIdx.x; F.lane = F.tid & 63; F.wave = __builtin_amdgcn_readfirstlane(F.tid >> 6);
    F.G = gridDim.x; F.bid = blockIdx.x;
    F.ka = (const CAS Args*)__builtin_amdgcn_kernarg_segment_ptr();
    F.out = args.out; F.ws = args.ws;
    const int vcu = (F.G % 8 == 0) ? (F.bid % 8) * (F.G / 8) + F.bid / 8 : F.bid;
    volatile LAS unsigned* MISC = (volatile LAS unsigned*)(F.lds + MISC_OFF);
    for (int u = F.tid; u < (LDS_BYTES - LDSCTL_OFF) / 4; u += NWAVES * 64) ((LAS unsigned*)(F.lds + LDSCTL_OFF))[u] = 0u;
    __syncthreads();
    const int lo = args.ph_lo, hi = args.ph_hi;
    unsigned* barw = (unsigned*)(F.ws + WS_CTL) + CW_BAR;
    XcdBarrier bar; bar.bar = barw; bar.x = 0; bar.st = nullptr;
    if (hi - lo > 1) bar = xcd_barrier_post(barw, MISC + 8);
#define IN(k) (lo <= (k) && (k) < hi)
#define PH_ENTER() asm volatile("" : "+s"(F.ws), "+s"(F.out))
#define SEAM(k) do { if (IN(k) && IN((k) + 1)) xcd_barrier(bar); } while (0)
#define XB WSP(bf16, WS_XB)
#define BIG WSP(bf16, WS_BIG)
#define MIX WSP(bf16, WS_MIX)
#define QO WSP(bf16, WS_QO)
#define SSQ WSP(float, WS_SSQ)

    #ifndef DIS_P0
    for (int rep = 0; rep < REP_P0; ++rep)
    if (IN(0)) { PH_ENTER(); p0_prologue(F); }
#endif
    SEAM(0);

    if (IN(1)) { PH_ENTER();
        pg8::Gemm g{XB, WSP(bf16, WS_WIN0), DM, DM, DM}; pg8::StaticOrder S; S.init(MROWS, 3072, F.G, F.bid, DM, DM);
        pg8::EpiIn0 E{BIG, SSQ, WSP(float, WS_LB)};
        GEMM_CALL<pg8::EpiIn0, pg8::StaticOrder, true, true>(F.lds, g, S, E);
    } SEAM(1);

    layer_phases<0>(F, lo, hi, bar, vcu);
    layer_phases<1>(F, lo, hi, bar, vcu);
    #ifndef DIS_FIN
    if (IN(15)) final_norm(F);
#endif
#undef IN
#undef SEAM
#undef XB
#undef BIG
#undef MIX
#undef QO
#undef SSQ
}

extern "C" void kernel_launch(void* const* d_in, const int* in_sizes, int n_in, void* d_out, int out_size, void* d_ws, size_t ws_size, hipStream_t stream) {
    static int grid = 0;
    if (grid == 0) {
        if (n_in != 26 || in_sizes[0] != MROWS * DM || out_size != MROWS * DM || ws_size < WS_END) {
            fprintf(stderr, "kernel_launch: unexpected shapes (n_in %d, in0 %d, out %d, ws %zu); nothing launched\n", n_in, n_in > 0 ? in_sizes[0] : -1, out_size, ws_size); grid = -1; return; }
        int dev = 0, cus = 0;
        if (hipGetDevice(&dev) != hipSuccess || hipDeviceGetAttribute(&cus, hipDeviceAttributeMultiprocessorCount, dev) != hipSuccess) { fprintf(stderr, "kernel_launch: device query failed\n"); grid = -1; return; }
        if (hipFuncSetAttribute((const void*)fwd_kernel, hipFuncAttributeMaxDynamicSharedMemorySize, LDS_BYTES) != hipSuccess) { fprintf(stderr, "kernel_launch: hipFuncSetAttribute failed\n"); grid = -1; return; }
        (void)hipGetLastError();
        grid = cus > 256 ? 256 : cus;
    }
    if (grid < 0) return;
    (void)hipMemsetAsync((char*)d_ws + WS_CTL, 0, CTL_ZERO_BYTES, stream);
    Args a{};
    for (int i = 0; i < 26; ++i) a.in[i] = (const float*)d_in[i];
    a.out = (float*)d_out; a.ws = (unsigned char*)d_ws;
#if MK_ONE_LAUNCH
    a.ph_lo = 0; a.ph_hi = NPH;
    hipLaunchKernelGGL(fwd_kernel, dim3(grid), dim3(NWAVES * 64), LDS_BYTES, stream, a);
#else
    for (int p = 0; p < NPH; ++p) { a.ph_lo = p; a.ph_hi = p + 1; hipLaunchKernelGGL(fwd_kernel, dim3(grid), dim3(NWAVES * 64), LDS_BYTES, stream, a); }
#endif
}
```
